# Optimizing an MI355X kernel written in HIP

```python
import jax, jax.numpy as jnp
from jax import lax
import numpy as np

D_MODEL = 1024
BATCH = 8
SEQ = 8192
DEPTH = 2

CHUNK = 64
N_A = DEPTH // 2
N_B = DEPTH - N_A

RWKV_HEAD = 64
RWKV_HEADS = D_MODEL // RWKV_HEAD
DECAY_LORA = 64
AAA_LORA = 64
GATE_LORA = 160
RWKV_LN_EPS = 64e-5

SB_HEAD = 64
SB_HEADS = D_MODEL // SB_HEAD
Q_BLOCK = 128

MEM_TOKENS = 256
MEM_HEADS = 4
MEM_HEAD = D_MODEL // MEM_HEADS

N_GROUPS = 4
EXPERTS_PER_GROUP = 8
N_EXPERTS = N_GROUPS * EXPERTS_PER_GROUP
TOP_K = 2
D_EXPERT = D_MODEL // 4
MOE_BLOCK = 128

NORM_EPS = 1e-6

kernel_name = 'rwkv7_stickbreak_yoco_hmoe'


def rmsnorm(x, g):
    xf = x.astype(jnp.float32)
    y = xf * lax.rsqrt(jnp.mean(xf * xf, axis=-1, keepdims=True) + NORM_EPS)
    return (y * g.astype(jnp.float32)).astype(x.dtype)


def rwkv7_scan(r, decay, k, v, a, b):
    B, S, H, N = r.shape

    def step(state, inp):
        r_t, w_t, k_t, v_t, a_t, b_t = inp
        sa = jnp.einsum('bhij,bhj->bhi', state, a_t)
        state = (state * w_t[:, :, None, :]
                 + sa[..., None] * b_t[:, :, None, :]
                 + v_t[..., None] * k_t[:, :, None, :])
        return state, jnp.einsum('bhij,bhj->bhi', state, r_t)

    tm = lambda t: jnp.moveaxis(t, 1, 0)
    s0 = jnp.zeros((B, H, N, N), jnp.float32)
    _, y = lax.scan(step, s0, (tm(r), tm(decay), tm(k), tm(v), tm(a), tm(b)))
    return jnp.moveaxis(y, 0, 1)


def rwkv7_time_mix(h, mu, w_rkv, w0, w1, w2, a0, a1, a2, g1, g2, k_k, k_a, r_k, ln_g, ln_b, w_o):
    B, S, D = h.shape
    H, N = RWKV_HEADS, RWKV_HEAD
    f32 = jnp.float32
    xx = jnp.pad(h, ((0, 0), (1, 0), (0, 0)))[:, :S] - h
    lerp = lambda i: h + xx * mu[i]
    rkv = jnp.einsum('nbsd,nde->nbse', jnp.stack([lerp(0), lerp(1), lerp(2)]), w_rkv).astype(f32)
    r, k, v = rkv[0], rkv[1], rkv[2]
    w = -jax.nn.softplus(-(w0 + jnp.tanh(lerp(3) @ w1) @ w2).astype(f32)) - 0.5
    decay = jnp.exp(-jnp.exp(w))
    a = jax.nn.sigmoid((a0 + (lerp(4) @ a1) @ a2).astype(f32))
    g = jax.nn.sigmoid(lerp(5) @ g1) @ g2
    heads = lambda t: t.reshape(B, S, H, N)
    kk = heads(k * k_k)
    kk = kk / jnp.maximum(jnp.sqrt(jnp.sum(kk * kk, axis=-1, keepdims=True)), 1e-12)
    k = k * (1.0 + (a - 1.0) * k_a)
    r, k, v, a, decay = heads(r), heads(k), heads(v), heads(a), heads(decay)
    y = rwkv7_scan(r, decay, k, v, -kk, kk * a)
    mean = jnp.mean(y, axis=-1, keepdims=True)
    var = jnp.mean(jnp.square(y - mean), axis=-1, keepdims=True)
    y = ((y - mean) * lax.rsqrt(var + RWKV_LN_EPS)).reshape(B, S, D) * ln_g + ln_b
    bonus = jnp.sum(r * k * r_k, axis=-1, keepdims=True) * v
    y = y + bonus.reshape(B, S, D)
    return (y.astype(h.dtype) * g) @ w_o


def stick_breaking_attention(q, k, v):
    B, S, H, Dh = q.shape
    nb = S // Q_BLOCK
    blk = lambda t: t.astype(jnp.float32).reshape(B, nb, Q_BLOCK, H, Dh).transpose(1, 0, 3, 2, 4)
    qb = blk(q) * (Dh ** -0.5)
    kb, vb = blk(k), blk(v)
    pos = jnp.arange(Q_BLOCK)

    def query_block(i):
        qi = lax.dynamic_index_in_dim(qb, i, 0, keepdims=False)

        def key_block(step, carry):
            acc, log_rest = carry
            j = i - step
            kj = lax.dynamic_index_in_dim(kb, j, 0, keepdims=False)
            vj = lax.dynamic_index_in_dim(vb, j, 0, keepdims=False)
            z = jnp.einsum('bhqd,bhkd->bhqk', qi, kj)
            causal = (j * Q_BLOCK + pos)[None, :] < (i * Q_BLOCK + pos)[:, None]
            log_keep = jnp.where(causal, jax.nn.log_sigmoid(-z), 0.0)
            between = lax.cumsum(log_keep, axis=3, reverse=True) - log_keep + log_rest[..., None]
            attn = jnp.where(causal, jnp.exp(jax.nn.log_sigmoid(z) + between), 0.0)
            acc = acc + jnp.einsum('bhqk,bhkd->bhqd', attn, vj)
            return acc, log_rest + jnp.sum(log_keep, axis=-1)

        init = (jnp.zeros((B, H, Q_BLOCK, Dh), jnp.float32), jnp.zeros((B, H, Q_BLOCK), jnp.float32))
        acc, _ = lax.fori_loop(0, i + 1, key_block, init)
        return acc

    out = lax.map(query_block, jnp.arange(nb))
    return out.transpose(1, 0, 3, 2, 4).reshape(B, S, H, Dh).astype(q.dtype)


def memory_cross_attention(h, mem, g_mem, w_q, w_kv, w_o):
    B, S, D = h.shape
    M = mem.shape[1]
    m = rmsnorm(mem, g_mem)
    q = (h @ w_q).reshape(B, S, MEM_HEADS, MEM_HEAD).astype(jnp.float32)
    kv = (m @ w_kv).reshape(B, M, 2, MEM_HEADS, MEM_HEAD).astype(jnp.float32)
    s = jnp.einsum('bshd,bmhd->bhsm', q, kv[:, :, 0]) * (MEM_HEAD ** -0.5)
    p = jax.nn.softmax(s, axis=-1)
    o = jnp.einsum('bhsm,bmhd->bshd', p, kv[:, :, 1]).astype(h.dtype).reshape(B, S, D)
    return o @ w_o


def hierarchical_moe(h, w_rg, b_rg, w_re, b_re, w_gate, w_up, w_down):
    B, S, D = h.shape
    T = B * S
    f32 = jnp.float32
    xt = h.reshape(T, D)
    g_prob = jax.nn.softmax((xt @ w_rg).astype(f32) + b_rg.astype(f32), axis=-1)
    grp = jnp.argmax(g_prob, axis=-1)
    g_w = jnp.take_along_axis(g_prob, grp[:, None], axis=1)
    e_logits = ((xt @ w_re).astype(f32) + b_re.astype(f32)).reshape(T, N_GROUPS, EXPERTS_PER_GROUP)
    e_logits = jnp.take_along_axis(e_logits, grp[:, None, None], axis=1)[:, 0]
    e_w, e_loc = lax.top_k(jax.nn.softmax(e_logits, axis=-1), TOP_K)
    e_w = e_w / jnp.sum(e_w, axis=-1, keepdims=True)
    gate = (g_w * e_w).reshape(-1)
    expert = (grp[:, None] * EXPERTS_PER_GROUP + e_loc).reshape(-1).astype(jnp.int32)
    token = jnp.repeat(jnp.arange(T, dtype=jnp.int32), TOP_K)
    A = T * TOP_K
    cap = A + N_EXPERTS * MOE_BLOCK
    n_blocks = cap // MOE_BLOCK
    order = jnp.argsort(expert)
    se = expert[order]
    counts = jnp.bincount(expert, length=N_EXPERTS)
    padded = (counts + MOE_BLOCK - 1) // MOE_BLOCK * MOE_BLOCK
    start = jnp.cumsum(counts) - counts
    pend = jnp.cumsum(padded)
    pstart = pend - padded
    dest = pstart[se] + jnp.arange(A, dtype=jnp.int32) - start[se]
    slot_tok = jnp.full((cap,), T, jnp.int32).at[dest].set(token[order])
    slot_gate = jnp.zeros((cap,), f32).at[dest].set(gate[order])
    block_expert = jnp.minimum(jnp.searchsorted(pend, jnp.arange(n_blocks) * MOE_BLOCK, side='right'), N_EXPERTS - 1)
    xpad = jnp.concatenate([xt, jnp.zeros((1, D), xt.dtype)], axis=0)
    xs = xpad[slot_tok].reshape(n_blocks, MOE_BLOCK, D)

    def expert_block(args):
        xb, e = args
        hid = jax.nn.silu(xb @ w_gate[e]) * (xb @ w_up[e])
        return hid @ w_down[e]

    ys = lax.map(expert_block, (xs, block_expert)).reshape(cap, D)
    y = jax.ops.segment_sum(ys * slot_gate[:, None].astype(ys.dtype), slot_tok, num_segments=T + 1)[:T]
    return y.reshape(B, S, D).astype(h.dtype)


def setup_inputs(seed: int = 0) -> dict:
    key = jax.random.key(seed)
    ks = iter(jax.random.split(key, 64))
    f32 = jnp.float32
    D, H, N = D_MODEL, RWKV_HEADS, RWKV_HEAD

    def nrm(shape, scale):
        return jax.random.normal(next(ks), shape, f32) * scale

    def gain(shape):
        return 1.0 + nrm(shape, 0.02)

    return {
        'x': nrm((BATCH, SEQ, D), 1.0),
        'mem': nrm((BATCH, MEM_TOKENS, D), 1.0),
        'norm_mix': gain((DEPTH, D)),
        'norm_mem': gain((DEPTH, D)),
        'norm_ffn': gain((DEPTH, D)),
        'norm_final': gain((D,)),
        'rwkv_mu': jax.random.uniform(next(ks), (N_A, 6, D), f32),
        'rwkv_w_rkv': nrm((N_A, 3, D, D), D ** -0.5),
        'rwkv_w0': jax.random.uniform(next(ks), (N_A, D), f32, -4.0, 0.0),
        'rwkv_w1': nrm((N_A, D, DECAY_LORA), D ** -0.5),
        'rwkv_w2': nrm((N_A, DECAY_LORA, D), 0.5 * DECAY_LORA ** -0.5),
        'rwkv_a0': nrm((N_A, D), 0.1),
        'rwkv_a1': nrm((N_A, D, AAA_LORA), D ** -0.5),
        'rwkv_a2': nrm((N_A, AAA_LORA, D), 0.5 * AAA_LORA ** -0.5),
        'rwkv_g1': nrm((N_A, D, GATE_LORA), D ** -0.5),
        'rwkv_g2': nrm((N_A, GATE_LORA, D), GATE_LORA ** -0.5),
        'rwkv_k_k': 0.85 + nrm((N_A, D), 0.05),
        'rwkv_k_a': 1.0 + nrm((N_A, D), 0.05),
        'rwkv_r_k': nrm((N_A, H, N), 0.1),
        'rwkv_ln_g': gain((N_A, D)),
        'rwkv_ln_b': nrm((N_A, D), 0.01),
        'rwkv_w_o': nrm((N_A, D, D), D ** -0.5),
        'kv_norm': gain((D,)),
        'w_kv_shared': nrm((D, 2 * D), D ** -0.5),
        'sb_w_q': nrm((N_B, D, D), D ** -0.5),
        'sb_w_o': nrm((N_B, D, D), D ** -0.5),
        'mem_norm_kv': gain((DEPTH, D)),
        'mem_w_q': nrm((DEPTH, D, D), D ** -0.5),
        'mem_w_kv': nrm((DEPTH, D, 2 * D), D ** -0.5),
        'mem_w_o': nrm((DEPTH, D, D), D ** -0.5),
        'moe_w_group': nrm((DEPTH, D, N_GROUPS), D ** -0.5),
        'moe_b_group': nrm((DEPTH, N_GROUPS), 0.01),
        'moe_w_expert': nrm((DEPTH, D, N_EXPERTS), D ** -0.5),
        'moe_b_expert': nrm((DEPTH, N_EXPERTS), 0.01),
        'moe_w_gate': nrm((DEPTH, N_EXPERTS, D, D_EXPERT), D ** -0.5),
        'moe_w_up': nrm((DEPTH, N_EXPERTS, D, D_EXPERT), D ** -0.5),
        'moe_w_down': nrm((DEPTH, N_EXPERTS, D_EXPERT, D), D_EXPERT ** -0.5),
    }


def reference(x, mem, norm_mix, norm_mem, norm_ffn, norm_final,
              rwkv_mu, rwkv_w_rkv, rwkv_w0, rwkv_w1, rwkv_w2, rwkv_a0, rwkv_a1, rwkv_a2,
              rwkv_g1, rwkv_g2, rwkv_k_k, rwkv_k_a, rwkv_r_k, rwkv_ln_g, rwkv_ln_b, rwkv_w_o,
              kv_norm, w_kv_shared, sb_w_q, sb_w_o,
              mem_norm_kv, mem_w_q, mem_w_kv, mem_w_o,
              moe_w_group, moe_b_group, moe_w_expert, moe_b_expert, moe_w_gate, moe_w_up, moe_w_down):
    B, S, D = x.shape
    k_sh = v_sh = None
    for l in range(DEPTH):
        h = rmsnorm(x, norm_mix[l])
        if l < N_A:
            a = l
            x = x + rwkv7_time_mix(h, rwkv_mu[a], rwkv_w_rkv[a], rwkv_w0[a], rwkv_w1[a], rwkv_w2[a],
                                   rwkv_a0[a], rwkv_a1[a], rwkv_a2[a], rwkv_g1[a], rwkv_g2[a],
                                   rwkv_k_k[a], rwkv_k_a[a], rwkv_r_k[a], rwkv_ln_g[a], rwkv_ln_b[a], rwkv_w_o[a])
        else:
            b = l - N_A
            q = (h @ sb_w_q[b]).reshape(B, S, SB_HEADS, SB_HEAD)
            o = stick_breaking_attention(q, k_sh, v_sh)
            x = x + o.reshape(B, S, D) @ sb_w_o[b]
        x = x + memory_cross_attention(rmsnorm(x, norm_mem[l]), mem, mem_norm_kv[l],
                                       mem_w_q[l], mem_w_kv[l], mem_w_o[l])
        x = x + hierarchical_moe(rmsnorm(x, norm_ffn[l]), moe_w_group[l], moe_b_group[l],
                                 moe_w_expert[l], moe_b_expert[l], moe_w_gate[l], moe_w_up[l], moe_w_down[l])
        if l == N_A - 1:
            kv = (rmsnorm(x, kv_norm) @ w_kv_shared).reshape(B, S, 2, SB_HEADS, SB_HEAD)
            k_sh, v_sh = kv[:, :, 0], kv[:, :, 1]
    return rmsnorm(x, norm_final)
```

```cpp
#include <hip/hip_runtime.h>
#include <cstdio>
#include <cstdint>

#define LAS __attribute__((address_space(3)))
typedef unsigned short bf16_t;
typedef short bf16x8 __attribute__((ext_vector_type(8)));
typedef float f32x4 __attribute__((ext_vector_type(4)));
typedef float f32x2 __attribute__((ext_vector_type(2)));
typedef short s16x4 __attribute__((ext_vector_type(4)));
typedef unsigned u32x4 __attribute__((ext_vector_type(4)));
typedef unsigned u32x2 __attribute__((ext_vector_type(2)));

constexpr int NB = 8, S = 8192, D = 1024, T = NB * S;
constexpr int HP_ROWS = NB * (S + 1);
constexpr int NSLOT_MAX = 2 * T + 32 * 256;
constexpr int NTILE_MAX = NSLOT_MAX / 256;
constexpr float NORM_EPS = 1e-6f;

constexpr size_t MiB = 1u << 20;
constexpr size_t WS_CTL = 0, CTL_BYTES = 1 * MiB;
constexpr size_t WS_WCAT = 1 * MiB;
constexpr size_t WS_WWA2 = WS_WCAT + (size_t)3584 * 2048 * 2;
constexpr size_t WS_WG2 = WS_WWA2 + (size_t)2048 * 256 * 2;
constexpr size_t WS_WO0 = WS_WG2 + (size_t)1024 * 256 * 2;
constexpr size_t WS_WKVQ = WS_WO0 + (size_t)1024 * 1024 * 2;
constexpr size_t WS_WOSB = WS_WKVQ + (size_t)3072 * 1024 * 2;
constexpr size_t WS_WMQ = WS_WOSB + (size_t)1024 * 1024 * 2;
constexpr size_t WS_WMKV = WS_WMQ + (size_t)2 * 1024 * 1024 * 2;
constexpr size_t WS_WMO = WS_WMKV + (size_t)2 * 2048 * 1024 * 2;
constexpr size_t WS_WGU = WS_WMO + (size_t)2 * 1024 * 1024 * 2;
constexpr size_t WS_WDN = WS_WGU + (size_t)2 * 32 * 512 * 1024 * 2;
constexpr size_t WS_WR = WS_WDN + (size_t)2 * 32 * 1024 * 256 * 2;
constexpr size_t WS_WEND = WS_WR + (size_t)2 * 36 * 1024 * 4;
constexpr size_t WS_MN = (WS_WEND + 4095) / 4096 * 4096;
constexpr size_t WS_KMEM = WS_MN + (size_t)2048 * 1024 * 2;
constexpr size_t WS_VT = WS_KMEM + (size_t)2 * 2048 * 1024 * 2;
constexpr size_t WS_SSQ = WS_VT + (size_t)2 * 2048 * 1024 * 2;
constexpr size_t WS_RS = WS_SSQ + (size_t)T * 16 * 4;
constexpr size_t WS_TOK = WS_RS + (size_t)T * 16 * 4;
constexpr size_t WS_SLOTOF = WS_TOK + (size_t)T * 16;
constexpr size_t WS_SLOTINFO = WS_SLOTOF + (size_t)T * 8;
constexpr size_t WS_TILEEXP = WS_SLOTINFO + (size_t)NSLOT_MAX * 8;
constexpr size_t WS_SLOTTOK = WS_TILEEXP + 4096;
constexpr size_t WS_ARENA = (WS_SLOTTOK + (size_t)NSLOT_MAX * 4 + MiB - 1) / MiB * MiB;
constexpr size_t R0 = WS_ARENA;
constexpr size_t R1 = R0 + 129 * MiB;
constexpr size_t R2 = R1 + 128 * MiB;
constexpr size_t R3 = R2 + 128 * MiB;
constexpr size_t R4 = R3 + 128 * MiB;
constexpr size_t R5 = R4 + 128 * MiB;
constexpr size_t R6 = R5 + 64 * MiB;
constexpr size_t WS_END = R6 + 128 * MiB;
static_assert((size_t)HP_ROWS * D * 2 <= 129 * MiB, "hp");
static_assert((size_t)NSLOT_MAX * D * 2 <= 3 * 128 * MiB, "xs/ys");
static_assert(WS_END <= (size_t)1024 * MiB, "workspace over 1 GiB");

constexpr int CW_BAR = 4096;
constexpr int CW_CNT = 16384;
constexpr int CW_FILL = 16384 + 256;
constexpr int CW_NT = 16384 + 512;

constexpr int LDS_BYTES = 161792;
constexpr int LDS_EPI = 131072;
constexpr int LDS_MISC = LDS_BYTES - 256;

__device__ __forceinline__ unsigned f2bf(float f) { unsigned u = __builtin_bit_cast(unsigned, f); return (u + 0x7fffu + ((u >> 16) & 1u)) >> 16; }
typedef __bf16 bf16v2_t __attribute__((ext_vector_type(2)));
__device__ __forceinline__ unsigned cvt_pk_c(float lo, float hi) { const f32x2 v = {lo, hi}; const bf16v2_t b = __builtin_convertvector(v, bf16v2_t); return __builtin_bit_cast(unsigned, b); }
__device__ __forceinline__ unsigned cvt_pk_bf16(float lo, float hi) { return cvt_pk_c(lo, hi); }
typedef float f32x16 __attribute__((ext_vector_type(16)));
__device__ __forceinline__ bf16x8 pack8c(float a0, float a1, float a2, float a3, float a4, float a5, float a6, float a7) {
    u32x4 w; w.x = cvt_pk_c(a0, a1); w.y = cvt_pk_c(a2, a3); w.z = cvt_pk_c(a4, a5); w.w = cvt_pk_c(a6, a7); return __builtin_bit_cast(bf16x8, w); }
__device__ __forceinline__ bf16x8 pack8v(float a0, float a1, float a2, float a3, float a4, float a5, float a6, float a7) {
    u32x4 w; w.x = cvt_pk_bf16(a0, a1); w.y = cvt_pk_bf16(a2, a3); w.z = cvt_pk_bf16(a4, a5); w.w = cvt_pk_bf16(a6, a7); return __builtin_bit_cast(bf16x8, w); }
__device__ __forceinline__ float bf_lo(unsigned w) { return __builtin_bit_cast(float, w << 16); }
__device__ __forceinline__ float bf_hi(unsigned w) { return __builtin_bit_cast(float, w & 0xffff0000u); }
__device__ __forceinline__ float wave_sum_shfl(float v) {
#pragma unroll
    for (int o = 1; o < 64; o <<= 1) v += __shfl_xor(v, o);
    return v;
}
__device__ __forceinline__ float dpp_f(float v, const int ctrl_sel) {
    int x = __builtin_bit_cast(int, v), r;
    if (ctrl_sel == 0) r = __builtin_amdgcn_update_dpp(0, x, 0xB1, 0xF, 0xF, true);
    else if (ctrl_sel == 1) r = __builtin_amdgcn_update_dpp(0, x, 0x4E, 0xF, 0xF, true);
    else if (ctrl_sel == 2) r = __builtin_amdgcn_update_dpp(0, x, 0x141, 0xF, 0xF, true);
    else r = __builtin_amdgcn_update_dpp(0, x, 0x140, 0xF, 0xF, true);
    return __builtin_bit_cast(float, r);
}
__device__ __forceinline__ float sum8(float v) { v += dpp_f(v, 0); v += dpp_f(v, 1); v += dpp_f(v, 2); return v; }
__device__ __forceinline__ float sum16(float v) { v = sum8(v); v += dpp_f(v, 3); return v; }
__device__ __forceinline__ float wave_sum(float v) { v = sum16(v);
    v += __builtin_bit_cast(float, __builtin_amdgcn_update_dpp(0, __builtin_bit_cast(int, v), 0x142, 0xF, 0xF, true));
    v += __builtin_bit_cast(float, __builtin_amdgcn_update_dpp(0, __builtin_bit_cast(int, v), 0x143, 0xF, 0xF, true));
    return __builtin_bit_cast(float, __builtin_amdgcn_readlane(__builtin_bit_cast(int, v), 63)); }
__device__ __forceinline__ float fast_sigmoid(float x) { return __builtin_amdgcn_rcpf(1.0f + __builtin_amdgcn_exp2f(-1.44269504f * x)); }
__device__ __forceinline__ float fast_tanh(float x) { return 1.0f - 2.0f * __builtin_amdgcn_rcpf(1.0f + __builtin_amdgcn_exp2f(2.88539008f * x)); }

__device__ __forceinline__ unsigned pin_u32(unsigned x) { asm volatile("" : "+v"(x)); return x; }
__device__ __forceinline__ int opaque_tid() { int t = threadIdx.x; asm volatile("" : "+v"(t)); return t; }
template <class P> __device__ __forceinline__ P* opaque_ptr(P* p) { asm volatile("" : "+s"(p)); return p; }
__device__ __forceinline__ void lds_barrier() { asm volatile("s_waitcnt lgkmcnt(0)" ::: "memory"); __builtin_amdgcn_s_barrier(); asm volatile("" ::: "memory"); }
#define XB_TMO      128
#define XB_XCNT(j)  (256  + 64 * (j))
#define XB_XSUB(j)  (1280 + 64 * (j))
#define XB_XGEN(j)  (2304 + 64 * (j))
#define XB_TOP      3328
#define XB_TOPGEN   3392
#define XCD_BAR_WORDS 3456
#define XB_SPIN_CAP (1u << 22)
__device__ __forceinline__ unsigned xb_ld(unsigned* p)              { return __hip_atomic_load(p, __ATOMIC_RELAXED, __HIP_MEMORY_SCOPE_AGENT); }
__device__ __forceinline__ unsigned xb_add(unsigned* p, unsigned v) { return __hip_atomic_fetch_add(p, v, __ATOMIC_RELAXED, __HIP_MEMORY_SCOPE_AGENT); }
__device__ __forceinline__ unsigned xb_xcc_id() { return (unsigned)__builtin_amdgcn_s_getreg((3 << 11) | 20) & 0xFu; }
#define XB_SPIN(cond, bar) do { unsigned _sp = 0; while (cond) { __builtin_amdgcn_s_sleep(1); \
    if ((++_sp & 255u) == 0u) { if (xb_ld(&(bar)[XB_TMO])) break; if (_sp > XB_SPIN_CAP) { atomicAdd(&(bar)[XB_TMO], 1u); break; } } } } while (0)
struct XcdBarrier { unsigned* bar; unsigned x; volatile LAS unsigned* st; };
__device__ __forceinline__ XcdBarrier xcd_barrier_post(unsigned* bar, volatile LAS unsigned* st) {
    XcdBarrier b; b.bar = bar; b.x = xb_xcc_id(); b.st = st;
    if (threadIdx.x == 0) (void)xb_add(&bar[XB_XCNT(b.x)], 1u);
    return b;
}
__device__ __forceinline__ void xcd_barrier_complete(unsigned* bar, unsigned x, unsigned& nloc, unsigned& nx) {
    const unsigned G = gridDim.x * gridDim.y * gridDim.z;
    unsigned sum, cnt, mine, sp = 0u;
    for (;;) {
        sum = 0u; cnt = 0u; mine = 0u;
#pragma unroll
        for (unsigned j = 0; j < 16; ++j) { const unsigned c = xb_ld(&bar[XB_XCNT(j)]); sum += c; cnt += (c > 0u) ? 1u : 0u; mine = (j == x) ? c : mine; }
        if (sum == G) break;
        __builtin_amdgcn_s_sleep(1);
        if ((++sp & 255u) == 0u) { if (xb_ld(&bar[XB_TMO])) break; if (sp > XB_SPIN_CAP) { atomicAdd(&bar[XB_TMO], 1u); break; } }
    }
    nloc = mine > 0u ? mine : 1u; nx = cnt > 0u ? cnt : 1u;
}
__device__ __forceinline__ void xcd_barrier(const XcdBarrier& b) {
    asm volatile("s_waitcnt vmcnt(0)" ::: "memory");
    __syncthreads();
    if (threadIdx.x == 0) {
        unsigned* bar = b.bar;
        __builtin_amdgcn_s_waitcnt(0);
        unsigned nloc = b.st[0], nx = b.st[1];
        if (nloc == 0u) { xcd_barrier_complete(bar, b.x, nloc, nx); b.st[0] = nloc; b.st[1] = nx; }
        const unsigned old = xb_add(&bar[XB_XSUB(b.x)], 1u);
        const unsigned gen = old / nloc;
        if (old + 1u == (gen + 1u) * nloc) {
            __builtin_amdgcn_fence(__ATOMIC_RELEASE, "agent");
            asm volatile("s_waitcnt vmcnt(0)" ::: "memory");
            const unsigned og = xb_add(&bar[XB_TOP], 1u);
            const unsigned tg = og / nx;
            if (og + 1u == (tg + 1u) * nx) xb_add(&bar[XB_TOPGEN], 1u);
            else XB_SPIN(xb_ld(&bar[XB_TOPGEN]) == tg, bar);
            __builtin_amdgcn_fence(__ATOMIC_ACQUIRE, "agent");
            xb_add(&bar[XB_XGEN(b.x)], 1u);
            asm volatile("s_waitcnt vmcnt(0)" ::: "memory");
        } else {
            XB_SPIN(xb_ld(&bar[XB_XGEN(b.x)]) == gen, bar);
            __builtin_amdgcn_fence(__ATOMIC_ACQUIRE, "agent");
            asm volatile("s_waitcnt vmcnt(0)" ::: "memory");
        }
    }
    __syncthreads();
}

namespace pg8 {
constexpr int BM = 256, BK = 64, HALF = 128, HTB = HALF * BK * 2, STAGE_BYTES = 8 * HTB, NXCD = 8, WGM = 8;
__host__ __device__ __forceinline__ int lds_byte(int r, int c) { const int st = (r >> 4) * 2 + (c >> 5), rr = r & 15, cc = c & 31, ob = rr * 64 + cc * 2; return st * 1024 + (ob ^ (((ob >> 9) & 1) << 5)); }
__host__ __device__ __forceinline__ void stage_rc(int b, int& R, int& C) { const int st = b / 1024, sb = b % 1024, swz = sb ^ (((sb >> 9) & 1) << 5); R = (st >> 1) * 16 + swz / 64; C = (st & 1) * 32 + (swz % 64) / 2; }
__host__ __device__ __forceinline__ int perm32(int rho) { const int n = rho >> 4, i = rho & 15; return 8 * (i >> 2) + 4 * n + (i & 3); }

struct Unit { int pm, pn; };
struct Gemm { const bf16_t* A; const bf16_t* Bt; int lda, ldb, K; };

struct OrderCore {
    int nM, nN, nwg, G, c;
    __device__ __forceinline__ void init(int nM_, int nN_, int G_, int c_) { nM = nM_; nN = nN_; nwg = nM * nN; G = G_; c = c_; }
    __device__ __forceinline__ bool map(int i, int& pm, int& pn) const { const long L = (long)i * G + c; if (c < 0 || L >= nwg) return false; return map_lin(L, pm, pn); }
    __device__ __forceinline__ bool map_lin(long L, int& pm, int& pn) const {
        int wgid = (int)L; { const int q = nwg / NXCD, r = nwg % NXCD, xcd = wgid % NXCD, off = wgid / NXCD; wgid = (xcd < r ? xcd * (q + 1) : r * (q + 1) + (xcd - r) * q) + off; }
        const int nig = WGM * nN, gid = wgid / nig, fm = gid * WGM, gsz = (nM - fm) < WGM ? (nM - fm) : WGM;
        pm = fm + ((wgid % nig) % gsz); pn = (wgid % nig) / gsz; return true;
    }
    __device__ __forceinline__ void a_ready(const Unit&) const {}
    __device__ __forceinline__ void done(const Unit&) const {}
};

template <class Epi, class Sched, bool ALIGN_EPI = true, bool SP2 = true>
__device__ __forceinline__ void gemm_phase(LAS unsigned char* lds, const Gemm g, const Sched& S, const Epi& E) {
    const int tid = opaque_tid(), wid = __builtin_amdgcn_readfirstlane(tid >> 6), lane = tid & 63, wr = wid >> 2, wc = wid & 3, fr = lane & 15, fq = lane >> 4;
    const int K = g.K, nt = K / BK;
    unsigned voffA[2], voffB[2];
#pragma unroll
    for (int i = 0; i < 2; ++i) { int R, C; stage_rc(tid * 16 + i * 8192, R, C); const int Rb = Epi::PERM ? ((R & ~31) + perm32(R & 31)) : R;
        voffA[i] = (unsigned)(R * g.lda + C) * 2u; voffB[i] = (unsigned)(Rb * g.ldb + C) * 2u; }
    const size_t kstep = (size_t)(BK * 2);
    const size_t hstepA = (size_t)HALF * g.lda * 2, hstepB = (size_t)HALF * g.ldb * 2;
    const unsigned ldsw = (unsigned)wid * 1024u;
    const int aoff = lds_byte(wr * 64 + fr, fq * 8), boff = lds_byte(wc * 32 + fr, fq * 8);
#define PG8_SA(b, h) (((b) * 2 + (h)) * HTB)
#define PG8_SB(b, h) ((4 + (b) * 2 + (h)) * HTB)
#define PG8_STAGE(bufoff, gbase, voff) do { _Pragma("unroll") for (int _i = 0; _i < 2; ++_i) \
        __builtin_amdgcn_global_load_lds((const unsigned*)((const char*)(gbase) + (voff)[_i]), (LAS unsigned*)(lds + (bufoff) + ldsw + _i * 8192), 16, 0, 0); } while (0)
#define PG8_LDA(dst, b, h) do { _Pragma("unroll") for (int m = 0; m < 4; ++m) _Pragma("unroll") for (int k = 0; k < 2; ++k) dst[m][k] = *(const LAS bf16x8*)(lds + PG8_SA(b, h) + aoff + m * 2048 + k * 1024); } while (0)
#define PG8_LDB(dst, b, h) do { _Pragma("unroll") for (int n = 0; n < 2; ++n) _Pragma("unroll") for (int k = 0; k < 2; ++k) dst[n][k] = *(const LAS bf16x8*)(lds + PG8_SB(b, h) + boff + n * 2048 + k * 1024); } while (0)
#define PG8_MMA(ai, bj, At, Bt) do { __builtin_amdgcn_s_setprio(1); _Pragma("unroll") for (int m = 0; m < 4; ++m) _Pragma("unroll") for (int n = 0; n < 2; ++n) _Pragma("unroll") for (int k = 0; k < 2; ++k) \
        acc[ai][bj][m][n] = __builtin_amdgcn_mfma_f32_16x16x32_bf16(Bt[n][k], At[m][k], acc[ai][bj][m][n], 0, 0, 0); __builtin_amdgcn_s_setprio(0); } while (0)
#define PG8_WAIT_V(n) asm volatile("s_waitcnt vmcnt(" #n ")" ::: "memory")
#define PG8_WAIT_L(n) asm volatile("s_waitcnt lgkmcnt(" #n ")" ::: "memory")
#define PG8_BAR __builtin_amdgcn_s_barrier()
#define PG8_SCHED __builtin_amdgcn_sched_barrier(0)
    __builtin_amdgcn_sched_barrier(0);
    Unit cur, nxt; int ui = 0;
    if (!S.next(0, cur)) return;
    f32x4 acc[2][2][4][2];
#pragma unroll
    for (int a = 0; a < 2; ++a)
#pragma unroll
        for (int b = 0; b < 2; ++b)
#pragma unroll
            for (int m = 0; m < 4; ++m)
#pragma unroll
                for (int n = 0; n < 2; ++n) acc[a][b][m][n] = (f32x4){0.f, 0.f, 0.f, 0.f};
    bf16x8 At[4][2], B0[2][2], B1[2][2];
    const char* cA; const char* cB; { long long ao, bo; S.offs(cur, ao, bo); cA = (const char*)g.A + ao; cB = (const char*)g.Bt + bo; }
    S.a_ready(cur);
    if constexpr (SP2) {
        PG8_STAGE(PG8_SB(0, 0), cB, voffB); PG8_STAGE(PG8_SB(0, 1), cB + hstepB, voffB); PG8_STAGE(PG8_SA(0, 0), cA, voffA); PG8_STAGE(PG8_SA(0, 1), cA + hstepA, voffA);
        if (wr == 1) PG8_BAR;
        PG8_WAIT_V(2); PG8_BAR;
        PG8_STAGE(PG8_SB(1, 0), cB + kstep, voffB); PG8_STAGE(PG8_SA(1, 0), cA + kstep, voffA); PG8_STAGE(PG8_SB(1, 1), cB + hstepB + kstep, voffB);
        PG8_WAIT_V(6); PG8_BAR;
    } else {
        PG8_STAGE(PG8_SB(0, 0), cB, voffB); PG8_STAGE(PG8_SA(0, 0), cA, voffA); PG8_STAGE(PG8_SB(0, 1), cB + hstepB, voffB); PG8_STAGE(PG8_SA(0, 1), cA + hstepA, voffA);
        if (wr == 1) PG8_BAR;
        PG8_WAIT_V(4); PG8_BAR;
        PG8_STAGE(PG8_SB(1, 0), cB + kstep, voffB); PG8_STAGE(PG8_SA(1, 0), cA + kstep, voffA); PG8_STAGE(PG8_SB(1, 1), cB + hstepB + kstep, voffB);
        PG8_WAIT_V(6); PG8_BAR;
    }
    for (;;) {
        const bool has_next = S.next(ui + 1, nxt);
        const char* nA = cA; const char* nB = cB; if (has_next) { long long ao, bo; S.offs(nxt, ao, bo); nA = (const char*)g.A + ao; nB = (const char*)g.Bt + bo; }
#pragma nounroll
        for (int t = 0; t < nt; t += 2) {
            const bool last = (t == nt - 2);
            const char* a1 = cA + (size_t)(t + 1) * kstep;
            const char* a2 = last ? nA : cA + (size_t)(t + 2) * kstep; const char* b2 = last ? nB : cB + (size_t)(t + 2) * kstep;
            const char* a3 = a2 + kstep; const char* b3 = b2 + kstep;
            if (last && has_next) S.a_ready(nxt);
            if constexpr (SP2) {
            PG8_LDB(B0, 0, 0); PG8_LDB(B1, 0, 1); PG8_SCHED; PG8_LDA(At, 0, 0); PG8_STAGE(PG8_SA(1, 1), a1 + hstepA, voffA);
            PG8_WAIT_V(8); PG8_WAIT_L(0); PG8_BAR; PG8_MMA(0, 0, At, B0); PG8_MMA(0, 1, At, B1); PG8_BAR; PG8_SCHED;
            PG8_LDA(At, 0, 1); PG8_STAGE(PG8_SB(0, 0), b2, voffB); PG8_STAGE(PG8_SB(0, 1), b2 + hstepB, voffB); PG8_STAGE(PG8_SA(0, 0), a2, voffA);
            PG8_WAIT_V(8); PG8_WAIT_L(0); PG8_BAR; PG8_MMA(1, 0, At, B0); PG8_MMA(1, 1, At, B1); PG8_BAR; PG8_SCHED;
            PG8_LDB(B0, 1, 0); PG8_LDB(B1, 1, 1); PG8_SCHED; PG8_LDA(At, 1, 0); PG8_STAGE(PG8_SA(0, 1), a2 + hstepA, voffA);
            PG8_WAIT_V(8); PG8_WAIT_L(0); PG8_BAR; PG8_MMA(0, 0, At, B0); PG8_MMA(0, 1, At, B1); PG8_BAR; PG8_SCHED;
            PG8_LDA(At, 1, 1); PG8_STAGE(PG8_SB(1, 0), b3, voffB); PG8_STAGE(PG8_SB(1, 1), b3 + hstepB, voffB); PG8_STAGE(PG8_SA(1, 0), a3, voffA);
            PG8_WAIT_V(8); PG8_WAIT_L(0); PG8_BAR; PG8_MMA(1, 0, At, B0); PG8_MMA(1, 1, At, B1); PG8_BAR; PG8_SCHED;
            } else {
            PG8_LDB(B0, 0, 0); PG8_SCHED; PG8_LDA(At, 0, 0); PG8_STAGE(PG8_SA(1, 1), a1 + hstepA, voffA);
            PG8_WAIT_L(8); PG8_BAR; PG8_WAIT_L(0); PG8_MMA(0, 0, At, B0); PG8_BAR; PG8_SCHED;
            PG8_LDB(B1, 0, 1); PG8_STAGE(PG8_SB(0, 0), b2, voffB);
            PG8_BAR; PG8_WAIT_L(0); PG8_MMA(0, 1, At, B1); PG8_BAR;
            PG8_LDA(At, 0, 1); PG8_STAGE(PG8_SA(0, 0), a2, voffA);
            PG8_BAR; PG8_WAIT_L(0); PG8_MMA(1, 0, At, B0); PG8_BAR; PG8_SCHED;
            PG8_STAGE(PG8_SB(0, 1), b2 + hstepB, voffB);
            PG8_WAIT_V(6); PG8_BAR; PG8_MMA(1, 1, At, B1); PG8_BAR;
            PG8_LDB(B0, 1, 0); PG8_SCHED; PG8_LDA(At, 1, 0); PG8_STAGE(PG8_SA(0, 1), a2 + hstepA, voffA);
            PG8_WAIT_L(8); PG8_BAR; PG8_WAIT_L(0); PG8_MMA(0, 0, At, B0); PG8_BAR; PG8_SCHED;
            PG8_LDB(B1, 1, 1); PG8_STAGE(PG8_SB(1, 0), b3, voffB);
            PG8_BAR; PG8_WAIT_L(0); PG8_MMA(0, 1, At, B1); PG8_BAR;
            PG8_LDA(At, 1, 1); PG8_STAGE(PG8_SA(1, 0), a3, voffA);
            PG8_BAR; PG8_WAIT_L(0); PG8_MMA(1, 0, At, B0); PG8_BAR; PG8_SCHED;
            PG8_STAGE(PG8_SB(1, 1), b3 + hstepB, voffB);
            PG8_WAIT_V(6); PG8_BAR; PG8_MMA(1, 1, At, B1); PG8_BAR;
            }
        }
        if constexpr (ALIGN_EPI) { if (wr == 0) PG8_BAR; }
        E(acc, cur, wr, wc, fr, fq, lds);
        if (!has_next) break;
#pragma unroll
        for (int a = 0; a < 2; ++a)
#pragma unroll
            for (int b = 0; b < 2; ++b)
#pragma unroll
                for (int m = 0; m < 4; ++m)
#pragma unroll
                    for (int n = 0; n < 2; ++n) acc[a][b][m][n] = (f32x4){0.f, 0.f, 0.f, 0.f};
        cur = nxt; cA = nA; cB = nB; ++ui;
        if constexpr (ALIGN_EPI) { if (wr == 1) PG8_BAR; }
    }
    PG8_WAIT_V(0);
    if constexpr (!ALIGN_EPI) { if (wr == 0) PG8_BAR; }
    PG8_BAR;
    PG8_SCHED;
#undef PG8_SA
#undef PG8_SB
#undef PG8_STAGE
#undef PG8_LDA
#undef PG8_LDB
#undef PG8_MMA
#undef PG8_WAIT_V
#undef PG8_WAIT_L
#undef PG8_BAR
#undef PG8_SCHED
}

template <class Epi, class Sched>
__device__ __forceinline__ void gemm_phase_gather(LAS unsigned char* lds, const Gemm g, const Sched& S, const Epi& E, const int* tok) {
    const int tid = opaque_tid(), wid = __builtin_amdgcn_readfirstlane(tid >> 6), lane = tid & 63, wr = wid >> 2, wc = wid & 3, fr = lane & 15, fq = lane >> 4;
    const int K = g.K, nt = K / BK;
    unsigned voffB[2]; int rA[2], cA2[2];
#pragma unroll
    for (int i = 0; i < 2; ++i) { int R, C; stage_rc(tid * 16 + i * 8192, R, C); const int Rb = Epi::PERM ? ((R & ~31) + perm32(R & 31)) : R; rA[i] = R; cA2[i] = C * 2; voffB[i] = (unsigned)(Rb * g.ldb + C) * 2u; }
    const size_t kstep = (size_t)(BK * 2); const size_t hstepB = (size_t)HALF * g.ldb * 2;
    const unsigned ldsw = (unsigned)wid * 1024u;
    const int aoff = lds_byte(wr * 64 + fr, fq * 8), boff = lds_byte(wc * 32 + fr, fq * 8);
#define PG8_SA(b, h) (((b) * 2 + (h)) * HTB)
#define PG8_SB(b, h) ((4 + (b) * 2 + (h)) * HTB)
#define PG8_STAGE(bufoff, gbase, voff) do { _Pragma("unroll") for (int _i = 0; _i < 2; ++_i) \
        __builtin_amdgcn_global_load_lds((const unsigned*)((const char*)(gbase) + (voff)[_i]), (LAS unsigned*)(lds + (bufoff) + ldsw + _i * 8192), 16, 0, 0); } while (0)
#define PG8_STAGEA(bufoff, go_, kb_) do { _Pragma("unroll") for (int _i = 0; _i < 2; ++_i) \
        __builtin_amdgcn_global_load_lds((const unsigned*)((const char*)g.A + (go_)[_i] + (kb_)), (LAS unsigned*)(lds + (bufoff) + ldsw + _i * 8192), 16, 0, 0); } while (0)
#define PG8_LDA(dst, b, h) do { _Pragma("unroll") for (int m = 0; m < 4; ++m) _Pragma("unroll") for (int k = 0; k < 2; ++k) dst[m][k] = *(const LAS bf16x8*)(lds + PG8_SA(b, h) + aoff + m * 2048 + k * 1024); } while (0)
#define PG8_LDB(dst, b, h) do { _Pragma("unroll") for (int n = 0; n < 2; ++n) _Pragma("unroll") for (int k = 0; k < 2; ++k) dst[n][k] = *(const LAS bf16x8*)(lds + PG8_SB(b, h) + boff + n * 2048 + k * 1024); } while (0)
#define PG8_MMA(ai, bj, At, Bt) do { __builtin_amdgcn_s_setprio(1); _Pragma("unroll") for (int m = 0; m < 4; ++m) _Pragma("unroll") for (int n = 0; n < 2; ++n) _Pragma("unroll") for (int k = 0; k < 2; ++k) \
        acc[ai][bj][m][n] = __builtin_amdgcn_mfma_f32_16x16x32_bf16(Bt[n][k], At[m][k], acc[ai][bj][m][n], 0, 0, 0); __builtin_amdgcn_s_setprio(0); } while (0)
#define PG8_WAIT_V(n) asm volatile("s_waitcnt vmcnt(" #n ")" ::: "memory")
#define PG8_WAIT_L(n) asm volatile("s_waitcnt lgkmcnt(" #n ")" ::: "memory")
#define PG8_BAR __builtin_amdgcn_s_barrier()
#define PG8_SCHED __builtin_amdgcn_sched_barrier(0)
#define PG8_GOFF(dst, u_) do { _Pragma("unroll") for (int _h = 0; _h < 2; ++_h) _Pragma("unroll") for (int _i = 0; _i < 2; ++_i) \
        dst[_h][_i] = (unsigned)tok[(u_).pm * 256 + _h * 128 + rA[_i]] * (unsigned)(g.lda * 2) + (unsigned)cA2[_i]; } while (0)
    __builtin_amdgcn_sched_barrier(0);
    Unit cur, nxt; int ui = 0;
    if (!S.next(0, cur)) return;
    f32x4 acc[2][2][4][2];
#pragma unroll
    for (int a = 0; a < 2; ++a)
#pragma unroll
        for (int b = 0; b < 2; ++b)
#pragma unroll
            for (int m = 0; m < 4; ++m)
#pragma unroll
                for (int n = 0; n < 2; ++n) acc[a][b][m][n] = (f32x4){0.f, 0.f, 0.f, 0.f};
    bf16x8 At[4][2], B0[2][2], B1[2][2];
    unsigned goC[2][2], goN[2][2];
    PG8_GOFF(goC, cur);
    const char* cB; { long long ao, bo; S.offs(cur, ao, bo); cB = (const char*)g.Bt + bo; }
    PG8_STAGE(PG8_SB(0, 0), cB, voffB); PG8_STAGE(PG8_SB(0, 1), cB + hstepB, voffB); PG8_STAGEA(PG8_SA(0, 0), goC[0], 0); PG8_STAGEA(PG8_SA(0, 1), goC[1], 0);
    if (wr == 1) PG8_BAR;
    PG8_WAIT_V(2); PG8_BAR;
    PG8_STAGE(PG8_SB(1, 0), cB + kstep, voffB); PG8_STAGEA(PG8_SA(1, 0), goC[0], kstep); PG8_STAGE(PG8_SB(1, 1), cB + hstepB + kstep, voffB);
    PG8_WAIT_V(6); PG8_BAR;
    for (;;) {
        const bool has_next = S.next(ui + 1, nxt);
        const char* nB = cB; if (has_next) { long long ao, bo; S.offs(nxt, ao, bo); nB = (const char*)g.Bt + bo; PG8_GOFF(goN, nxt); }
        else {
#pragma unroll
            for (int _h = 0; _h < 2; ++_h)
#pragma unroll
                for (int _i = 0; _i < 2; ++_i) goN[_h][_i] = goC[_h][_i]; }
#pragma nounroll
        for (int t = 0; t < nt; t += 2) {
            const bool last = (t == nt - 2);
            const size_t k1 = (size_t)(t + 1) * kstep, k2 = last ? 0 : (size_t)(t + 2) * kstep, k3 = k2 + kstep;
            const char* b2 = last ? nB : cB + (size_t)(t + 2) * kstep; const char* b3 = b2 + kstep;
            unsigned g2[2][2];
#pragma unroll
            for (int _h = 0; _h < 2; ++_h)
#pragma unroll
                for (int _i = 0; _i < 2; ++_i) g2[_h][_i] = last ? goN[_h][_i] : goC[_h][_i];
            PG8_LDB(B0, 0, 0); PG8_LDB(B1, 0, 1); PG8_SCHED; PG8_LDA(At, 0, 0); PG8_STAGEA(PG8_SA(1, 1), goC[1], k1);
            PG8_WAIT_V(8); PG8_WAIT_L(0); PG8_BAR; PG8_MMA(0, 0, At, B0); PG8_MMA(0, 1, At, B1); PG8_BAR; PG8_SCHED;
            PG8_LDA(At, 0, 1); PG8_STAGE(PG8_SB(0, 0), b2, voffB); PG8_STAGE(PG8_SB(0, 1), b2 + hstepB, voffB); PG8_STAGEA(PG8_SA(0, 0), g2[0], k2);
            PG8_WAIT_V(8); PG8_WAIT_L(0); PG8_BAR; PG8_MMA(1, 0, At, B0); PG8_MMA(1, 1, At, B1); PG8_BAR; PG8_SCHED;
            PG8_LDB(B0, 1, 0); PG8_LDB(B1, 1, 1); PG8_SCHED; PG8_LDA(At, 1, 0); PG8_STAGEA(PG8_SA(0, 1), g2[1], k2);
            PG8_WAIT_V(8); PG8_WAIT_L(0); PG8_BAR; PG8_MMA(0, 0, At, B0); PG8_MMA(0, 1, At, B1); PG8_BAR; PG8_SCHED;
            PG8_LDA(At, 1, 1); PG8_STAGE(PG8_SB(1, 0), b3, voffB); PG8_STAGE(PG8_SB(1, 1), b3 + hstepB, voffB); PG8_STAGEA(PG8_SA(1, 0), g2[0], k3);
            PG8_WAIT_V(8); PG8_WAIT_L(0); PG8_BAR; PG8_MMA(1, 0, At, B0); PG8_MMA(1, 1, At, B1); PG8_BAR; PG8_SCHED;
        }
        if (wr == 0) PG8_BAR;
        E(acc, cur, wr, wc, fr, fq, lds);
        if (!has_next) break;
#pragma unroll
        for (int a = 0; a < 2; ++a)
#pragma unroll
            for (int b = 0; b < 2; ++b)
#pragma unroll
                for (int m = 0; m < 4; ++m)
#pragma unroll
                    for (int n = 0; n < 2; ++n) acc[a][b][m][n] = (f32x4){0.f, 0.f, 0.f, 0.f};
        cur = nxt; cB = nB; ++ui;
#pragma unroll
        for (int _h = 0; _h < 2; ++_h)
#pragma unroll
            for (int _i = 0; _i < 2; ++_i) goC[_h][_i] = goN[_h][_i];
        if (wr == 1) PG8_BAR;
    }
    PG8_WAIT_V(0);
    PG8_BAR;
    PG8_SCHED;
#undef PG8_SA
#undef PG8_SB
#undef PG8_STAGE
#undef PG8_STAGEA
#undef PG8_LDA
#undef PG8_LDB
#undef PG8_MMA
#undef PG8_WAIT_V
#undef PG8_WAIT_L
#undef PG8_BAR
#undef PG8_SCHED
#undef PG8_GOFF
}
}
using pg8::Unit;
typedef const f32x4 (&AccRef)[2][2][4][2];

struct SchedPlain : pg8::OrderCore {
    long long astr, bstr;
    __device__ __forceinline__ bool next(int i, Unit& u) const { return map(i, u.pm, u.pn); }
    __device__ __forceinline__ void offs(const Unit& u, long long& ao, long long& bo) const { ao = (long long)u.pm * astr; bo = (long long)u.pn * bstr; }
};
struct SchedRange : pg8::OrderCore {
    long long astr, bstr; int base, count;
    __device__ __forceinline__ bool next(int i, Unit& u) const { const long L = (long)i * G + c; if (c < 0 || L >= count) return false; return map_lin(base + L, u.pm, u.pn); }
    __device__ __forceinline__ void offs(const Unit& u, long long& ao, long long& bo) const { ao = (long long)u.pm * astr; bo = (long long)u.pn * bstr; }
};
struct SchedHP : pg8::OrderCore {
    __device__ __forceinline__ bool next(int i, Unit& u) const { return map(i, u.pm, u.pn); }
    __device__ __forceinline__ void offs(const Unit& u, long long& ao, long long& bo) const {
        ao = ((long long)(u.pm >> 5) * (S + 1) + (long long)(u.pm & 31) * 256) * (D * 2); bo = (long long)u.pn * 256 * (2 * D) * 2; }
};
struct SchedRKV : pg8::OrderCore {
    long long aoff0, aoff1;
    __device__ __forceinline__ bool next(int i, Unit& u) const { return map(i, u.pm, u.pn); }
    __device__ __forceinline__ void offs(const Unit& u, long long& ao, long long& bo) const {
        const int t = u.pn >> 2; long long base = aoff1 + (long long)(t - 1) * ((long long)T * D * 2); if (t == 0) base = aoff0; ao = base + (long long)u.pm * 256 * D * 2; bo = (long long)u.pn * 256 * D * 2; }
};
struct SchedMoE : pg8::OrderCore {
    const int* tile_expert; int mode;
    __device__ __forceinline__ bool next(int i, Unit& u) const { return map(i, u.pm, u.pn); }
    __device__ __forceinline__ void offs(const Unit& u, long long& ao, long long& bo) const {
        const int e = tile_expert[u.pm];
        if (mode == 0) { ao = (long long)u.pm * 256 * D * 2; bo = ((long long)e * 512 + u.pn * 256) * D * 2; }
        else { ao = (long long)u.pm * 256 * 256 * 2; bo = ((long long)e * 1024 + u.pn * 256) * 256 * 2; } }
};

__device__ __forceinline__ u32x4 pack8v4(const f32x4 v0, const f32x4 v1) { u32x4 w; w.x = cvt_pk_c(v0[0], v0[1]); w.y = cvt_pk_c(v0[2], v0[3]); w.z = cvt_pk_c(v1[0], v1[1]); w.w = cvt_pk_c(v1[2], v1[3]); return w; }
__device__ __forceinline__ u32x4 pack8(const f32x4 v0, const f32x4 v1) { u32x4 w; w.x = cvt_pk_c(v0[0], v0[1]); w.y = cvt_pk_c(v0[2], v0[3]); w.z = cvt_pk_c(v1[0], v1[1]); w.w = cvt_pk_c(v1[2], v1[3]); return w; }

struct EpiCat {
    static constexpr bool PERM = true;
    bf16_t *R, *L; long long tstride; int pn_off;
    __device__ __forceinline__ void operator()(AccRef acc, const Unit& u, int wr, int wc, int fr, int fq, LAS unsigned char*) const {
        const int row0 = u.pm * 256 + wr * 64 + fr; const int pn = u.pn + pn_off;
        if (pn < 12) {
            const int t = pn >> 2; bf16_t* base = R + (long long)t * tstride; const int col0 = (pn & 3) * 256 + wc * 32 + 8 * fq;
#pragma unroll
            for (int ai = 0; ai < 2; ++ai)
#pragma unroll
                for (int m = 0; m < 4; ++m) { bf16_t* rowp = base + (size_t)(row0 + ai * 128 + m * 16) * D + col0;
#pragma unroll
                    for (int bj = 0; bj < 2; ++bj) *(u32x4*)(rowp + bj * 128) = pack8(acc[ai][bj][m][0], acc[ai][bj][m][1]); }
        } else {
            const int ct = wc * 32 + 8 * fq, lcol0 = (pn - 12) * 256 + ct;
#pragma unroll
            for (int ai = 0; ai < 2; ++ai)
#pragma unroll
                for (int m = 0; m < 4; ++m) { bf16_t* rowp = L + (size_t)(row0 + ai * 128 + m * 16) * 512 + lcol0;
#pragma unroll
                    for (int bj = 0; bj < 2; ++bj) { f32x4 v0 = acc[ai][bj][m][0], v1 = acc[ai][bj][m][1];
                        const int mode = (pn == 13) ? 2 : ((ct + bj * 128) < 64 ? 1 : 0);
                        if (mode == 1) {
#pragma unroll
                            for (int j = 0; j < 4; ++j) { v0[j] = fast_tanh(v0[j]); v1[j] = fast_tanh(v1[j]); } }
                        else if (mode == 2) {
#pragma unroll
                            for (int j = 0; j < 4; ++j) { v0[j] = fast_sigmoid(v0[j]); v1[j] = fast_sigmoid(v1[j]); } }
                        *(u32x4*)(rowp + bj * 128) = pack8(v0, v1); } }
        }
    }
};
struct EpiAct {
    static constexpr bool PERM = true;
    bf16_t* O0; long long ostride; const float* bias0; long long bstride; float sc0, dsc;
    __device__ __forceinline__ void operator()(AccRef acc, const Unit& u, int wr, int wc, int fr, int fq, LAS unsigned char*) const {
        const int t = u.pn >> 2; const int row0 = u.pm * 256 + wr * 64 + fr, col0 = (u.pn & 3) * 256 + wc * 32 + 8 * fq;
        bf16_t* base = O0 + (long long)t * ostride; const float* bs = bias0 + (long long)t * bstride;
        f32x4 bv[2][2];
#pragma unroll
        for (int bj = 0; bj < 2; ++bj)
#pragma unroll
            for (int n = 0; n < 2; ++n) bv[bj][n] = bias0 ? *(const f32x4*)(bs + col0 + bj * 128 + 4 * n) : (f32x4){0.f, 0.f, 0.f, 0.f};
#pragma unroll
        for (int ai = 0; ai < 2; ++ai)
#pragma unroll
            for (int m = 0; m < 4; ++m) { bf16_t* rowp = base + (size_t)(row0 + ai * 128 + m * 16) * D + col0;
#pragma unroll
                for (int bj = 0; bj < 2; ++bj) { f32x4 v0 = acc[ai][bj][m][0] + bv[bj][0], v1 = acc[ai][bj][m][1] + bv[bj][1];
                    if (bias0) { const float sc = sc0 + (float)t * dsc;
#pragma unroll
                        for (int j = 0; j < 4; ++j) { v0[j] = sc * fast_sigmoid(v0[j]); v1[j] = sc * fast_sigmoid(v1[j]); } }
                    *(u32x4*)(rowp + bj * 128) = pack8(v0, v1); } }
    }
};
struct EpiResid {
    static constexpr bool PERM = true;
    const float* resid_f32; bf16_t* xb; float* ssq; float bscale;
    __device__ __forceinline__ void operator()(AccRef acc, const Unit& u, int wr, int wc, int fr, int fq, LAS unsigned char*) const {
        const int row0 = u.pm * 256 + wr * 64 + fr, col0 = u.pn * 256 + wc * 32 + 8 * fq;
        if (resid_f32) {
#pragma unroll
            for (int bt = 0; bt < 4; ++bt) { f32x4 rr[2][2][2];
#pragma unroll
                for (int mm = 0; mm < 2; ++mm)
#pragma unroll
                    for (int bj = 0; bj < 2; ++bj) { const size_t off = (size_t)(row0 + (bt >> 1) * 128 + ((bt & 1) * 2 + mm) * 16) * D + col0 + bj * 128;
                        rr[mm][bj][0] = *(const f32x4*)(resid_f32 + off); rr[mm][bj][1] = *(const f32x4*)(resid_f32 + off + 4); }
                float s[2];
#pragma unroll
                for (int mm = 0; mm < 2; ++mm) { const int ai = bt >> 1, m = (bt & 1) * 2 + mm; const size_t off = (size_t)(row0 + ai * 128 + m * 16) * D + col0; s[mm] = 0.f;
#pragma unroll
                    for (int bj = 0; bj < 2; ++bj) { const f32x4 o0 = rr[mm][bj][0] + acc[ai][bj][m][0] * bscale, o1 = rr[mm][bj][1] + acc[ai][bj][m][1] * bscale;
                        *(u32x4*)(xb + off + bj * 128) = pack8(o0, o1);
                        s[mm] += ((o0[0] * o0[0] + o0[1] * o0[1]) + (o0[2] * o0[2] + o0[3] * o0[3])) + ((o1[0] * o1[0] + o1[1] * o1[1]) + (o1[2] * o1[2] + o1[3] * o1[3])); } }
#pragma unroll
                for (int mm = 0; mm < 2; ++mm) { s[mm] += __shfl_xor(s[mm], 16); s[mm] += __shfl_xor(s[mm], 32);
                    if (fq == 0) ssq[(size_t)(row0 + (bt >> 1) * 128 + ((bt & 1) * 2 + mm) * 16) * 16 + u.pn * 4 + wc] = s[mm]; }
                asm volatile("" ::: "memory"); }
        } else {
#pragma unroll
            for (int ai = 0; ai < 2; ++ai) { u32x4 rw[4][2];
#pragma unroll
                for (int m = 0; m < 4; ++m)
#pragma unroll
                    for (int bj = 0; bj < 2; ++bj) rw[m][bj] = *(const u32x4*)(xb + (size_t)(row0 + ai * 128 + m * 16) * D + col0 + bj * 128);
                float s[4];
#pragma unroll
                for (int m = 0; m < 4; ++m) { const size_t off = (size_t)(row0 + ai * 128 + m * 16) * D + col0; s[m] = 0.f;
#pragma unroll
                    for (int bj = 0; bj < 2; ++bj) { const u32x4 w = rw[m][bj];
                        const f32x4 r0 = (f32x4){bf_lo(w.x), bf_hi(w.x), bf_lo(w.y), bf_hi(w.y)}, r1 = (f32x4){bf_lo(w.z), bf_hi(w.z), bf_lo(w.w), bf_hi(w.w)};
                        const f32x4 o0 = r0 + acc[ai][bj][m][0] * bscale, o1 = r1 + acc[ai][bj][m][1] * bscale;
                        *(u32x4*)(xb + off + bj * 128) = pack8(o0, o1);
                        s[m] += ((o0[0] * o0[0] + o0[1] * o0[1]) + (o0[2] * o0[2] + o0[3] * o0[3])) + ((o1[0] * o1[0] + o1[1] * o1[1]) + (o1[2] * o1[2] + o1[3] * o1[3])); } }
#pragma unroll
                for (int m = 0; m < 4; ++m) { s[m] += __shfl_xor(s[m], 16); s[m] += __shfl_xor(s[m], 32);
                    if (fq == 0) ssq[(size_t)(row0 + ai * 128 + m * 16) * 16 + u.pn * 4 + wc] = s[m]; }
                asm volatile("" ::: "memory"); }
        }
    }
};
struct EpiRstd {
    static constexpr bool PERM = true;
    bf16_t* O0; long long tstride; const float* ssq;
    __device__ __forceinline__ void operator()(AccRef acc, const Unit& u, int wr, int wc, int fr, int fq, LAS unsigned char*) const {
        const int t = u.pn >> 2; bf16_t* base = O0 + (long long)t * tstride;
        const int row0 = u.pm * 256 + wr * 64 + fr, col0 = (u.pn & 3) * 256 + wc * 32 + 8 * fq;
#pragma unroll
        for (int ai = 0; ai < 2; ++ai)
#pragma unroll
            for (int m = 0; m < 4; ++m) { const int row = row0 + ai * 128 + m * 16; const f32x4* sp = (const f32x4*)(ssq + (size_t)row * 16);
                const f32x4 s4 = (sp[0] + sp[1]) + (sp[2] + sp[3]); const float rstd = __builtin_amdgcn_rsqf(((s4[0] + s4[1]) + (s4[2] + s4[3])) * (1.0f / D) + NORM_EPS);
                bf16_t* rowp = base + (size_t)row * D + col0;
#pragma unroll
                for (int bj = 0; bj < 2; ++bj) *(u32x4*)(rowp + bj * 128) = pack8(acc[ai][bj][m][0] * rstd, acc[ai][bj][m][1] * rstd); }
    }
};
struct EpiSwiGLU {
    static constexpr bool PERM = true;
    bf16_t* H; const float* slot_info;
    __device__ __forceinline__ void operator()(AccRef acc, const Unit& u, int wr, int wc, int fr, int fq, LAS unsigned char*) const {
        const int row0 = u.pm * 256 + wr * 64 + fr, col0 = u.pn * 128 + wc * 32 + 8 * fq;
#pragma unroll
        for (int ai = 0; ai < 2; ++ai)
#pragma unroll
            for (int m = 0; m < 4; ++m) { const int row = row0 + ai * 128 + m * 16; const float rstd = slot_info[(size_t)row * 2 + 1];
                f32x4 h0, h1;
#pragma unroll
                for (int j = 0; j < 4; ++j) { const float g0 = acc[ai][0][m][0][j] * rstd, g1 = acc[ai][0][m][1][j] * rstd;
                    h0[j] = g0 * fast_sigmoid(g0) * (acc[ai][1][m][0][j] * rstd); h1[j] = g1 * fast_sigmoid(g1) * (acc[ai][1][m][1][j] * rstd); }
                *(u32x4*)(H + (size_t)row * 256 + col0) = pack8(h0, h1); }
    }
};
struct EpiGate {
    static constexpr bool PERM = true;
    bf16_t* Y; const float* slot_info;
    __device__ __forceinline__ void operator()(AccRef acc, const Unit& u, int wr, int wc, int fr, int fq, LAS unsigned char*) const {
        const int row0 = u.pm * 256 + wr * 64 + fr, col0 = u.pn * 256 + wc * 32 + 8 * fq;
#pragma unroll
        for (int ai = 0; ai < 2; ++ai)
#pragma unroll
            for (int m = 0; m < 4; ++m) { const int row = row0 + ai * 128 + m * 16; const float gt = slot_info[(size_t)row * 2];
                bf16_t* rowp = Y + (size_t)row * D + col0;
#pragma unroll
                for (int bj = 0; bj < 2; ++bj) *(u32x4*)(rowp + bj * 128) = pack8(acc[ai][bj][m][0] * gt, acc[ai][bj][m][1] * gt); }
    }
};
struct EpiMemKV {
    static constexpr bool PERM = true;
    bf16_t* KM; bf16_t* VM;
    __device__ __forceinline__ void operator()(AccRef acc, const Unit& u, int wr, int wc, int fr, int fq, LAS unsigned char*) const {
        const int l = u.pm >> 3, prow0 = (u.pm & 7) * 256 + wr * 64 + fr, ct0 = u.pn * 256 + wc * 32 + 8 * fq;
#pragma unroll
        for (int ai = 0; ai < 2; ++ai)
#pragma unroll
            for (int m = 0; m < 4; ++m) { const int row = prow0 + ai * 128 + m * 16;
#pragma unroll
                for (int bj = 0; bj < 2; ++bj) { const int col = ct0 + bj * 128; bf16_t* dst = (col < 1024 ? KM : VM - 1024) + ((size_t)l * 2048 + row) * D + col;
                    *(u32x4*)dst = pack8(acc[ai][bj][m][0], acc[ai][bj][m][1]); } }
    }
};
struct SchedMemKV : pg8::OrderCore {
    __device__ __forceinline__ bool next(int i, Unit& u) const { return map(i, u.pm, u.pn); }
    __device__ __forceinline__ void offs(const Unit& u, long long& ao, long long& bo) const { ao = (long long)(u.pm & 7) * 256 * D * 2; bo = ((long long)(u.pm >> 3) * 2048 + u.pn * 256) * D * 2; }
};

struct SchedMemPre : pg8::OrderCore {
    int mode;
    __device__ __forceinline__ bool next(int i, Unit& u) const { return map(i, u.pm, u.pn); }
    __device__ __forceinline__ void offs(const Unit& u, long long& ao, long long& bo) const {
        const int lb = u.pm >> 2, q = u.pm & 3, l = lb >> 3;
        if (mode == 0) { ao = ((long long)lb * 256 * D + q * 256) * 2; bo = ((long long)l * D * D + (long long)u.pn * 256 * D + q * 256) * 2; }
        else { ao = ((long long)l * D * D + (long long)q * 256 * D + u.pn * 256) * 2; bo = ((long long)lb * 256 * D + u.pn * 256) * 2; } }
};
struct EpiMemPre {
    static constexpr bool PERM = true;
    bf16_t* O;
    __device__ __forceinline__ void operator()(AccRef acc, const Unit& u, int wr, int wc, int fr, int fq, LAS unsigned char*) const {
        const int row0 = (u.pm >> 2) * 1024 + (u.pm & 3) * 256 + wr * 64 + fr, col0 = u.pn * 256 + wc * 32 + 8 * fq;
#pragma unroll
        for (int ai = 0; ai < 2; ++ai)
#pragma unroll
            for (int m = 0; m < 4; ++m) { bf16_t* rowp = O + (size_t)(row0 + ai * 128 + m * 16) * D + col0;
#pragma unroll
                for (int bj = 0; bj < 2; ++bj) *(u32x4*)(rowp + bj * 128) = pack8(acc[ai][bj][m][0], acc[ai][bj][m][1]); }
    }
};
struct SchedBatchB : pg8::OrderCore {
    __device__ __forceinline__ bool next(int i, Unit& u) const { return map(i, u.pm, u.pn); }
    __device__ __forceinline__ void offs(const Unit& u, long long& ao, long long& bo) const { ao = (long long)u.pm * 256 * D * 2; bo = ((long long)(u.pm >> 5) * 1024 + u.pn * 256) * D * 2; }
};
struct EpiSoftmax {
    static constexpr bool PERM = true;
    bf16_t* P; const float* ssq;
    __device__ __forceinline__ void operator()(AccRef acc_c, const Unit& u, int wr, int wc, int fr, int fq, LAS unsigned char* lds) const {
        f32x4 (&acc)[2][2][4][2] = const_cast<f32x4 (&)[2][2][4][2]>(acc_c);
        LAS f32x2* ex = (LAS f32x2*)(lds + LDS_EPI);
#pragma unroll
        for (int ai = 0; ai < 2; ++ai)
#pragma unroll
            for (int m = 0; m < 4; ++m) { const int rl = ai * 128 + wr * 64 + m * 16 + fr; const f32x4* sp = (const f32x4*)(ssq + (size_t)(u.pm * 256 + rl) * 16);
                const f32x4 s4 = (sp[0] + sp[1]) + (sp[2] + sp[3]); const float rstd = __builtin_amdgcn_rsqf(((s4[0] + s4[1]) + (s4[2] + s4[3])) * (1.0f / D) + NORM_EPS);
                float mx = -3.0e38f;
#pragma unroll
                for (int bj = 0; bj < 2; ++bj)
#pragma unroll
                    for (int n = 0; n < 2; ++n) { acc[ai][bj][m][n] = acc[ai][bj][m][n] * rstd; mx = fmaxf(mx, fmaxf(fmaxf(acc[ai][bj][m][n][0], acc[ai][bj][m][n][1]), fmaxf(acc[ai][bj][m][n][2], acc[ai][bj][m][n][3]))); }
                mx = fmaxf(mx, __shfl_xor(mx, 16)); mx = fmaxf(mx, __shfl_xor(mx, 32));
                float sm = 0.f;
#pragma unroll
                for (int bj = 0; bj < 2; ++bj)
#pragma unroll
                    for (int n = 0; n < 2; ++n) {
#pragma unroll
                        for (int j = 0; j < 4; ++j) { const float pj = __builtin_amdgcn_exp2f(acc[ai][bj][m][n][j] - mx); acc[ai][bj][m][n][j] = pj; sm += pj; } }
                sm += __shfl_xor(sm, 16); sm += __shfl_xor(sm, 32);
                if (fq == 0) ex[rl * 4 + wc] = (f32x2){mx, sm}; }
        lds_barrier();
#pragma unroll
        for (int ai = 0; ai < 2; ++ai)
#pragma unroll
            for (int m = 0; m < 4; ++m) { const int rl = ai * 128 + wr * 64 + m * 16 + fr;
                const f32x4 e01 = *(const LAS f32x4*)(ex + rl * 4), e23 = *(const LAS f32x4*)(ex + rl * 4 + 2);
                const float gm = fmaxf(fmaxf(e01[0], e01[2]), fmaxf(e23[0], e23[2]));
                const float tot = (e01[1] * __builtin_amdgcn_exp2f(e01[0] - gm) + e01[3] * __builtin_amdgcn_exp2f(e01[2] - gm)) + (e23[1] * __builtin_amdgcn_exp2f(e23[0] - gm) + e23[3] * __builtin_amdgcn_exp2f(e23[2] - gm));
                const float own = wc == 0 ? e01[0] : wc == 1 ? e01[2] : wc == 2 ? e23[0] : e23[2];
                const float f = __builtin_amdgcn_exp2f(own - gm) * __builtin_amdgcn_rcpf(tot);
                bf16_t* rowp = P + (size_t)(u.pm * 256 + rl) * D + u.pn * 256 + wc * 32 + 8 * fq;
#pragma unroll
                for (int bj = 0; bj < 2; ++bj) *(u32x4*)(rowp + bj * 128) = pack8(acc[ai][bj][m][0] * f, acc[ai][bj][m][1] * f); }
    }
};
struct EpiRouter {
    static constexpr bool PERM = true;
    const float* ssq; const float* brg; const float* bre; u32x4* tok;
    __device__ __forceinline__ void operator()(AccRef acc, const Unit& u, int wr, int wc, int fr, int fq, LAS unsigned char* lds) const {
        LAS f32x4* gl = (LAS f32x4*)(lds + LDS_EPI); LAS int* lc = (LAS int*)(lds + LDS_EPI + 4096);
        auto row_rstd = [&](int row) { const f32x4* sp = (const f32x4*)(ssq + (size_t)row * 16); const f32x4 s4 = (sp[0] + sp[1]) + (sp[2] + sp[3]);
            return __builtin_amdgcn_rsqf(((s4[0] + s4[1]) + (s4[2] + s4[3])) * (1.0f / D) + NORM_EPS); };
        if (wc == 1 && fq == 0) { const f32x4 bg = *(const f32x4*)brg;
#pragma unroll
            for (int ai = 0; ai < 2; ++ai)
#pragma unroll
                for (int m = 0; m < 4; ++m) { const int rl = ai * 128 + wr * 64 + m * 16 + fr; gl[rl] = (acc[ai][0][m][0] + acc[ai][1][m][0]) * row_rstd(u.pm * 256 + rl) + bg; } }
        lds_barrier();
        if (wc == 0) {
#pragma unroll
            for (int ai = 0; ai < 2; ++ai)
#pragma unroll
                for (int m = 0; m < 4; ++m) { const int rl = ai * 128 + wr * 64 + m * 16 + fr; const f32x4 g = gl[rl];
                    int grp = 0; float gm = g[0];
#pragma unroll
                    for (int c = 1; c < 4; ++c) if (g[c] > gm) { gm = g[c]; grp = c; }
                    if (fq == grp) {
                        float gden = 0.f;
#pragma unroll
                        for (int c = 0; c < 4; ++c) gden += __expf(g[c] - gm);
                        const float gw = 1.0f / gden;
                        const f32x4 b0 = *(const f32x4*)(bre + grp * 8), b1 = *(const f32x4*)(bre + grp * 8 + 4);
                        const float rs = row_rstd(u.pm * 256 + rl);
                        const f32x4 e0 = (acc[ai][0][m][0] + acc[ai][1][m][0]) * rs + b0, e1v = (acc[ai][0][m][1] + acc[ai][1][m][1]) * rs + b1;
                        const float el[8] = {e0[0], e0[1], e0[2], e0[3], e1v[0], e1v[1], e1v[2], e1v[3]};
                        int i1 = 0; float m1 = el[0];
#pragma unroll
                        for (int c = 1; c < 8; ++c) if (el[c] > m1) { m1 = el[c]; i1 = c; }
                        int i2 = -1; float m2 = -3.0e38f;
#pragma unroll
                        for (int c = 0; c < 8; ++c) if (c != i1 && el[c] > m2) { m2 = el[c]; i2 = c; }
                        if (i2 < 0) i2 = i1 ? 0 : 1;
                        const float ex = __expf(m2 - m1); const float w1 = 1.0f / (1.0f + ex), w2 = ex * w1;
                        const int x1 = grp * 8 + i1, x2 = grp * 8 + i2;
                        u32x4 o; o.x = (unsigned)x1 | ((unsigned)x2 << 8); o.y = __builtin_bit_cast(unsigned, gw * w1); o.z = __builtin_bit_cast(unsigned, gw * w2); o.w = __builtin_bit_cast(unsigned, rs);
                        tok[u.pm * 256 + rl] = o; atomicAdd((int*)&lc[x1], 1); atomicAdd((int*)&lc[x2], 1); } } }
    }
};

struct Args { const float* in[37]; float* out; unsigned char* ws; int ph_lo, ph_hi; };
typedef const __attribute__((address_space(4))) Args* KArgs;
__device__ __forceinline__ KArgs kargs() { KArgs p = (KArgs)__builtin_amdgcn_kernarg_segment_ptr(); asm volatile("" : "+s"(p)); return p; }
enum { I_X = 0, I_MEM, I_NORM_MIX, I_NORM_MEM, I_NORM_FFN, I_NORM_FINAL, I_MU, I_WRKV, I_W0, I_W1, I_W2, I_A0, I_A1, I_A2, I_G1, I_G2, I_KK, I_KA, I_RK, I_LNG, I_LNB, I_WO,
       I_KVNORM, I_WKVS, I_SBWQ, I_SBWO, I_MEMNORMKV, I_MEMWQ, I_MEMWKV, I_MEMWO, I_WRG, I_BRG, I_WRE, I_BRE, I_WGATE, I_WUP, I_WDOWN };

struct ConvJob { const float* src; bf16_t* dst; const float* g; const float* mu; int K, N, lds, ldd, mumode; float cst; };
constexpr int NJOBS = 25 + 320;
__device__ __forceinline__ ConvJob get_job(KArgs a, int j) {
    ConvJob J; J.g = nullptr; J.mu = nullptr; J.mumode = 0; J.cst = 1.f;
    unsigned char* ws = a->ws;
    if (j < 12) { const int i = j >> 1, part = j & 1; J.K = D; J.g = a->in[I_NORM_MIX];
        if (i < 3) {
            J.src = a->in[I_WRKV] + (size_t)i * D * D; J.N = part ? 0 : D; J.lds = D; J.ldd = D; J.dst = (bf16_t*)(ws + WS_WCAT) + (size_t)(i * 1024) * D; return J; }
        J.ldd = 2 * D; J.mu = a->in[I_MU] + i * D; J.mumode = part ? 2 : 1;
        bf16_t* base = (bf16_t*)(ws + WS_WCAT) + part * D;
        if (i == 3) { J.src = a->in[I_W1]; J.N = 64; J.lds = 64; J.dst = base + (size_t)3072 * 2 * D; }
        else if (i == 4) { J.src = a->in[I_A1]; J.N = 64; J.lds = 64; J.dst = base + (size_t)(3072 + 64) * 2 * D; }
        else { J.src = a->in[I_G1]; J.N = 160; J.lds = 160; J.dst = base + (size_t)3328 * 2 * D; }
        return J; }
    if (j == 12) { J.src = a->in[I_W2]; J.K = 64; J.N = D; J.lds = D; J.dst = (bf16_t*)(ws + WS_WWA2); J.ldd = 256; return J; }
    if (j == 13) { J.src = a->in[I_A2]; J.K = 64; J.N = D; J.lds = D; J.dst = (bf16_t*)(ws + WS_WWA2) + (size_t)1024 * 256 + 64; J.ldd = 256; return J; }
    if (j == 14) { J.src = a->in[I_G2]; J.K = 160; J.N = D; J.lds = D; J.dst = (bf16_t*)(ws + WS_WG2); J.ldd = 256; return J; }
    if (j == 15) { J.src = a->in[I_WO]; J.K = D; J.N = D; J.lds = D; J.dst = (bf16_t*)(ws + WS_WO0); J.ldd = D; return J; }
    if (j == 16) { J.src = a->in[I_WKVS]; J.K = D; J.N = 2 * D; J.lds = 2 * D; J.dst = (bf16_t*)(ws + WS_WKVQ); J.ldd = D; J.g = a->in[I_KVNORM]; return J; }
    if (j == 17) { J.src = a->in[I_SBWQ]; J.K = D; J.N = D; J.lds = D; J.dst = (bf16_t*)(ws + WS_WKVQ) + (size_t)2048 * D; J.ldd = D; J.g = a->in[I_NORM_MIX] + D; J.cst = 0.125f * 1.44269504f; return J; }
    if (j == 18) { J.src = a->in[I_SBWO]; J.K = D; J.N = D; J.lds = D; J.dst = (bf16_t*)(ws + WS_WOSB); J.ldd = D; return J; }
    if (j < 25) { const int l = (j - 19) / 3, w = (j - 19) % 3; J.K = D; J.ldd = D;
        if (w == 0) { J.src = a->in[I_MEMWQ]; J.N = 0; J.lds = D; J.dst = (bf16_t*)(ws + WS_WMQ); }
        else if (w == 1) { J.src = a->in[I_MEMWKV] + (size_t)l * D * 2 * D; J.N = 2 * D; J.lds = 2 * D; J.dst = (bf16_t*)(ws + WS_WMKV) + (size_t)l * 2 * D * D; J.g = a->in[I_MEMNORMKV] + l * D; }
        else { J.src = a->in[I_MEMWO] + (size_t)l * D * D; J.N = D; J.lds = D; J.dst = (bf16_t*)(ws + WS_WMO) + (size_t)l * D * D; }
        return J; }
    const int mI = j - 25, l = mI / 160, e = (mI % 160) / 5, part = mI % 5;
    if (part < 4) { const int up = part >> 1, hh = part & 1; J.src = a->in[up ? I_WUP : I_WGATE] + ((size_t)l * 32 + e) * D * 256 + hh * 128; J.K = D; J.N = 128; J.lds = 256;
        J.dst = (bf16_t*)(ws + WS_WGU) + (((size_t)l * 32 + e) * 512 + hh * 256 + up * 128) * D; J.ldd = D; J.g = a->in[I_NORM_FFN] + l * D; }
    else { J.src = a->in[I_WDOWN] + ((size_t)l * 32 + e) * 256 * D; J.K = 256; J.N = D; J.lds = D; J.dst = (bf16_t*)(ws + WS_WDN) + ((size_t)l * 32 + e) * D * 256; J.ldd = 256; }
    return J;
}
__device__ __forceinline__ void conv_load(const ConvJob& J, int tile, float (&v)[64], float& gk, float& mk, int lane) {
    const int ntn = (J.N + 63) >> 6, kb = tile / ntn, nb = tile % ntn, k0 = kb * 64, n0 = nb * 64;
    const int nc = (n0 + lane) < J.N ? n0 + lane : J.N - 1;
    { const int kc = (k0 + lane) < J.K ? k0 + lane : J.K - 1; gk = J.g ? J.g[kc] : 1.0f; mk = J.mu ? J.mu[kc] : 0.0f; }
    const float* sp = J.src + nc;
#pragma unroll
    for (int u = 0; u < 64; ++u) { const int kr = (k0 + u) < J.K ? k0 + u : J.K - 1; v[u] = __builtin_nontemporal_load(sp + (size_t)kr * J.lds); }
}
__device__ __forceinline__ void conv_store(const ConvJob& J, int tile, const float (&v)[64], float gk, float mk, LAS float* scr, int lane) {
    const int ntn = (J.N + 63) >> 6, kb = tile / ntn, nb = tile % ntn, k0 = kb * 64, n0 = nb * 64;
    float sk = 0.f;
    if (k0 + lane < J.K) { sk = J.cst * gk; if (J.mumode == 1) sk *= mk; else if (J.mumode == 2) sk *= (1.0f - mk); }
#pragma unroll
    for (int u = 0; u < 64; ++u) { const float s = __builtin_bit_cast(float, __builtin_amdgcn_readlane(__builtin_bit_cast(int, sk), u)); scr[u * 65 + lane] = v[u] * s; }
    asm volatile("s_waitcnt lgkmcnt(0)" ::: "memory");
    const int c = lane & 7;
#pragma unroll
    for (int it = 0; it < 8; ++it) { const int n = (lane >> 3) + 8 * it; const LAS float* s = scr + (8 * c) * 65 + n;
        if (n0 + n < J.N && k0 + 8 * c < J.K) { u32x4 o; o.x = cvt_pk_bf16(s[0], s[65]); o.y = cvt_pk_bf16(s[130], s[195]); o.z = cvt_pk_bf16(s[260], s[325]); o.w = cvt_pk_bf16(s[390], s[455]);
            *(u32x4*)(J.dst + (size_t)(n0 + n) * J.ldd + k0 + 8 * c) = o; } }
    asm volatile("s_waitcnt lgkmcnt(0)" ::: "memory");
}
struct ConvIter { int j, t, ntiles, tbase; };
__device__ __forceinline__ bool conv_next(KArgs a, ConvIter& it, ConvJob& J, int& tile, int gw, int NGW) {
    for (;;) {
        if (it.j >= NJOBS) return false;
        if (it.t < it.ntiles) { J = get_job(a, it.j); tile = it.t; it.t += NGW; return true; }
        it.tbase = (it.tbase + it.ntiles) % NGW; ++it.j;
        if (it.j < NJOBS) { const ConvJob Jn = get_job(a, it.j); it.ntiles = ((Jn.K + 63) >> 6) * ((Jn.N + 63) >> 6); int t0 = (gw - it.tbase) % NGW; if (t0 < 0) t0 += NGW; it.t = t0; }
    }
}
__device__ __forceinline__ void rms_row_to_bf16(const float* xrow, bf16_t* orow, int lane) {
    const f32x4* xr = (const f32x4*)xrow + lane; f32x4 v[4]; float s = 0.f;
#pragma unroll
    for (int j = 0; j < 4; ++j) { v[j] = xr[64 * j]; s += (v[j][0] * v[j][0] + v[j][1] * v[j][1]) + (v[j][2] * v[j][2] + v[j][3] * v[j][3]); }
    const float rstd = __builtin_amdgcn_rsqf(wave_sum(s) * (1.0f / D) + NORM_EPS);
    u32x2* o8 = (u32x2*)orow + lane;
#pragma unroll
    for (int j = 0; j < 4; ++j) { u32x2 w; w.x = cvt_pk_bf16(v[j][0] * rstd, v[j][1] * rstd); w.y = cvt_pk_bf16(v[j][2] * rstd, v[j][3] * rstd); o8[64 * j] = w; }
}
__device__ __forceinline__ void prologue_phase(KArgs a, LAS unsigned char* lds, int bid, int nb) {
    const int tid = opaque_tid(), lane = tid & 63, wave = __builtin_amdgcn_readfirstlane(tid >> 6);
    const int gw = bid * 8 + wave, NGW = nb * 8;
    LAS float* scr = (LAS float*)(lds + wave * 16896);
    {   ConvIter it; it.j = 0; it.tbase = 0; { const ConvJob J0 = get_job(a, 0); it.ntiles = ((J0.K + 63) >> 6) * ((J0.N + 63) >> 6); it.t = gw; }
        ConvJob JA, JB, JC; int tA = 0, tB = 0, tC = 0; float vA[64], vB[64], vC[64], gA = 1.f, mA = 0.f, gB = 1.f, mB = 0.f, gC = 1.f, mC = 0.f;
        bool okA = conv_next(a, it, JA, tA, gw, NGW); if (okA) conv_load(JA, tA, vA, gA, mA, lane);
        bool okB = okA && conv_next(a, it, JB, tB, gw, NGW); if (okB) conv_load(JB, tB, vB, gB, mB, lane);
        while (okA) {
            const bool okC = okB && conv_next(a, it, JC, tC, gw, NGW); if (okC) conv_load(JC, tC, vC, gC, mC, lane);
            conv_store(JA, tA, vA, gA, mA, scr, lane);
            okA = okC && conv_next(a, it, JA, tA, gw, NGW); if (okA) conv_load(JA, tA, vA, gA, mA, lane);
            if (!okB) break;
            conv_store(JB, tB, vB, gB, mB, scr, lane);
            okB = okA && conv_next(a, it, JB, tB, gw, NGW); if (okB) conv_load(JB, tB, vB, gB, mB, lane);
            if (!okC) break;
            conv_store(JC, tC, vC, gC, mC, scr, lane);
        }
    }
    { bf16_t* wq = (bf16_t*)(a->ws + WS_WMQ);
      for (int i = bid * 512 + tid; i < 2 * D * D / 4; i += nb * 512) { const int l = i >> 18, k = (i >> 8) & 1023;
          const f32x4 v = *(const f32x4*)(a->in[I_MEMWQ] + (size_t)i * 4) * (a->in[I_NORM_MEM][l * D + k] * (0.0625f * 1.44269504f));
          u32x2 o; o.x = cvt_pk_bf16(v[0], v[1]); o.y = cvt_pk_bf16(v[2], v[3]); *(u32x2*)(wq + (size_t)i * 4) = o; } }
    bf16_t* wr2 = (bf16_t*)(a->ws + WS_RS);
    for (int i = bid * 512 + tid; i < 2 * 256 * 1024; i += nb * 512) { const int l = i >> 18, c = (i >> 10) & 255, k = i & 1023, cc = c & 127;
        float w = 0.f;
        if (cc < 36) w = a->in[I_NORM_FFN][l * D + k] * (cc < 32 ? a->in[I_WRE][((size_t)l * D + k) * 32 + cc] : a->in[I_WRG][((size_t)l * D + k) * 4 + (cc - 32)]);
        const unsigned hi = f2bf(w); const unsigned lo = f2bf(w - __builtin_bit_cast(float, hi << 16));
        wr2[i] = (bf16_t)((c >> 7) ? lo : hi); }
    bf16_t* mn = (bf16_t*)(a->ws + WS_MN);
    for (int r = gw; r < 2048; r += NGW) rms_row_to_bf16(a->in[I_MEM] + (size_t)r * D, mn + (size_t)r * D, lane);
    bf16_t* hp = (bf16_t*)(a->ws + R0);
    { bf16_t* L0 = (bf16_t*)(a->ws + R6); bf16_t* L1 = (bf16_t*)a->out; bf16_t* L2 = (bf16_t*)a->out + (size_t)T * D;
      constexpr int RPW = 32;
      const int e0 = lane * 8, e1 = lane * 8 + 4, e2 = 512 + lane * 8, e3 = 512 + lane * 8 + 4;
      for (int r0 = gw * RPW; r0 < T; r0 += NGW * RPW) {
          f32x4 mu[3][4];
#pragma unroll
          for (int i = 0; i < 3; ++i) { const float* mp = a->in[I_MU] + i * D; mu[i][0] = *(const f32x4*)(mp + e0); mu[i][1] = *(const f32x4*)(mp + e1); mu[i][2] = *(const f32x4*)(mp + e2); mu[i][3] = *(const f32x4*)(mp + e3); }
          f32x4 hprev[4];
          { const int t0 = r0 & (S - 1);
            if (t0 == 0) {
#pragma unroll
                for (int j = 0; j < 4; ++j) hprev[j] = (f32x4){0.f, 0.f, 0.f, 0.f}; }
            else { const float* xr = a->in[I_X] + (size_t)(r0 - 1) * D; float s = 0.f;
                hprev[0] = *(const f32x4*)(xr + e0); hprev[1] = *(const f32x4*)(xr + e1); hprev[2] = *(const f32x4*)(xr + e2); hprev[3] = *(const f32x4*)(xr + e3);
#pragma unroll
                for (int j = 0; j < 4; ++j) s += (hprev[j][0] * hprev[j][0] + hprev[j][1] * hprev[j][1]) + (hprev[j][2] * hprev[j][2] + hprev[j][3] * hprev[j][3]);
                const float rstd = __builtin_amdgcn_rsqf(wave_sum(s) * (1.0f / D) + NORM_EPS);
#pragma unroll
                for (int j = 0; j < 4; ++j) hprev[j] = hprev[j] * rstd; } }
          f32x4 va[4], vb[4];
          { const float* xr = a->in[I_X] + (size_t)r0 * D; va[0] = __builtin_nontemporal_load((const f32x4*)(xr + e0)); va[1] = __builtin_nontemporal_load((const f32x4*)(xr + e1)); va[2] = __builtin_nontemporal_load((const f32x4*)(xr + e2)); va[3] = __builtin_nontemporal_load((const f32x4*)(xr + e3));
            xr += D; vb[0] = __builtin_nontemporal_load((const f32x4*)(xr + e0)); vb[1] = __builtin_nontemporal_load((const f32x4*)(xr + e1)); vb[2] = __builtin_nontemporal_load((const f32x4*)(xr + e2)); vb[3] = __builtin_nontemporal_load((const f32x4*)(xr + e3)); }
#define PRO_ROW(V_, rr_) { const int r = r0 + (rr_), b = r >> 13, t = r & (S - 1); \
              f32x4 v[4]; float s = 0.f; \
              _Pragma("unroll") for (int j = 0; j < 4; ++j) { v[j] = V_[j]; s += (v[j][0] * v[j][0] + v[j][1] * v[j][1]) + (v[j][2] * v[j][2] + v[j][3] * v[j][3]); } \
              { const int rn = ((rr_) + 2 < RPW) ? r + 2 : r; const float* xr = a->in[I_X] + (size_t)rn * D; \
                V_[0] = __builtin_nontemporal_load((const f32x4*)(xr + e0)); V_[1] = __builtin_nontemporal_load((const f32x4*)(xr + e1)); V_[2] = __builtin_nontemporal_load((const f32x4*)(xr + e2)); V_[3] = __builtin_nontemporal_load((const f32x4*)(xr + e3)); } \
              const float rstd = __builtin_amdgcn_rsqf(wave_sum(s) * (1.0f / D) + NORM_EPS); \
              bf16_t* oh = hp + ((size_t)b * (S + 1) + 1 + t) * D + e0; bf16_t* o0 = L0 + (size_t)r * D + e0; bf16_t* o1 = L1 + (size_t)r * D + e0; bf16_t* o2 = L2 + (size_t)r * D + e0; \
              _Pragma("unroll") for (int jh = 0; jh < 2; ++jh) { const f32x4 ha = v[2 * jh] * rstd, hb = v[2 * jh + 1] * rstd, da = hprev[2 * jh] - ha, db = hprev[2 * jh + 1] - hb; \
                  *(u32x4*)(oh + 512 * jh) = pack8(ha, hb); \
                  *(u32x4*)(o0 + 512 * jh) = pack8(ha + da * mu[0][2 * jh], hb + db * mu[0][2 * jh + 1]); \
                  *(u32x4*)(o1 + 512 * jh) = pack8(ha + da * mu[1][2 * jh], hb + db * mu[1][2 * jh + 1]); \
                  *(u32x4*)(o2 + 512 * jh) = pack8(ha + da * mu[2][2 * jh], hb + db * mu[2][2 * jh + 1]); \
                  hprev[2 * jh] = ha; hprev[2 * jh + 1] = hb; } }
#pragma unroll 1
          for (int rr = 0; rr < RPW; rr += 2) { PRO_ROW(va, rr) PRO_ROW(vb, rr + 1) }
#undef PRO_ROW
      } }
    if (gw < NB) { u32x4* z = (u32x4*)(hp + (size_t)gw * (S + 1) * D); z[lane] = (u32x4){0u, 0u, 0u, 0u}; z[64 + lane] = (u32x4){0u, 0u, 0u, 0u}; }
}

namespace rw {
constexpr int RB = 144, SLOT = 64 * RB;
enum { S_AT = 0, S_BT, S_KT, S_RT, S_ATT, S_VT, S_BHT, S_KHT, S_TM, S_APT0, S_APT1, S_AAK, S_XT0, S_TRI, NSLOTS };
constexpr int S_AP0 = S_BT, S_AP1 = S_KT, S_XT1 = S_RT, S_ARB = S_BHT, S_ARK = S_KHT;
constexpr int MISC = NSLOTS * SLOT;
__device__ __forceinline__ int rowmap(int q, int h) { return (q & 3) + 8 * (q >> 2) + 4 * h; }
__device__ __forceinline__ f32x16 zero16() { f32x16 z;
#pragma unroll
    for (int i = 0; i < 16; ++i) z[i] = 0.f;
    return z; }
__device__ __forceinline__ bf16x8 tr_frag(const LAS unsigned char* T, int row0, int ks, int r, int h) {
    const int q = (r & 15) >> 2, p = r & 3, blk = (r >> 4) & 1, sw = (q >> 1) & 1;
    const LAS unsigned char* a0 = T + (16 * ks + 8 * h + q) * 128 + ((((row0 >> 5) ^ sw) * 4 + 2 * blk + (p >> 1)) << 4) + 8 * (p & 1);
    return __builtin_shufflevector(__builtin_amdgcn_ds_read_tr16_b64_v4i16((LAS s16x4*)a0), __builtin_amdgcn_ds_read_tr16_b64_v4i16((LAS s16x4*)(a0 + 4 * 128)), 0, 1, 2, 3, 4, 5, 6, 7); }
template <bool SX = false, bool SY = false>
__device__ __forceinline__ f32x16 mm(f32x16 acc, const LAS unsigned char* X, int xrow0, const LAS unsigned char* Yt, int yrow0, int r, int h, int nks) {
#pragma unroll
    for (int ks = 0; ks < 4; ++ks) if (ks < nks) {
        const bf16x8 a = SX ? tr_frag(X, xrow0, ks, r, h) : *(const LAS bf16x8*)(X + (xrow0 + r) * RB + (16 * ks + 8 * h) * 2);
        const bf16x8 b = SY ? tr_frag(Yt, yrow0, ks, r, h) : *(const LAS bf16x8*)(Yt + (yrow0 + r) * RB + (16 * ks + 8 * h) * 2);
        acc = __builtin_amdgcn_mfma_f32_32x32x16_bf16(a, b, acc, 0, 0, 0); }
    return acc; }
__device__ __forceinline__ void write_T(LAS unsigned char* buf, int col0, int row0, const f32x16& acc, int r, int h) {
#pragma unroll
    for (int m = 0; m < 4; ++m) { u32x2 w; w.x = cvt_pk_c(acc[4 * m], acc[4 * m + 1]); w.y = cvt_pk_c(acc[4 * m + 2], acc[4 * m + 3]);
        *(LAS u32x2*)(buf + (col0 + r) * RB + (row0 + 8 * m + 4 * h) * 2) = w; } }
__device__ __forceinline__ void write_R(LAS unsigned char* buf, int row0, int col0, const f32x16& acc, int r, int h) {
#pragma unroll
    for (int q = 0; q < 16; q += 2) { const unsigned p = cvt_pk_c(acc[q], acc[q + 1]);
        *(LAS unsigned short*)(buf + (row0 + rowmap(q, h)) * RB + (col0 + r) * 2) = (unsigned short)p; *(LAS unsigned short*)(buf + (row0 + rowmap(q + 1, h)) * RB + (col0 + r) * 2) = (unsigned short)(p >> 16); } }
__device__ __forceinline__ void zero_tile(LAS unsigned char* buf, int row0, int col0, int lane) {
#pragma unroll
    for (int i = 0; i < 4; ++i) { const int idx = i * 64 + lane, row = idx >> 3, ch = idx & 7; *(LAS u32x2*)(buf + (row0 + row) * RB + col0 * 2 + ch * 8) = (u32x2){0u, 0u}; } }

#define RW_P8(v_, s_) pack8c(v_[8 * (s_)], v_[8 * (s_) + 1], v_[8 * (s_) + 2], v_[8 * (s_) + 3], v_[8 * (s_) + 4], v_[8 * (s_) + 5], v_[8 * (s_) + 6], v_[8 * (s_) + 7])
__device__ __forceinline__ void inv32(const f32x16 A, const f32x16 AT, f32x16& Tt, f32x16& TtT, int r, int h) {
    f32x16 X = A, Y = AT; Tt = A; TtT = AT;
#pragma unroll
    for (int q = 0; q < 16; ++q) if (rowmap(q, h) == r) { Tt[q] += 1.0f; TtT[q] += 1.0f; }
#pragma unroll
    for (int k = 0; k < 4; ++k) {
        const bf16x8 x0 = RW_P8(X, 0), x1 = RW_P8(X, 1), y0 = RW_P8(Y, 0), y1 = RW_P8(Y, 1);
        f32x16 Sx = zero16(), Sy = zero16();
        Sx = __builtin_amdgcn_mfma_f32_32x32x16_bf16(y0, x0, Sx, 0, 0, 0); if (k < 3) Sy = __builtin_amdgcn_mfma_f32_32x32x16_bf16(x0, y0, Sy, 0, 0, 0);
        Sx = __builtin_amdgcn_mfma_f32_32x32x16_bf16(y1, x1, Sx, 0, 0, 0); if (k < 3) Sy = __builtin_amdgcn_mfma_f32_32x32x16_bf16(x1, y1, Sy, 0, 0, 0);
        const bf16x8 s0 = RW_P8(Sx, 0), s1 = RW_P8(Sx, 1), t0 = RW_P8(TtT, 0), t1 = RW_P8(TtT, 1);
        Tt = __builtin_amdgcn_mfma_f32_32x32x16_bf16(t0, s0, Tt, 0, 0, 0); TtT = __builtin_amdgcn_mfma_f32_32x32x16_bf16(s0, t0, TtT, 0, 0, 0);
        Tt = __builtin_amdgcn_mfma_f32_32x32x16_bf16(t1, s1, Tt, 0, 0, 0); TtT = __builtin_amdgcn_mfma_f32_32x32x16_bf16(s1, t1, TtT, 0, 0, 0);
        X = Sx; Y = Sy;
    }
}
__device__ __forceinline__ void tri_init(LAS unsigned char* lds, int tid) {
    const int row = tid >> 3, kb = (tid & 7) * 8; u32x4 v; unsigned ww[4];
#pragma unroll
    for (int q = 0; q < 4; ++q) ww[q] = ((kb + 2 * q <= row) ? 0x3F80u : 0u) | ((kb + 2 * q + 1 <= row) ? 0x3F800000u : 0u);
    v.x = ww[0]; v.y = ww[1]; v.z = ww[2]; v.w = ww[3]; *(LAS u32x4*)(lds + S_TRI * SLOT + row * RB + kb * 2) = v; }
struct Raw { u32x4 r, k, v, e, a; };
template <bool NEED_R>
__device__ __forceinline__ void raw_load(KArgs a, Raw& R, int item, int tid) {
    const int lane = tid & 63, w = __builtin_amdgcn_readfirstlane(tid >> 6); const int bh = item >> 7, c = item & 127, b = bh >> 4, hd = bh & 15;
    const size_t g0 = ((size_t)b * S + c * 64 + 8 * w) * D + hd * 64;
    const unsigned o = (unsigned)((lane >> 3) * D + (lane & 7) * 8);
    if (NEED_R) R.r = *(const u32x4*)((const bf16_t*)(a->ws + R1) + g0 + o);
    R.k = *(const u32x4*)((const bf16_t*)(a->ws + R2) + g0 + o); R.v = *(const u32x4*)((const bf16_t*)(a->ws + R3) + g0 + o);
    R.e = *(const u32x4*)((const bf16_t*)(a->ws + R4) + g0 + o); R.a = *(const u32x4*)((const bf16_t*)a->out + g0 + o); }
__device__ __forceinline__ void unpack8(const u32x4 w, float (&f)[8]) { f[0] = bf_lo(w.x); f[1] = bf_hi(w.x); f[2] = bf_lo(w.y); f[3] = bf_hi(w.y); f[4] = bf_lo(w.z); f[5] = bf_hi(w.z); f[6] = bf_lo(w.w); f[7] = bf_hi(w.w); }
__device__ __forceinline__ void store_tm(LAS unsigned char* p, const float (&f)[8]) {
    u32x2 lo, hi; lo.x = cvt_pk_c(f[0], f[1]); lo.y = cvt_pk_c(f[2], f[3]); hi.x = cvt_pk_c(f[4], f[5]); hi.y = cvt_pk_c(f[6], f[7]);
    *(LAS u32x2*)p = lo; *(LAS u32x2*)(p + 16) = hi; }
constexpr int CS = 68, CLN_OFF = MISC + 1024, LWTN_OFF = CLN_OFF + 64 * CS * 4;
static_assert(LWTN_OFF + 8192 <= LDS_MISC, "scan LDS");
__device__ __forceinline__ void lwt_store(LAS unsigned char* lds, const u32x4 e, int w, int lane) {
    const int tq = lane >> 3, cg = lane & 7, tk = 8 * w + tq; *(LAS u32x4*)(lds + LWTN_OFF + tk * 128 + ((cg ^ (((tq >> 1) & 1) << 2)) << 4)) = e; }
__device__ __forceinline__ void cumsum_tile(LAS unsigned char* lds, int t4, int r, int h) {
    const int ti = t4 >> 1, cj = t4 & 1; f32x16 acc = zero16(); acc = mm<false, true>(acc, lds + S_TRI * SLOT, 32 * ti, lds + LWTN_OFF, 32 * cj, r, h, ti ? 4 : 2);
    LAS float* CL = (LAS float*)(lds + CLN_OFF);
#pragma unroll
    for (int q = 0; q < 16; ++q) CL[(32 * ti + rowmap(q, h)) * CS + 32 * cj + r] = acc[q]; }
template <bool STAGE_C>
__device__ __forceinline__ void chunk_front(KArgs a, LAS unsigned char* lds, int b, int hd, int c, int tid, Raw& RW, int next_item, u32x4& vraw) {
    const int lane = tid & 63, w = __builtin_amdgcn_readfirstlane(tid >> 6), r = lane & 31, h = lane >> 5;
    LAS float* WLf = (LAS float*)(lds + MISC); LAS float* bon = WLf + 64;
    const LAS float* CL = (const LAS float*)(lds + CLN_OFF);
    {
        const int tq = lane >> 3, cg = lane & 7, tk = 8 * w + tq, ch = hd * 64 + cg * 8;
        u32x4 rr, kr4, vr, er, ar;
        if (STAGE_C) { rr.x = pin_u32(RW.r.x); rr.y = pin_u32(RW.r.y); rr.z = pin_u32(RW.r.z); rr.w = pin_u32(RW.r.w); } else rr = (u32x4){0u, 0u, 0u, 0u};
        kr4.x = pin_u32(RW.k.x); kr4.y = pin_u32(RW.k.y); kr4.z = pin_u32(RW.k.z); kr4.w = pin_u32(RW.k.w);
        vr.x = pin_u32(RW.v.x); vr.y = pin_u32(RW.v.y); vr.z = pin_u32(RW.v.z); vr.w = pin_u32(RW.v.w); er.x = pin_u32(RW.e.x); er.y = pin_u32(RW.e.y); er.z = pin_u32(RW.e.z); er.w = pin_u32(RW.e.w);
        ar.x = pin_u32(RW.a.x); ar.y = pin_u32(RW.a.y); ar.z = pin_u32(RW.a.z); ar.w = pin_u32(RW.a.w);
        vraw = vr;
        if (next_item >= 0) raw_load<STAGE_C>(a, RW, next_item, tid);
        const int cmo = tk * 128 + ((cg ^ (((tq >> 1) & 1) << 2)) << 4);
        *(LAS u32x4*)(lds + S_VT * SLOT + cmo) = vr;
        float rv[8], kv[8], lw[8], lr[8], kk[8], kp[8];
        unpack8(rr, rv); unpack8(kr4, kv); unpack8(er, lw); unpack8(ar, lr);
        { const f32x4 kc0 = *(const f32x4*)(a->in[I_KK] + ch), kc1 = *(const f32x4*)(a->in[I_KK] + ch + 4), ac0 = *(const f32x4*)(a->in[I_KA] + ch), ac1 = *(const f32x4*)(a->in[I_KA] + ch + 4);
          const float kkc[8] = {kc0[0], kc0[1], kc0[2], kc0[3], kc1[0], kc1[1], kc1[2], kc1[3]}, kac[8] = {ac0[0], ac0[1], ac0[2], ac0[3], ac1[0], ac1[1], ac1[2], ac1[3]};
          float ss = 0.f;
#pragma unroll
          for (int j = 0; j < 8; ++j) { kk[j] = kv[j] * kkc[j]; ss += kk[j] * kk[j]; kp[j] = kv[j] * (1.0f + (lr[j] - 1.0f) * kac[j]); }
          const float rn = __builtin_amdgcn_rsqf(fmaxf(sum8(ss), 1e-24f));
#pragma unroll
          for (int j = 0; j < 8; ++j) kk[j] *= rn;
          if (STAGE_C) { const f32x4 rc0 = *(const f32x4*)(a->in[I_RK] + ch), rc1 = *(const f32x4*)(a->in[I_RK] + ch + 4); const float rkc[8] = {rc0[0], rc0[1], rc0[2], rc0[3], rc1[0], rc1[1], rc1[2], rc1[3]};
              float bs = 0.f;
#pragma unroll
              for (int j = 0; j < 8; ++j) bs += rv[j] * kp[j] * rkc[j];
              bs = sum8(bs); if (cg == 0) bon[tk] = bs; } }
        const f32x4 c10 = *(const LAS f32x4*)(CL + tk * CS + cg * 8), c11 = *(const LAS f32x4*)(CL + tk * CS + cg * 8 + 4), ct0 = *(const LAS f32x4*)(CL + 63 * CS + cg * 8), ct1 = *(const LAS f32x4*)(CL + 63 * CS + cg * 8 + 4);
        const float c1[8] = {c10[0], c10[1], c10[2], c10[3], c11[0], c11[1], c11[2], c11[3]}, ct[8] = {ct0[0], ct0[1], ct0[2], ct0[3], ct1[0], ct1[1], ct1[2], ct1[3]};
        if (!STAGE_C && tk == 63) {
            f32x4 w0, w1;
#pragma unroll
            for (int j = 0; j < 4; ++j) { w0[j] = __builtin_amdgcn_exp2f(1.44269504f * ct[j]); w1[j] = __builtin_amdgcn_exp2f(1.44269504f * ct[4 + j]); }
            *(LAS f32x4*)(WLf + cg * 8) = w0; *(LAS f32x4*)(WLf + cg * 8 + 4) = w1; }
        float at[8], bt[8], kt[8], rt[8], bh[8], kh[8];
#pragma unroll
        for (int j = 0; j < 8; ++j) { const float c0 = c1[j] - lw[j]; const float ep = __builtin_amdgcn_exp2f(1.44269504f * c1[j]), em = __builtin_amdgcn_rcpf(ep);
            at[j] = -kk[j] * __builtin_amdgcn_exp2f(1.44269504f * c0); const float kl = kk[j] * lr[j]; bt[j] = kl * em; kt[j] = kp[j] * em; rt[j] = rv[j] * ep;
            if (!STAGE_C) { const float ew = __builtin_amdgcn_exp2f(1.44269504f * (ct[j] - c1[j])); bh[j] = kl * ew; kh[j] = kp[j] * ew; } }
        { const int tmo = tk * RB + (32 * (cg >> 1) + 8 * (cg & 1));
          store_tm(lds + S_AT * SLOT + tmo, at); store_tm(lds + S_BT * SLOT + tmo, bt); store_tm(lds + S_KT * SLOT + tmo, kt); if (STAGE_C) store_tm(lds + S_RT * SLOT + tmo, rt); }
        if (!STAGE_C) { *(LAS u32x4*)(lds + S_ATT * SLOT + cmo) = __builtin_bit_cast(u32x4, pack8c(at[0], at[1], at[2], at[3], at[4], at[5], at[6], at[7]));
            *(LAS u32x4*)(lds + S_BHT * SLOT + cmo) = __builtin_bit_cast(u32x4, pack8c(bh[0], bh[1], bh[2], bh[3], bh[4], bh[5], bh[6], bh[7]));
            *(LAS u32x4*)(lds + S_KHT * SLOT + cmo) = __builtin_bit_cast(u32x4, pack8c(kh[0], kh[1], kh[2], kh[3], kh[4], kh[5], kh[6], kh[7])); }
    }
    lds_barrier();
    if (w < 2) { f32x16 A = zero16(), AT = zero16(); A = mm(A, lds + S_AT * SLOT, 32 * w, lds + S_BT * SLOT, 32 * w, r, h, 4); AT = mm(AT, lds + S_BT * SLOT, 32 * w, lds + S_AT * SLOT, 32 * w, r, h, 4);
#pragma unroll
        for (int q = 0; q < 16; ++q) { A[q] = (rowmap(q, h) > r) ? A[q] : 0.f; AT[q] = (rowmap(q, h) < r) ? AT[q] : 0.f; }
        f32x16 Ti, TiT; inv32(A, AT, Ti, TiT, r, h);
        write_T(lds + S_TM * SLOT, 32 * w, 32 * w, TiT, r, h);
        if (w == 0) write_T(lds + S_APT1 * SLOT + 32 * RB, 0, 0, Ti, r, h); }
    else if (w == 2) { f32x16 A = zero16(); A = mm(A, lds + S_AT * SLOT, 32, lds + S_BT * SLOT, 0, r, h, 4); write_R(lds + S_APT1 * SLOT, 0, 0, A, r, h); }
    else if (w < 6) { const int ti = (w == 3) ? 0 : 1, tj = (w == 5) ? 1 : 0; f32x16 x = zero16(); x = mm(x, lds + S_AT * SLOT, 32 * ti, lds + S_KT * SLOT, 32 * tj, r, h, 4);
#pragma unroll
        for (int q = 0; q < 16; ++q) { const bool keep = (ti != tj) || (rowmap(q, h) > r); x[q] = keep ? x[q] : 0.f; }
        write_R(lds + S_AAK * SLOT, 32 * ti, 32 * tj, x, r, h); }
    else if (w == 6) { zero_tile(lds + S_AAK * SLOT, 0, 32, lane); zero_tile(lds + S_TM * SLOT, 0, 32, lane); }
    if (STAGE_C && w >= 2) {
        const int t6 = w - 2, t3 = t6 % 3, ti = t3 == 0 ? 0 : 1, tj = t3 == 2 ? 1 : 0; const bool isk = t6 >= 3;
        f32x16 x = zero16(); x = mm(x, lds + S_RT * SLOT, 32 * ti, lds + (isk ? S_KT : S_BT) * SLOT, 32 * tj, r, h, 4);
#pragma unroll
        for (int q = 0; q < 16; ++q) { const bool keep = (ti != tj) || (rowmap(q, h) >= r); x[q] = keep ? x[q] : 0.f; }
        write_R(lds + (isk ? S_ARK : S_ARB) * SLOT, 32 * ti, 32 * tj, x, r, h);
        if (w == 7) { zero_tile(lds + S_ARB * SLOT, 0, 32, lane); zero_tile(lds + S_ARK * SLOT, 0, 32, lane); } }
    lds_barrier();
}
__device__ __forceinline__ void t10_step(LAS unsigned char* lds, int r, int h) {
    f32x16 X = zero16(); X = mm(X, lds + S_APT1 * SLOT, 0, lds + S_APT1 * SLOT + 32 * RB, 0, r, h, 2);
    f32x16 T10 = zero16();
#pragma unroll
    for (int s2 = 0; s2 < 2; ++s2) { const LAS unsigned char* p = lds + S_TM * SLOT + (32 + r) * RB + (32 + 16 * s2 + 4 * h) * 2; const u32x2 lo = *(const LAS u32x2*)p, hi = *(const LAS u32x2*)(p + 16);
        u32x4 aw; aw.x = lo.x; aw.y = lo.y; aw.z = hi.x; aw.w = hi.y;
        const bf16x8 bfr = s2 == 0 ? pack8c(X[0], X[1], X[2], X[3], X[4], X[5], X[6], X[7]) : pack8c(X[8], X[9], X[10], X[11], X[12], X[13], X[14], X[15]);
        T10 = __builtin_amdgcn_mfma_f32_32x32x16_bf16(__builtin_bit_cast(bf16x8, aw), bfr, T10, 0, 0, 0); }
    write_R(lds + S_TM * SLOT, 32, 0, T10, r, h);
}

__device__ __forceinline__ void stage_a(KArgs a, LAS unsigned char* lds, int bid, int nb) {
    const int tid = opaque_tid(), lane = tid & 63, w = __builtin_amdgcn_readfirstlane(tid >> 6), r = lane & 31, h = lane >> 5;
    unsigned char* MF = a->ws + R6; unsigned char* GF = a->ws + R0;
    const LAS float* WLf = (const LAS float*)(lds + MISC);
    const int per = (NB * 16 * 128 + nb - 1) / nb, item0 = bid * per, item1 = (item0 + per < NB * 16 * 128) ? item0 + per : NB * 16 * 128;
    Raw RW; if (item0 < item1) raw_load<false>(a, RW, item0, tid);
    tri_init(lds, tid);
    if (item0 < item1) { lwt_store(lds, RW.e, w, lane); lds_barrier(); if (w < 4) cumsum_tile(lds, w, r, h); }
    for (int item = item0; item < item1; ++item) {
        const int bh = item >> 7, c = item & 127, b = bh >> 4, hd = bh & 15;
        lds_barrier();
        u32x4 vdummy; chunk_front<false>(a, lds, b, hd, c, tid, RW, (item + 1 < item1) ? item + 1 : -1, vdummy);
        const int ti = (w >> 1) & 1, tj = w & 1;
        if (w == 2) t10_step(lds, r, h);
        else if (w >= 4) { f32x16 x = zero16(); x = mm<false, true>(x, lds + S_AAK * SLOT, 32 * ti, lds + S_VT * SLOT, 32 * tj, r, h, 4); write_T(lds + S_XT1 * SLOT, 32 * tj, 32 * ti, x, r, h); }
        lds_barrier();
        if (item + 1 < item1) lwt_store(lds, RW.e, w, lane);
        if (w < 4) { f32x16 p = zero16(); p = mm<false, true>(p, lds + S_TM * SLOT, 32 * ti, lds + S_ATT * SLOT, 32 * tj, r, h, 4); write_T(lds + S_XT0 * SLOT, 32 * tj, 32 * ti, p, r, h); }
        else { f32x16 q2 = zero16(); q2 = mm(q2, lds + S_TM * SLOT, 32 * ti, lds + S_XT1 * SLOT, 32 * tj, r, h, 4); write_T(lds + S_APT0 * SLOT, 32 * tj, 32 * ti, q2, r, h); }
        lds_barrier();
        if (w < 4 && item + 1 < item1) cumsum_tile(lds, w, r, h);
        f32x16 res = zero16();
        if (w < 4) { res = mm<false, true>(res, lds + S_XT0 * SLOT, 32 * ti, lds + S_BHT * SLOT, 32 * tj, r, h, 4);
            if (ti == tj) {
#pragma unroll
                for (int q = 0; q < 16; ++q) if (rowmap(q, h) == r) res[q] += WLf[32 * ti + r]; } }
        else { res = mm<true, false>(res, lds + S_BHT * SLOT, 32 * ti, lds + S_APT0 * SLOT, 32 * tj, r, h, 4); res = mm<true, true>(res, lds + S_KHT * SLOT, 32 * ti, lds + S_VT * SLOT, 32 * tj, r, h, 4); }
        { unsigned char* d0 = (w < 4) ? MF + (size_t)item * 8192 + (tj * 4 + 2 * ti) * 1024 + lane * 16 : GF + (size_t)item * 8192 + (tj * 2 + ti) * 2048 + lane * 16;
          unsigned char* d1 = d0 + 1024;
          { *(u32x4*)d0 = __builtin_bit_cast(u32x4, pack8c(res[0], res[1], res[2], res[3], res[4], res[5], res[6], res[7]));
                         *(u32x4*)d1 = __builtin_bit_cast(u32x4, pack8c(res[8], res[9], res[10], res[11], res[12], res[13], res[14], res[15])); } }
    }
    __syncthreads();
}

__device__ __forceinline__ void stage_b(KArgs a, LAS unsigned char* lds, int bh) {
    const int tid = opaque_tid(), lane = tid & 63, w = __builtin_amdgcn_readfirstlane(tid >> 6);
    constexpr int DD = 7, NS = 9, NSTEP = 128;
    const unsigned char* MF = a->ws + R6 + (size_t)bh * NSTEP * 8192; unsigned char* GF = a->ws + R0 + (size_t)bh * NSTEP * 8192;
    f32x16 H0 = zero16(), H1 = zero16();
#define RW_ISSUE(step_) do { const int step__ = (step_); const int st = step__ < NSTEP ? step__ : NSTEP - 1; LAS unsigned char* slot = lds + (step__ % NS) * 16384; \
        _Pragma("unroll") for (int p = 0; p < 4; ++p) { const int pc = (w - 4) * 4 + p; const unsigned char* src = (pc < 8 ? MF + (size_t)st * 8192 + pc * 1024 : GF + (size_t)st * 8192 + (pc - 8) * 1024) + lane * 16; \
            __builtin_amdgcn_global_load_lds((const unsigned*)src, (LAS unsigned*)(slot + pc * 1024), 16, 0, 0); } } while (0)
    if (w >= 4) {
#pragma unroll 1
        for (int s0 = 0; s0 < DD; ++s0) RW_ISSUE(s0); }
#pragma unroll 1
    for (int c = 0; c < NSTEP; ++c) {
        if (w >= 4) { RW_ISSUE(c + DD); asm volatile("s_waitcnt vmcnt(28)" ::: "memory"); }
        __builtin_amdgcn_s_barrier(); asm volatile("" ::: "memory");
        if (w < 2) {
            const LAS unsigned char* slot = lds + (c % NS) * 16384;
            bf16x8 f[4];
            f[0] = pack8c(H0[0], H0[1], H0[2], H0[3], H0[4], H0[5], H0[6], H0[7]); f[1] = pack8c(H0[8], H0[9], H0[10], H0[11], H0[12], H0[13], H0[14], H0[15]);
            f[2] = pack8c(H1[0], H1[1], H1[2], H1[3], H1[4], H1[5], H1[6], H1[7]); f[3] = pack8c(H1[8], H1[9], H1[10], H1[11], H1[12], H1[13], H1[14], H1[15]);
            const u32x4 g00 = *(const LAS u32x4*)(slot + 8192 + (w * 2 + 0) * 2048 + lane * 16), g01 = *(const LAS u32x4*)(slot + 8192 + (w * 2 + 0) * 2048 + 1024 + lane * 16);
            const u32x4 g10 = *(const LAS u32x4*)(slot + 8192 + (w * 2 + 1) * 2048 + lane * 16), g11 = *(const LAS u32x4*)(slot + 8192 + (w * 2 + 1) * 2048 + 1024 + lane * 16);
            f32x16 n0, n1;
            { const unsigned ww[8] = {g00.x, g00.y, g00.z, g00.w, g01.x, g01.y, g01.z, g01.w};
#pragma unroll
              for (int q = 0; q < 8; ++q) { n0[2 * q] = bf_lo(ww[q]); n0[2 * q + 1] = bf_hi(ww[q]); } }
            { const unsigned ww[8] = {g10.x, g10.y, g10.z, g10.w, g11.x, g11.y, g11.z, g11.w};
#pragma unroll
              for (int q = 0; q < 8; ++q) { n1[2 * q] = bf_lo(ww[q]); n1[2 * q + 1] = bf_hi(ww[q]); } }
#pragma unroll
            for (int ks = 0; ks < 4; ++ks) { n0 = __builtin_amdgcn_mfma_f32_32x32x16_bf16(*(const LAS bf16x8*)(slot + (0 * 4 + ks) * 1024 + lane * 16), f[ks], n0, 0, 0, 0);
                                             n1 = __builtin_amdgcn_mfma_f32_32x32x16_bf16(*(const LAS bf16x8*)(slot + (1 * 4 + ks) * 1024 + lane * 16), f[ks], n1, 0, 0, 0); }
            unsigned char* hdst = GF + (size_t)c * 8192;
#pragma unroll
            for (int ks = 0; ks < 4; ++ks) *(u32x4*)(hdst + ((w * 4 + ks) * 64 + lane) * 16) = __builtin_bit_cast(u32x4, f[ks]);
            H0 = n0; H1 = n1;
        }
    }
    asm volatile("s_waitcnt vmcnt(0)" ::: "memory");
    lds_barrier();
}

__device__ __forceinline__ void stage_c(KArgs a, LAS unsigned char* lds, int bid, int nb) {
    const int tid = opaque_tid(), lane = tid & 63, w = __builtin_amdgcn_readfirstlane(tid >> 6), r = lane & 31, h = lane >> 5;
    const unsigned char* HF = a->ws + R0; bf16_t* Yg = (bf16_t*)(a->ws + R6);
    const bf16_t* Vg = (const bf16_t*)(a->ws + R3); const bf16_t* Gg = (const bf16_t*)a->out + (size_t)T * D;
    const LAS float* bon = (const LAS float*)(lds + MISC) + 64;
    LAS float* yb = (LAS float*)(lds + S_AP0 * SLOT); constexpr int YS = 68;
    const int per = (NB * 16 * 128 + nb - 1) / nb, item0 = bid * per, item1 = (item0 + per < NB * 16 * 128) ? item0 + per : NB * 16 * 128;
    Raw RW; if (item0 < item1) raw_load<true>(a, RW, item0, tid);
    tri_init(lds, tid);
    if (item0 < item1) { lwt_store(lds, RW.e, w, lane); lds_barrier(); if (w < 4) cumsum_tile(lds, w, r, h); }
    for (int item = item0; item < item1; ++item) {
        const int bh = item >> 7, c = item & 127, b = bh >> 4, hd = bh & 15;
        lds_barrier();
        u32x4 pvv; chunk_front<true>(a, lds, b, hd, c, tid, RW, (item + 1 < item1) ? item + 1 : -1, pvv);
        const int ptk = 8 * w + (lane >> 3), pcg = lane & 7;
        const size_t po = ((size_t)b * S + c * 64 + ptk) * D + hd * 64 + pcg * 8;
        const u32x4 pgv = *(const u32x4*)(Gg + po);
        const int ytile = w - 4, rtile = (w == 0) ? 0 : (w == 1) ? 1 : (w == 3) ? 2 : (w == 5) ? 3 : -1;
        const int tjw = (w >= 4) ? (w & 1) : (w == 1 ? 1 : 0);
        bf16x8 hf[4];
        { const unsigned char* hsrc = HF + (size_t)item * 8192;
#pragma unroll
          for (int ks = 0; ks < 4; ++ks) hf[ks] = *(const bf16x8*)(hsrc + ((tjw * 4 + ks) * 64 + lane) * 16); }
        f32x16 y = zero16();
        if (w == 2) t10_step(lds, r, h);
        if (w >= 4) { const int ti = (ytile >> 1) & 1;
#pragma unroll
            for (int ks = 0; ks < 4; ++ks) y = __builtin_amdgcn_mfma_f32_32x32x16_bf16(*(const LAS bf16x8*)(lds + S_RT * SLOT + (32 * ti + r) * RB + (16 * ks + 8 * h) * 2), hf[ks], y, 0, 0, 0);
            y = mm<false, true>(y, lds + S_ARK * SLOT, 32 * ti, lds + S_VT * SLOT, 32 * tjw, r, h, 4); }
        if (rtile >= 0) { const int ti = (rtile >> 1) & 1; f32x16 x = zero16();
#pragma unroll
            for (int ks = 0; ks < 4; ++ks) x = __builtin_amdgcn_mfma_f32_32x32x16_bf16(*(const LAS bf16x8*)(lds + S_AT * SLOT + (32 * ti + r) * RB + (16 * ks + 8 * h) * 2), hf[ks], x, 0, 0, 0);
            x = mm<false, true>(x, lds + S_AAK * SLOT, 32 * ti, lds + S_VT * SLOT, 32 * tjw, r, h, 4);
            write_T(lds + S_XT0 * SLOT, 32 * tjw, 32 * ti, x, r, h); }
        lds_barrier();
        if (item + 1 < item1) lwt_store(lds, RW.e, w, lane);
        if (w < 4) { const int ti = (w >> 1) & 1, tj = w & 1; f32x16 u = zero16(); u = mm(u, lds + S_TM * SLOT, 32 * ti, lds + S_XT0 * SLOT, 32 * tj, r, h, 4); write_T(lds + S_APT0 * SLOT, 32 * tj, 32 * ti, u, r, h); }
        lds_barrier();
        if (w < 4 && item + 1 < item1) cumsum_tile(lds, w, r, h);
        if (w >= 4) { const int ti = (ytile >> 1) & 1; y = mm(y, lds + S_ARB * SLOT, 32 * ti, lds + S_APT0 * SLOT, 32 * tjw, r, h, 4);
#pragma unroll
            for (int q = 0; q < 16; ++q) yb[(32 * ti + rowmap(q, h)) * YS + 32 * tjw + r] = y[q]; }
        lds_barrier();
        {
            const int ch = hd * 64 + pcg * 8;
            const f32x4 y0 = *(const LAS f32x4*)(yb + ptk * YS + pcg * 8), y1 = *(const LAS f32x4*)(yb + ptk * YS + pcg * 8 + 4);
            const f32x4 g0 = *(const f32x4*)(a->in[I_LNG] + ch), g1 = *(const f32x4*)(a->in[I_LNG] + ch + 4), b0 = *(const f32x4*)(a->in[I_LNB] + ch), b1 = *(const f32x4*)(a->in[I_LNB] + ch + 4);
            const float mean = sum8(((y0[0] + y0[1]) + (y0[2] + y0[3])) + ((y1[0] + y1[1]) + (y1[2] + y1[3]))) * (1.0f / 64.0f);
            const f32x4 d0 = y0 - mean, d1 = y1 - mean;
            const float var = sum8(((d0[0] * d0[0] + d0[1] * d0[1]) + (d0[2] * d0[2] + d0[3] * d0[3])) + ((d1[0] * d1[0] + d1[1] * d1[1]) + (d1[2] * d1[2] + d1[3] * d1[3]))) * (1.0f / 64.0f);
            const float rs = __builtin_amdgcn_rsqf(var + 64e-5f), bn = bon[ptk];
            const f32x4 v0 = (f32x4){bf_lo(pvv.x), bf_hi(pvv.x), bf_lo(pvv.y), bf_hi(pvv.y)}, v1 = (f32x4){bf_lo(pvv.z), bf_hi(pvv.z), bf_lo(pvv.w), bf_hi(pvv.w)};
            const f32x4 q0 = (f32x4){bf_lo(pgv.x), bf_hi(pgv.x), bf_lo(pgv.y), bf_hi(pgv.y)}, q1 = (f32x4){bf_lo(pgv.z), bf_hi(pgv.z), bf_lo(pgv.w), bf_hi(pgv.w)};
            const f32x4 o0 = ((d0 * rs) * g0 + b0 + v0 * bn) * q0, o1 = ((d1 * rs) * g1 + b1 + v1 * bn) * q1;
            *(u32x4*)(Yg + po) = pack8(o0, o1);
        }
    }
    __syncthreads();
}
}

template <bool DIAG>
__device__ __forceinline__ void sb_block(const f32x16& s, const bf16x8 (&tri)[2], float R, int r, int hh, bf16x8& pb0, bf16x8& pb1, float& tsum) {
    f32x2 X2[8], zr2[8], ts2 = {0.f, 0.f};
#pragma unroll
    for (int qp = 0; qp < 8; ++qp) { const int q0 = 2 * qp, q1 = q0 + 1; const f32x2 z2 = {s[q0], s[q1]};
        const f32x2 e2 = {__builtin_amdgcn_exp2f(-fabsf(z2.x)), __builtin_amdgcn_exp2f(-fabsf(z2.y))};
        const f32x2 u2 = e2 + 1.0f;
        const f32x2 l2 = {__builtin_amdgcn_logf(u2.x), __builtin_amdgcn_logf(u2.y)}, m2 = {fmaxf(z2.x, 0.f), fmaxf(z2.y, 0.f)};
        const f32x2 sp2 = m2 + l2;
        f32x2 x2 = -sp2;
        if (DIAG) { const int k0 = (q0 & 3) + 8 * (q0 >> 2) + 4 * hh, k1 = (q1 & 3) + 8 * (q1 >> 2) + 4 * hh; x2.x = (k0 < r) ? x2.x : 0.f; x2.y = (k1 < r) ? x2.y : 0.f; }
        X2[qp] = x2; ts2 += x2; zr2[qp] = (z2 - sp2) + R; }
    tsum = ts2.x + ts2.y;
    const bf16x8 xb0 = pack8c(X2[0].x, X2[0].y, X2[1].x, X2[1].y, X2[2].x, X2[2].y, X2[3].x, X2[3].y), xb1 = pack8c(X2[4].x, X2[4].y, X2[5].x, X2[5].y, X2[6].x, X2[6].y, X2[7].x, X2[7].y);
    f32x16 c = rw::zero16();
    c = __builtin_amdgcn_mfma_f32_32x32x16_bf16(tri[0], xb0, c, 0, 0, 0); c = __builtin_amdgcn_mfma_f32_32x32x16_bf16(tri[1], xb1, c, 0, 0, 0);
    float P[16];
#pragma unroll
    for (int qp = 0; qp < 8; ++qp) { const int q0 = 2 * qp, q1 = q0 + 1; const f32x2 a2 = zr2[qp] + (f32x2){c[q0], c[q1]};
        float p0 = __builtin_amdgcn_exp2f(a2.x), p1 = __builtin_amdgcn_exp2f(a2.y);
        if (DIAG) { const int k0 = (q0 & 3) + 8 * (q0 >> 2) + 4 * hh, k1 = (q1 & 3) + 8 * (q1 >> 2) + 4 * hh; p0 = (k0 < r) ? p0 : 0.f; p1 = (k1 < r) ? p1 : 0.f; }
        P[q0] = p0; P[q1] = p1; }
    pb0 = pack8c(P[0], P[1], P[2], P[3], P[4], P[5], P[6], P[7]); pb1 = pack8c(P[8], P[9], P[10], P[11], P[12], P[13], P[14], P[15]);
}
__device__ __forceinline__ void sbattn_phase(KArgs a, LAS unsigned char* lds, int bid, int nb) {
    const int tid = opaque_tid(), lane = tid & 63, w = __builtin_amdgcn_readfirstlane(tid >> 6), r = lane & 31, hh = lane >> 5;
    constexpr int NR = 10, KROWB = 144, KBLK = 32 * KROWB, VROWB = 192, VBLK = 32 * VROWB;
    LAS unsigned char* Kr = lds; LAS unsigned char* Vr = lds + NR * KBLK; LAS unsigned char* Ost = Vr + NR * VBLK; volatile LAS int* flag = (volatile LAS int*)(Ost + 8 * 4608);
    const bf16_t* Kg = (const bf16_t*)(a->ws + R2); const bf16_t* Vg = (const bf16_t*)(a->ws + R3); const bf16_t* Qg = (const bf16_t*)(a->ws + R4); bf16_t* Og = (bf16_t*)(a->ws + R0);
    bf16x8 tri[2];
#pragma unroll
    for (int ks = 0; ks < 2; ++ks) {
#pragma unroll
        for (int jj = 0; jj < 8; ++jj) { const int key = 16 * ks + 8 * (jj >> 2) + 4 * hh + (jj & 3); tri[ks][jj] = (key > r) ? (short)0x3F80 : (short)0; } }
    const int skey = (tid & 255) >> 3, sch = tid & 7; const bool isv = tid >= 256;
    u32x4 pre[8];
#define SB_REQUEST(unit_) do { const int u_ = (unit_); const int b_ = u_ >> 9, h_ = (u_ >> 5) & 15, qt_ = u_ & 31; const size_t hb_ = (size_t)b_ * S * D + h_ * 64; \
        _Pragma("unroll") for (int m = 0; m < 8; ++m) { const size_t go = hb_ + (size_t)((qt_ * 8 + m) * 32 + skey) * D + sch * 8; pre[m] = isv ? *(const u32x4*)(Vg + go) : *(const u32x4*)(Kg + go); } } while (0)
    if (bid < NB * 16 * 32) SB_REQUEST(bid);
    for (int unit = bid; unit < NB * 16 * 32; unit += nb) {
        const int b = unit >> 9, h = (unit >> 5) & 15, qt = unit & 31, q0 = qt * 256, kb0 = qt * 8;
        const size_t hbase = (size_t)b * S * D + h * 64;
        lds_barrier();
        if (tid < 3) flag[tid] = 0;
        bf16x8 Qf[4];
        { const bf16_t* qp = Qg + hbase + (size_t)(q0 + 32 * w + r) * D + 8 * hh;
#pragma unroll
          for (int ks = 0; ks < 4; ++ks) Qf[ks] = *(const bf16x8*)(qp + 16 * ks); }
        {
#pragma unroll
            for (int m = 0; m < 8; ++m) { const int slot = (kb0 + m) % NR; const u32x4 v = pre[m];
                if (!isv) *(LAS u32x4*)(Kr + slot * KBLK + skey * KROWB + sch * 16) = v;
                else *(LAS u32x4*)(Vr + slot * VBLK + skey * VROWB + sch * 16) = v; }
        }
        f32x16 o0, o1;
#pragma unroll
        for (int i = 0; i < 16; ++i) { o0[i] = 0.f; o1[i] = 0.f; }
        float R = 0.f; bool wdone = false;
        u32x4 sg0 = (u32x4){0u, 0u, 0u, 0u}, sg1 = sg0, sg2 = sg0;
        { const int n0 = kb0 - 1, n1 = kb0 - 2, n2 = kb0 - 3;
          if (n0 >= 0) { const size_t go = hbase + (size_t)(n0 * 32 + skey) * D + sch * 8; sg0 = isv ? *(const u32x4*)(Vg + go) : *(const u32x4*)(Kg + go); }
          if (n1 >= 0) { const size_t go = hbase + (size_t)(n1 * 32 + skey) * D + sch * 8; sg1 = isv ? *(const u32x4*)(Vg + go) : *(const u32x4*)(Kg + go); }
          if (n2 >= 0) { const size_t go = hbase + (size_t)(n2 * 32 + skey) * D + sch * 8; sg2 = isv ? *(const u32x4*)(Vg + go) : *(const u32x4*)(Kg + go); } }
        if (unit + nb < NB * 16 * 32) SB_REQUEST(unit + nb);
        for (int i = 0;; ++i) {
            lds_barrier();
            if (i > 0 && flag[(i - 1) % 3] == 0) break;
            if (tid == 0) flag[(i + 1) % 3] = 0;
            const int nblk = kb0 - i - 1;
            const u32x4 stg = sg0; sg0 = sg1; sg1 = sg2;
            { const int nf = kb0 - i - 4; sg2 = (u32x4){0u, 0u, 0u, 0u};
              if (nf >= 0) { const size_t go = hbase + (size_t)(nf * 32 + skey) * D + sch * 8; sg2 = isv ? *(const u32x4*)(Vg + go) : *(const u32x4*)(Kg + go); } }
            const int kb = kb0 + w - i;
            if (!wdone && kb >= 0) {
                const int slot = kb % NR;
                f32x16 s;
#pragma unroll
                for (int q = 0; q < 16; ++q) s[q] = 0.f;
#pragma unroll
                for (int ks = 0; ks < 4; ++ks) { const bf16x8 kf = *(const LAS bf16x8*)(Kr + slot * KBLK + r * KROWB + (16 * ks + 8 * hh) * 2); s = __builtin_amdgcn_mfma_f32_32x32x16_bf16(kf, Qf[ks], s, 0, 0, 0); }
                bf16x8 pb0, pb1; float tsum;
                if (i == 0) sb_block<true>(s, tri, R, r, hh, pb0, pb1, tsum); else sb_block<false>(s, tri, R, r, hh, pb0, pb1, tsum);
                const LAS unsigned char* vbase = Vr + slot * VBLK + (4 * hh + ((lane & 15) >> 2)) * VROWB + (16 * ((lane >> 4) & 1) + 4 * (lane & 3)) * 2;
#define SB_VT(s_, c_) __builtin_shufflevector(__builtin_amdgcn_ds_read_tr16_b64_v4i16((LAS s16x4*)(vbase + (16 * (s_)) * VROWB + 64 * (c_))), __builtin_amdgcn_ds_read_tr16_b64_v4i16((LAS s16x4*)(vbase + (16 * (s_) + 8) * VROWB + 64 * (c_))), 0, 1, 2, 3, 4, 5, 6, 7)
                { const bf16x8 v00 = SB_VT(0, 0), v10 = SB_VT(1, 0);
                  o0 = __builtin_amdgcn_mfma_f32_32x32x16_bf16(v00, pb0, o0, 0, 0, 0);
                  o0 = __builtin_amdgcn_mfma_f32_32x32x16_bf16(v10, pb1, o0, 0, 0, 0); }
                __builtin_amdgcn_sched_barrier(0);
                { const bf16x8 v01 = SB_VT(0, 1), v11 = SB_VT(1, 1);
                  o1 = __builtin_amdgcn_mfma_f32_32x32x16_bf16(v01, pb0, o1, 0, 0, 0);
                  o1 = __builtin_amdgcn_mfma_f32_32x32x16_bf16(v11, pb1, o1, 0, 0, 0); }
#undef SB_VT
                tsum += __shfl_xor(tsum, 32); R += tsum;
                wdone = (kb == 0) || (__builtin_amdgcn_ballot_w64(R >= -160.0f) == 0ull);
                if (!wdone && lane == 0) flag[i % 3] = 1;
            }
            if (nblk >= 0) { const int slot = nblk % NR;
                if (!isv) *(LAS u32x4*)(Kr + slot * KBLK + skey * KROWB + sch * 16) = stg;
                else *(LAS u32x4*)(Vr + slot * VBLK + skey * VROWB + sch * 16) = stg; }
        }
        { LAS bf16_t* ow = (LAS bf16_t*)(Ost + w * 4608);
#pragma unroll
          for (int m = 0; m < 4; ++m) { u32x2 wa, wb; wa.x = cvt_pk_c(o0[4 * m], o0[4 * m + 1]); wa.y = cvt_pk_c(o0[4 * m + 2], o0[4 * m + 3]); wb.x = cvt_pk_c(o1[4 * m], o1[4 * m + 1]); wb.y = cvt_pk_c(o1[4 * m + 2], o1[4 * m + 3]);
              *(LAS u32x2*)(ow + r * 72 + 8 * m + 4 * hh) = wa; *(LAS u32x2*)(ow + r * 72 + 32 + 8 * m + 4 * hh) = wb; }
          asm volatile("s_waitcnt lgkmcnt(0)" ::: "memory");
#pragma unroll
          for (int c4 = 0; c4 < 4; ++c4) { const int idx = c4 * 64 + lane, row = idx >> 3, ch = idx & 7; const u32x4 v = *(const LAS u32x4*)(ow + row * 72 + ch * 8);
              *(u32x4*)(Og + hbase + (size_t)(q0 + 32 * w + row) * D + ch * 8) = v; }
          asm volatile("s_waitcnt lgkmcnt(0)" ::: "memory"); }
    }
#undef SB_REQUEST
    __syncthreads();
}

__device__ __forceinline__ void assign_phase(KArgs a, int l, LAS unsigned char* lds, int bid, int nb) {
    const int tid = opaque_tid(), lane = tid & 63, wave = tid >> 6;
    LAS int* pst = (LAS int*)lds; LAS int* lc = pst + 64; LAS int* lbase = lc + 32; LAS int* a_tok = lbase + 32; LAS int* a_slot = a_tok + 512;
    unsigned* ctl = (unsigned*)a->ws;
    if (tid == 0) { int accv = 0; for (int e = 0; e < 32; ++e) { pst[e] = accv; accv += (int)((__hip_atomic_load(ctl + CW_CNT + 64 * l + e, __ATOMIC_RELAXED, __HIP_MEMORY_SCOPE_AGENT) + 255u) / 256u * 256u); } pst[32] = accv; }
    if (tid < 32) lc[tid] = 0;
    __syncthreads();
    int* tile_expert = (int*)(a->ws + WS_TILEEXP);
    if (bid == 0) { const int ntl = pst[32] >> 8; if (tid == 0) ctl[CW_NT + 64 * l] = (unsigned)ntl;
        for (int ti = tid; ti < ntl; ti += 512) { int e = 0; for (int q = 1; q < 32; ++q) if (pst[q] <= ti * 256) e = q; tile_expert[ti] = e; } }
    const u32x4* tok = (const u32x4*)(a->ws + WS_TOK); int* slot_of = (int*)(a->ws + WS_SLOTOF); float* slot_info = (float*)(a->ws + WS_SLOTINFO);
    int* slot_tok = (int*)(a->ws + WS_SLOTTOK);
    for (int chunk = bid; chunk < T / 256; chunk += nb) {
        const int t = chunk * 256 + (tid >> 1), kk = tid & 1;
        const u32x4 info = tok[t]; const int e = kk ? (int)((info.x >> 8) & 0xff) : (int)(info.x & 0xff);
        const unsigned gbits = kk ? info.z : info.y, rbits = info.w;
        const float gate = __uint_as_float(gbits), rstd = __uint_as_float(rbits);
        const int rank = atomicAdd((int*)&lc[e], 1);
        __syncthreads();
        if (tid < 32) lbase[tid] = (int)__hip_atomic_fetch_add(ctl + CW_FILL + 64 * l + tid, (unsigned)lc[tid], __ATOMIC_RELAXED, __HIP_MEMORY_SCOPE_AGENT);
        __syncthreads();
        const int slot = pst[e] + lbase[e] + rank;
        slot_of[t * 2 + kk] = slot; slot_info[(size_t)slot * 2] = gate; slot_info[(size_t)slot * 2 + 1] = rstd; slot_tok[slot] = t;
        __syncthreads();
        if (tid < 32) lc[tid] = 0;
        __syncthreads();
    }
}

__device__ __forceinline__ void combine_phase(KArgs a, bool fin, int bid, int nb, float msc = 1.f) {
    const int tid = opaque_tid(), lane = tid & 63, wave = tid >> 6;
    float* x = a->out; const bf16_t* ys = (const bf16_t*)(a->ws + R2); const int* slot_of = (const int*)(a->ws + WS_SLOTOF);
    bf16_t* xb = (bf16_t*)(a->ws + R1); float* ssq = (float*)(a->ws + WS_SSQ); const float* nf = a->in[I_NORM_FINAL];
    u32x4 px[2], py1[2], py2[2];
    { const int row0 = bid * 8 + wave; const int s1 = slot_of[row0 * 2], s2 = slot_of[row0 * 2 + 1];
#pragma unroll
      for (int k = 0; k < 2; ++k) { px[k] = *(const u32x4*)(xb + (size_t)row0 * D + k * 512 + lane * 8); py1[k] = *(const u32x4*)(ys + (size_t)s1 * D + k * 512 + lane * 8); py2[k] = *(const u32x4*)(ys + (size_t)s2 * D + k * 512 + lane * 8); } }
    for (int row = bid * 8 + wave; row < T; row += nb * 8) {
        f32x4 xv[4]; float ss = 0.f;
        const int nrow = (row + nb * 8 < T) ? row + nb * 8 : row; const int ns1 = slot_of[nrow * 2], ns2 = slot_of[nrow * 2 + 1];
#pragma unroll
        for (int k = 0; k < 2; ++k) { u32x4 xw, y1, y2;
            xw.x = pin_u32(px[k].x); xw.y = pin_u32(px[k].y); xw.z = pin_u32(px[k].z); xw.w = pin_u32(px[k].w); y1.x = pin_u32(py1[k].x); y1.y = pin_u32(py1[k].y); y1.z = pin_u32(py1[k].z); y1.w = pin_u32(py1[k].w);
            y2.x = pin_u32(py2[k].x); y2.y = pin_u32(py2[k].y); y2.z = pin_u32(py2[k].z); y2.w = pin_u32(py2[k].w);
            const float ms = msc;
            xv[2 * k] = (f32x4){bf_lo(xw.x) + ms * (bf_lo(y1.x) + bf_lo(y2.x)), bf_hi(xw.x) + ms * (bf_hi(y1.x) + bf_hi(y2.x)), bf_lo(xw.y) + ms * (bf_lo(y1.y) + bf_lo(y2.y)), bf_hi(xw.y) + ms * (bf_hi(y1.y) + bf_hi(y2.y))};
            xv[2 * k + 1] = (f32x4){bf_lo(xw.z) + ms * (bf_lo(y1.z) + bf_lo(y2.z)), bf_hi(xw.z) + ms * (bf_hi(y1.z) + bf_hi(y2.z)), bf_lo(xw.w) + ms * (bf_lo(y1.w) + bf_lo(y2.w)), bf_hi(xw.w) + ms * (bf_hi(y1.w) + bf_hi(y2.w))};
            ss += ((xv[2 * k][0] * xv[2 * k][0] + xv[2 * k][1] * xv[2 * k][1]) + (xv[2 * k][2] * xv[2 * k][2] + xv[2 * k][3] * xv[2 * k][3])) + ((xv[2 * k + 1][0] * xv[2 * k + 1][0] + xv[2 * k + 1][1] * xv[2 * k + 1][1]) + (xv[2 * k + 1][2] * xv[2 * k + 1][2] + xv[2 * k + 1][3] * xv[2 * k + 1][3])); }
        if (nrow != row) {
#pragma unroll
            for (int k = 0; k < 2; ++k) { px[k] = *(const u32x4*)(xb + (size_t)nrow * D + k * 512 + lane * 8); py1[k] = *(const u32x4*)(ys + (size_t)ns1 * D + k * 512 + lane * 8); py2[k] = *(const u32x4*)(ys + (size_t)ns2 * D + k * 512 + lane * 8); } }
        ss = wave_sum(ss);
        if (fin) { const float rstd = __builtin_amdgcn_rsqf(ss * (1.0f / D) + NORM_EPS);
#pragma unroll
            for (int k = 0; k < 2; ++k) { const f32x4 ga = *(const f32x4*)(nf + k * 512 + lane * 8), gb = *(const f32x4*)(nf + k * 512 + lane * 8 + 4);
                *(f32x4*)(x + (size_t)row * D + k * 512 + lane * 8) = xv[2 * k] * rstd * ga; *(f32x4*)(x + (size_t)row * D + k * 512 + lane * 8 + 4) = xv[2 * k + 1] * rstd * gb; } }
        else {
#pragma unroll
            for (int k = 0; k < 2; ++k) *(u32x4*)(xb + (size_t)row * D + k * 512 + lane * 8) = pack8v4(xv[2 * k], xv[2 * k + 1]);
            if (lane < 16) ssq[(size_t)row * 16 + lane] = lane == 0 ? ss : 0.f; }
    }
}

#define GRID_BAR() do { XcdBarrier b_; b_.bar = (unsigned*)a->ws + CW_BAR; b_.x = xb_xcc_id(); b_.st = (volatile LAS unsigned*)(lds + LDS_MISC) + 8; xcd_barrier(b_); } while (0)
#define IN(k) true
#define SEAM(k) do { if (IN(k) && IN((k) + 1)) GRID_BAR(); } while (0)
template <int l> __device__ __forceinline__ void layer_body(KArgs a, LAS unsigned char* lds, const int lo, const int hi) {
    const int bid = blockIdx.x, nb = gridDim.x; unsigned char* ws = a->ws;

        const int pb = 1 + 13 * l;
        if constexpr (l == 0) {
            if (IN(pb + 0)) {
                { pg8::Gemm g{(const bf16_t*)ws, (const bf16_t*)(ws + WS_WCAT), D, D, D};
                  SchedRKV Sd; Sd.init(T / 256, 12, nb, bid); Sd.aoff0 = (long long)R6; Sd.aoff1 = (long long)((const unsigned char*)a->out - ws);
                  EpiCat E{(bf16_t*)(ws + R1), (bf16_t*)(ws + R5), (long long)(R2 - R1) / 2, 0};
                  pg8::gemm_phase(lds, g, Sd, E); }
                { pg8::Gemm g{(const bf16_t*)(ws + R0), (const bf16_t*)(ws + WS_WCAT) + (size_t)3072 * 2 * D, D, 2 * D, 2 * D};
                  SchedHP Sd; Sd.init(T / 256, 2, nb, bid);
                  EpiCat E{(bf16_t*)(ws + R1), (bf16_t*)(ws + R5), (long long)(R2 - R1) / 2, 12};
                  pg8::gemm_phase(lds, g, Sd, E); }
            }
            SEAM(pb + 0);
            if (IN(pb + 1)) {
                { pg8::Gemm g{(const bf16_t*)(ws + R5), (const bf16_t*)(ws + WS_WWA2), 512, 256, 256};
                  SchedPlain Sd; Sd.init(T / 256, 8, nb, bid); Sd.astr = (long long)256 * 512 * 2; Sd.bstr = (long long)256 * 256 * 2;
                  const float* b0 = a->in[I_W0]; const float* b1 = a->in[I_A0]; bf16_t* o0 = (bf16_t*)(ws + R4); bf16_t* o1 = (bf16_t*)a->out;
                  EpiAct E{o0, (long long)(o1 - o0), b0, (long long)(b1 - b0), -0.60653066f, 1.60653066f};
                  pg8::gemm_phase(lds, g, Sd, E); }
            }
            SEAM(pb + 1);
            if (IN(pb + 2)) {
                rw::stage_a(a, lds, bid, nb);
                GRID_BAR();
                if (bid < 128) rw::stage_b(a, lds, bid);
                else {
                    pg8::Gemm g{(const bf16_t*)(ws + WS_MN), (const bf16_t*)(ws + WS_WMKV), D, D, D};
                    SchedMemKV Sd; Sd.init(16, 8, nb - 128, bid - 128);
                    EpiMemKV E{(bf16_t*)(ws + WS_KMEM), (bf16_t*)(ws + WS_VT)};
                    pg8::gemm_phase(lds, g, Sd, E); }
                {
                    constexpr int NU = (T / 256) * 4, NSCAN = NU * 2 / 8;
                    pg8::Gemm g{(const bf16_t*)(ws + R5) + 256, (const bf16_t*)(ws + WS_WG2), 512, 256, 256};
                    SchedRange Sd; Sd.init(T / 256, 4, bid < 128 ? 128 : nb - 128, bid < 128 ? bid : bid - 128); Sd.astr = (long long)256 * 512 * 2; Sd.bstr = (long long)256 * 256 * 2;
                    Sd.base = bid < 128 ? 0 : NSCAN; Sd.count = bid < 128 ? NSCAN : NU - NSCAN;
                    EpiAct E{(bf16_t*)a->out + (size_t)T * D, 0, nullptr, 0, 1.f, 0.f};
                    pg8::gemm_phase(lds, g, Sd, E); }
                GRID_BAR();
                rw::stage_c(a, lds, bid, nb);
            }
            SEAM(pb + 2);
        } else {
            if (IN(pb + 0)) {
                pg8::Gemm g{(const bf16_t*)(ws + R1), (const bf16_t*)(ws + WS_WKVQ), D, D, D};
                SchedPlain Sd; Sd.init(T / 256, 12, nb, bid); Sd.astr = (long long)256 * D * 2; Sd.bstr = (long long)256 * D * 2;
                EpiRstd E{(bf16_t*)(ws + R2), (long long)(R3 - R2) / 2, (const float*)(ws + WS_SSQ)};
                pg8::gemm_phase(lds, g, Sd, E);
            }
            SEAM(pb + 0);
            if (IN(pb + 1)) { sbattn_phase(a, lds, bid, nb);
            }
            if (IN(pb + 1) && IN(pb + 3)) GRID_BAR();
        }
        if (IN(pb + 3)) {
            pg8::Gemm g{(const bf16_t*)(ws + (l ? R0 : R6)), (const bf16_t*)(ws + (l ? WS_WOSB : WS_WO0)), D, D, D};
            SchedPlain Sd; Sd.init(T / 256, 4, nb, bid); Sd.astr = (long long)256 * D * 2; Sd.bstr = (long long)256 * D * 2;
            EpiResid E{l ? (const float*)nullptr : a->in[I_X], (bf16_t*)(ws + R1), (float*)(ws + WS_SSQ), 1.f};
            pg8::gemm_phase(lds, g, Sd, E);
            if constexpr (l == 0) {
                { pg8::Gemm g2{(const bf16_t*)(ws + WS_KMEM), (const bf16_t*)(ws + WS_WMQ), D, D, 256};
                  SchedMemPre S2; S2.init(64, 4, nb, bid); S2.mode = 0; EpiMemPre E2{(bf16_t*)a->out};
                  pg8::gemm_phase(lds, g2, S2, E2); }
                { pg8::Gemm g2{(const bf16_t*)(ws + WS_WMO), (const bf16_t*)(ws + WS_VT), D, D, 256};
                  SchedMemPre S2; S2.init(64, 4, nb, bid); S2.mode = 1; EpiMemPre E2{(bf16_t*)a->out + (size_t)16 * D * D};
                  pg8::gemm_phase(lds, g2, S2, E2); } }
        }
        SEAM(pb + 3);
        if (IN(pb + 4)) {
            pg8::Gemm g{(const bf16_t*)(ws + R1), (const bf16_t*)a->out + (size_t)l * 8 * D * D, D, D, D};
            SchedBatchB Sd; Sd.init(T / 256, 4, nb, bid);
            EpiSoftmax E{(bf16_t*)(ws + R2), (const float*)(ws + WS_SSQ)};
            pg8::gemm_phase(lds, g, Sd, E);
        }
        SEAM(pb + 4);
        if (IN(pb + 7)) {
            pg8::Gemm g{(const bf16_t*)(ws + R2), (const bf16_t*)a->out + (size_t)(16 + l * 8) * D * D, D, D, D};
            SchedBatchB Sd; Sd.init(T / 256, 4, nb, bid);
            EpiResid E{(const float*)nullptr, (bf16_t*)(ws + R1), (float*)(ws + WS_SSQ), 1.f};
            pg8::gemm_phase(lds, g, Sd, E);
        }
        SEAM(pb + 7);
        if (IN(pb + 8)) {
            LAS int* lc = (LAS int*)(lds + LDS_EPI + 4096);
            if (threadIdx.x < 32) lc[threadIdx.x] = 0;
            __syncthreads();
            { pg8::Gemm g{(const bf16_t*)(ws + R1), (const bf16_t*)(ws + WS_RS) + (size_t)l * 256 * D, D, D, D};
              SchedPlain Sd; Sd.init(T / 256, 1, nb, bid); Sd.astr = (long long)256 * D * 2; Sd.bstr = 0;
              EpiRouter E{(const float*)(ws + WS_SSQ), a->in[I_BRG] + l * 4, a->in[I_BRE] + l * 32, (u32x4*)(ws + WS_TOK)};
              pg8::gemm_phase(lds, g, Sd, E); }
            __syncthreads();
            if (threadIdx.x < 32) atomicAdd((unsigned*)ws + CW_CNT + 64 * l + threadIdx.x, (unsigned)lc[threadIdx.x]);
        }
        SEAM(pb + 8);
        if (IN(pb + 9)) { assign_phase(a, l, lds, bid, nb);
        }
        SEAM(pb + 9);
        if (IN(pb + 10)) {
            const int ntl = (int)__hip_atomic_load((unsigned*)ws + CW_NT + 64 * l, __ATOMIC_RELAXED, __HIP_MEMORY_SCOPE_AGENT);
            pg8::Gemm g{(const bf16_t*)(ws + R1), (const bf16_t*)(ws + WS_WGU) + (size_t)l * 32 * 512 * D, D, D, D};
            SchedMoE Sd; Sd.init(ntl, 2, nb, bid); Sd.tile_expert = (const int*)(ws + WS_TILEEXP); Sd.mode = 0;
            EpiSwiGLU E{(bf16_t*)(ws + R0), (const float*)(ws + WS_SLOTINFO)};
            pg8::gemm_phase_gather(lds, g, Sd, E, (const int*)(ws + WS_SLOTTOK));
        }
        SEAM(pb + 10);
        if (IN(pb + 11)) {
            const int ntl = (int)__hip_atomic_load((unsigned*)ws + CW_NT + 64 * l, __ATOMIC_RELAXED, __HIP_MEMORY_SCOPE_AGENT);
            pg8::Gemm g{(const bf16_t*)(ws + R0), (const bf16_t*)(ws + WS_WDN) + (size_t)l * 32 * D * 256, 256, 256, 256};
            SchedMoE Sd; Sd.init(ntl, 4, nb, bid); Sd.tile_expert = (const int*)(ws + WS_TILEEXP); Sd.mode = 1;
            EpiGate E{(bf16_t*)(ws + R2), (const float*)(ws + WS_SLOTINFO)};
            pg8::gemm_phase(lds, g, Sd, E);
        }
        SEAM(pb + 11);
        combine_phase(a, l == 1, bid, nb);
        if (l == 0) SEAM(pb + 12);
    }
constexpr int NPHASE = 27;
__global__ void __launch_bounds__(512, 2) fwd_kernel(Args a_unused) {
    extern __shared__ __attribute__((aligned(16))) unsigned char lds_raw[];
    LAS unsigned char* lds = (LAS unsigned char*)lds_raw;
    const int tid = threadIdx.x, bid = blockIdx.x, nb = gridDim.x;
    KArgs a = kargs();
    unsigned char* ws = a->ws;
    volatile LAS unsigned* MISC = (volatile LAS unsigned*)(lds + LDS_MISC);
    if (tid < 64) MISC[tid] = 0u;
    __syncthreads();
    (void)xcd_barrier_post((unsigned*)ws + CW_BAR, MISC + 8);
    const int lo = a->ph_lo, hi = a->ph_hi;
    prologue_phase(a, lds, bid, nb);
    SEAM(0);
    layer_body<0>(a, lds, lo, hi);
    layer_body<1>(a, lds, lo, hi);
#undef IN
#undef SEAM
}

extern "C" void kernel_launch(void* const* d_in, const int* in_sizes, int n_in, void* d_out, int out_size, void* d_ws, size_t ws_size, hipStream_t stream) {
    static int grid = 0;
    if (grid == 0) {
        if (n_in != 37 || in_sizes[0] != T * D || out_size != T * D || ws_size < WS_END) { fprintf(stderr, "kernel_launch: unexpected shapes (n_in %d, ws %zu < %zu)\n", n_in, ws_size, (size_t)WS_END); grid = -1; return; }
        int dev = 0, cus = 0, per_cu = 0;
        if (hipGetDevice(&dev) != hipSuccess || hipDeviceGetAttribute(&cus, hipDeviceAttributeMultiprocessorCount, dev) != hipSuccess) { grid = -1; return; }
        if (hipFuncSetAttribute((const void*)fwd_kernel, hipFuncAttributeMaxDynamicSharedMemorySize, LDS_BYTES) != hipSuccess) { fprintf(stderr, "kernel_launch: hipFuncSetAttribute failed\n"); grid = -1; return; }
        if (hipOccupancyMaxActiveBlocksPerMultiprocessor(&per_cu, (const void*)fwd_kernel, 512, LDS_BYTES) != hipSuccess || per_cu < 1) fprintf(stderr, "kernel_launch: occupancy query reports %d\n", per_cu);
        (void)hipGetLastError();
        grid = cus;
    }
    if (grid < 0) return;
    hipMemsetAsync((char*)d_ws + WS_CTL, 0, CTL_BYTES, stream);
    hipMemsetAsync((char*)d_ws + WS_WCAT + (size_t)3072 * 2048 * 2, 0, (size_t)512 * 2048 * 2, stream);
    hipMemsetAsync((char*)d_ws + WS_WWA2, 0, (size_t)3072 * 256 * 2, stream);
    hipMemsetAsync((char*)d_ws + WS_SLOTTOK, 0, (size_t)NSLOT_MAX * 4, stream);
    Args ha{};
    for (int i = 0; i < 37; ++i) ha.in[i] = (const float*)d_in[i];
    ha.out = (float*)d_out; ha.ws = (unsigned char*)d_ws;
    ha.ph_lo = 0; ha.ph_hi = NPHASE;
    hipLaunchKernelGGL(fwd_kernel, dim3(grid), dim3(512), LDS_BYTES, stream, ha);
}
```

```cpp
#include <hip/hip_runtime.h>
#include <cstdio>
#include <cstdint>

#define LAS __attribute__((address_space(3)))
typedef unsigned short bf16_t;
typedef short bf16x8 __attribute__((ext_vector_type(8)));
typedef float f32x4 __attribute__((ext_vector_type(4)));
typedef float f32x2 __attribute__((ext_vector_type(2)));
typedef short s16x4 __attribute__((ext_vector_type(4)));
typedef unsigned u32x4 __attribute__((ext_vector_type(4)));
typedef unsigned u32x2 __attribute__((ext_vector_type(2)));

constexpr int NB = 8, S = 8192, D = 1024, T = NB * S;
constexpr int HP_ROWS = NB * (S + 1);
constexpr int NSLOT_MAX = 2 * T + 32 * 256;
constexpr int NTILE_MAX = NSLOT_MAX / 256;
constexpr float NORM_EPS = 1e-6f;

constexpr size_t MiB = 1u << 20;
constexpr size_t WS_CTL = 0, CTL_BYTES = 1 * MiB;
constexpr size_t WS_WCAT = 1 * MiB;
constexpr size_t WS_WWA2 = WS_WCAT + (size_t)3584 * 2048 * 2;
constexpr size_t WS_WG2 = WS_WWA2 + (size_t)2048 * 256 * 2;
constexpr size_t WS_WO0 = WS_WG2 + (size_t)1024 * 256 * 2;
constexpr size_t WS_WKVQ = WS_WO0 + (size_t)1024 * 1024 * 2;
constexpr size_t WS_WOSB = WS_WKVQ + (size_t)3072 * 1024 * 2;
constexpr size_t WS_WMQ = WS_WOSB + (size_t)1024 * 1024 * 2;
constexpr size_t WS_WMKV = WS_WMQ + (size_t)2 * 1024 * 1024 * 2;
constexpr size_t WS_WMO = WS_WMKV + (size_t)2 * 2048 * 1024 * 2;
constexpr size_t WS_WGU = WS_WMO + (size_t)2 * 1024 * 1024 * 2;
constexpr size_t WS_WDN = WS_WGU + (size_t)2 * 32 * 512 * 1024 * 2;
constexpr size_t WS_WR = WS_WDN + (size_t)2 * 32 * 1024 * 256 * 2;
constexpr size_t WS_WEND = WS_WR + (size_t)2 * 36 * 1024 * 4;
constexpr size_t WS_MN = (WS_WEND + 4095) / 4096 * 4096;
constexpr size_t WS_KMEM = WS_MN + (size_t)2048 * 1024 * 2;
constexpr size_t WS_VT = WS_KMEM + (size_t)2 * 2048 * 1024 * 2;
constexpr size_t WS_SSQ = WS_VT + (size_t)2 * 2048 * 1024 * 2;
constexpr size_t WS_RS = WS_SSQ + (size_t)T * 16 * 4;
constexpr size_t WS_TOK = WS_RS + (size_t)T * 16 * 4;
constexpr size_t WS_SLOTOF = WS_TOK + (size_t)T * 16;
constexpr size_t WS_SLOTINFO = WS_SLOTOF + (size_t)T * 8;
constexpr size_t WS_TILEEXP = WS_SLOTINFO + (size_t)NSLOT_MAX * 8;
constexpr size_t WS_SLOTTOK = WS_TILEEXP + 4096;
constexpr size_t WS_ARENA = (WS_SLOTTOK + (size_t)NSLOT_MAX * 4 + MiB - 1) / MiB * MiB;
constexpr size_t R0 = WS_ARENA;
constexpr size_t R1 = R0 + 129 * MiB;
constexpr size_t R2 = R1 + 128 * MiB;
constexpr size_t R3 = R2 + 128 * MiB;
constexpr size_t R4 = R3 + 128 * MiB;
constexpr size_t R5 = R4 + 128 * MiB;
constexpr size_t R6 = R5 + 64 * MiB;
constexpr size_t WS_END = R6 + 128 * MiB;
static_assert((size_t)HP_ROWS * D * 2 <= 129 * MiB, "hp");
static_assert((size_t)NSLOT_MAX * D * 2 <= 3 * 128 * MiB, "xs/ys");
static_assert(WS_END <= (size_t)1024 * MiB, "workspace over 1 GiB");

constexpr int CW_BAR = 4096;
constexpr int CW_CNT = 16384;
constexpr int CW_FILL = 16384 + 256;
constexpr int CW_NT = 16384 + 512;

constexpr int LDS_BYTES = 161792;
constexpr int LDS_EPI = 131072;
constexpr int LDS_MISC = LDS_BYTES - 256;

__device__ __forceinline__ unsigned f2bf(float f) { unsigned u = __builtin_bit_cast(unsigned, f); return (u + 0x7fffu + ((u >> 16) & 1u)) >> 16; }
typedef __bf16 bf16v2_t __attribute__((ext_vector_type(2)));
__device__ __forceinline__ unsigned cvt_pk_c(float lo, float hi) { const f32x2 v = {lo, hi}; const bf16v2_t b = __builtin_convertvector(v, bf16v2_t); return __builtin_bit_cast(unsigned, b); }
__device__ __forceinline__ unsigned cvt_pk_bf16(float lo, float hi) { return cvt_pk_c(lo, hi); }
typedef float f32x16 __attribute__((ext_vector_type(16)));
__device__ __forceinline__ bf16x8 pack8c(float a0, float a1, float a2, float a3, float a4, float a5, float a6, float a7) {
    u32x4 w; w.x = cvt_pk_c(a0, a1); w.y = cvt_pk_c(a2, a3); w.z = cvt_pk_c(a4, a5); w.w = cvt_pk_c(a6, a7); return __builtin_bit_cast(bf16x8, w); }
__device__ __forceinline__ bf16x8 pack8v(float a0, float a1, float a2, float a3, float a4, float a5, float a6, float a7) {
    u32x4 w; w.x = cvt_pk_bf16(a0, a1); w.y = cvt_pk_bf16(a2, a3); w.z = cvt_pk_bf16(a4, a5); w.w = cvt_pk_bf16(a6, a7); return __builtin_bit_cast(bf16x8, w); }
__device__ __forceinline__ float bf_lo(unsigned w) { return __builtin_bit_cast(float, w << 16); }
__device__ __forceinline__ float bf_hi(unsigned w) { return __builtin_bit_cast(float, w & 0xffff0000u); }
__device__ __forceinline__ float wave_sum_shfl(float v) {
#pragma unroll
    for (int o = 1; o < 64; o <<= 1) v += __shfl_xor(v, o);
    return v;
}
__device__ __forceinline__ float dpp_f(float v, const int ctrl_sel) {
    int x = __builtin_bit_cast(int, v), r;
    if (ctrl_sel == 0) r = __builtin_amdgcn_update_dpp(0, x, 0xB1, 0xF, 0xF, true);
    else if (ctrl_sel == 1) r = __builtin_amdgcn_update_dpp(0, x, 0x4E, 0xF, 0xF, true);
    else if (ctrl_sel == 2) r = __builtin_amdgcn_update_dpp(0, x, 0x141, 0xF, 0xF, true);
    else r = __builtin_amdgcn_update_dpp(0, x, 0x140, 0xF, 0xF, true);
    return __builtin_bit_cast(float, r);
}
__device__ __forceinline__ float sum8(float v) { v += dpp_f(v, 0); v += dpp_f(v, 1); v += dpp_f(v, 2); return v; }
__device__ __forceinline__ float sum16(float v) { v = sum8(v); v += dpp_f(v, 3); return v; }
__device__ __forceinline__ float wave_sum(float v) { v = sum16(v);
    v += __builtin_bit_cast(float, __builtin_amdgcn_update_dpp(0, __builtin_bit_cast(int, v), 0x142, 0xF, 0xF, true));
    v += __builtin_bit_cast(float, __builtin_amdgcn_update_dpp(0, __builtin_bit_cast(int, v), 0x143, 0xF, 0xF, true));
    return __builtin_bit_cast(float, __builtin_amdgcn_readlane(__builtin_bit_cast(int, v), 63)); }
__device__ __forceinline__ float fast_sigmoid(float x) { return __builtin_amdgcn_rcpf(1.0f + __builtin_amdgcn_exp2f(-1.44269504f * x)); }
__device__ __forceinline__ float fast_tanh(float x) { return 1.0f - 2.0f * __builtin_amdgcn_rcpf(1.0f + __builtin_amdgcn_exp2f(2.88539008f * x)); }

__device__ __forceinline__ unsigned pin_u32(unsigned x) { asm volatile("" : "+v"(x)); return x; }
__device__ __forceinline__ int opaque_tid() { int t = threadIdx.x; asm volatile("" : "+v"(t)); return t; }
template <class P> __device__ __forceinline__ P* opaque_ptr(P* p) { asm volatile("" : "+s"(p)); return p; }
__device__ __forceinline__ void lds_barrier() { asm volatile("s_waitcnt lgkmcnt(0)" ::: "memory"); __builtin_amdgcn_s_barrier(); asm volatile("" ::: "memory"); }
#define XB_TMO      128
#define XB_XCNT(j)  (256  + 64 * (j))
#define XB_XSUB(j)  (1280 + 64 * (j))
#define XB_XGEN(j)  (2304 + 64 * (j))
#define XB_TOP      3328
#define XB_TOPGEN   3392
#define XCD_BAR_WORDS 3456
#define XB_SPIN_CAP (1u << 22)
__device__ __forceinline__ unsigned xb_ld(unsigned* p)              { return __hip_atomic_load(p, __ATOMIC_RELAXED, __HIP_MEMORY_SCOPE_AGENT); }
__device__ __forceinline__ unsigned xb_add(unsigned* p, unsigned v) { return __hip_atomic_fetch_add(p, v, __ATOMIC_RELAXED, __HIP_MEMORY_SCOPE_AGENT); }
__device__ __forceinline__ unsigned xb_xcc_id() { return (unsigned)__builtin_amdgcn_s_getreg((3 << 11) | 20) & 0xFu; }
#define XB_SPIN(cond, bar) do { unsigned _sp = 0; while (cond) { __builtin_amdgcn_s_sleep(1); \
    if ((++_sp & 255u) == 0u) { if (xb_ld(&(bar)[XB_TMO])) break; if (_sp > XB_SPIN_CAP) { atomicAdd(&(bar)[XB_TMO], 1u); break; } } } } while (0)
struct XcdBarrier { unsigned* bar; unsigned x; volatile LAS unsigned* st; };
__device__ __forceinline__ XcdBarrier xcd_barrier_post(unsigned* bar, volatile LAS unsigned* st) {
    XcdBarrier b; b.bar = bar; b.x = xb_xcc_id(); b.st = st;
    if (threadIdx.x == 0) (void)xb_add(&bar[XB_XCNT(b.x)], 1u);
    return b;
}
__device__ __forceinline__ void xcd_barrier_complete(unsigned* bar, unsigned x, unsigned& nloc, unsigned& nx) {
    const unsigned G = gridDim.x * gridDim.y * gridDim.z;
    unsigned sum, cnt, mine, sp = 0u;
    for (;;) {
        sum = 0u; cnt = 0u; mine = 0u;
#pragma unroll
        for (unsigned j = 0; j < 16; ++j) { const unsigned c = xb_ld(&bar[XB_XCNT(j)]); sum += c; cnt += (c > 0u) ? 1u : 0u; mine = (j == x) ? c : mine; }
        if (sum == G) break;
        __builtin_amdgcn_s_sleep(1);
        if ((++sp & 255u) == 0u) { if (xb_ld(&bar[XB_TMO])) break; if (sp > XB_SPIN_CAP) { atomicAdd(&bar[XB_TMO], 1u); break; } }
    }
    nloc = mine > 0u ? mine : 1u; nx = cnt > 0u ? cnt : 1u;
}
__device__ __forceinline__ void xcd_barrier(const XcdBarrier& b) {
    asm volatile("s_waitcnt vmcnt(0)" ::: "memory");
    __syncthreads();
    if (threadIdx.x == 0) {
        unsigned* bar = b.bar;
        __builtin_amdgcn_s_waitcnt(0);
        unsigned nloc = b.st[0], nx = b.st[1];
        if (nloc == 0u) { xcd_barrier_complete(bar, b.x, nloc, nx); b.st[0] = nloc; b.st[1] = nx; }
        const unsigned old = xb_add(&bar[XB_XSUB(b.x)], 1u);
        const unsigned gen = old / nloc;
        if (old + 1u == (gen + 1u) * nloc) {
            __builtin_amdgcn_fence(__ATOMIC_RELEASE, "agent");
            asm volatile("s_waitcnt vmcnt(0)" ::: "memory");
            const unsigned og = xb_add(&bar[XB_TOP], 1u);
            const unsigned tg = og / nx;
            if (og + 1u == (tg + 1u) * nx) xb_add(&bar[XB_TOPGEN], 1u);
            else XB_SPIN(xb_ld(&bar[XB_TOPGEN]) == tg, bar);
            __builtin_amdgcn_fence(__ATOMIC_ACQUIRE, "agent");
            xb_add(&bar[XB_XGEN(b.x)], 1u);
            asm volatile("s_waitcnt vmcnt(0)" ::: "memory");
        } else {
            XB_SPIN(xb_ld(&bar[XB_XGEN(b.x)]) == gen, bar);
            __builtin_amdgcn_fence(__ATOMIC_ACQUIRE, "agent");
            asm volatile("s_waitcnt vmcnt(0)" ::: "memory");
        }
    }
    __syncthreads();
}

namespace pg8 {
constexpr int BM = 256, BK = 64, HALF = 128, HTB = HALF * BK * 2, STAGE_BYTES = 8 * HTB, NXCD = 8, WGM = 8;
__host__ __device__ __forceinline__ int lds_byte(int r, int c) { const int st = (r >> 4) * 2 + (c >> 5), rr = r & 15, cc = c & 31, ob = rr * 64 + cc * 2; return st * 1024 + (ob ^ (((ob >> 9) & 1) << 5)); }
__host__ __device__ __forceinline__ void stage_rc(int b, int& R, int& C) { const int st = b / 1024, sb = b % 1024, swz = sb ^ (((sb >> 9) & 1) << 5); R = (st >> 1) * 16 + swz / 64; C = (st & 1) * 32 + (swz % 64) / 2; }
__host__ __device__ __forceinline__ int perm32(int rho) { const int n = rho >> 4, i = rho & 15; return 8 * (i >> 2) + 4 * n + (i & 3); }

struct Unit { int pm, pn; };
struct Gemm { const bf16_t* A; const bf16_t* Bt; int lda, ldb, K; };

struct OrderCore {
    int nM, nN, nwg, G, c;
    __device__ __forceinline__ void init(int nM_, int nN_, int G_, int c_) { nM = nM_; nN = nN_; nwg = nM * nN; G = G_; c = c_; }
    __device__ __forceinline__ bool map(int i, int& pm, int& pn) const { const long L = (long)i * G + c; if (c < 0 || L >= nwg) return false; return map_lin(L, pm, pn); }
    __device__ __forceinline__ bool map_lin(long L, int& pm, int& pn) const {
        int wgid = (int)L; { const int q = nwg / NXCD, r = nwg % NXCD, xcd = wgid % NXCD, off = wgid / NXCD; wgid = (xcd < r ? xcd * (q + 1) : r * (q + 1) + (xcd - r) * q) + off; }
        const int nig = WGM * nN, gid = wgid / nig, fm = gid * WGM, gsz = (nM - fm) < WGM ? (nM - fm) : WGM;
        pm = fm + ((wgid % nig) % gsz); pn = (wgid % nig) / gsz; return true;
    }
    __device__ __forceinline__ void a_ready(const Unit&) const {}
    __device__ __forceinline__ void done(const Unit&) const {}
};

template <class Epi, class Sched, bool ALIGN_EPI = true, bool SP2 = true>
__device__ __forceinline__ void gemm_phase(LAS unsigned char* lds, const Gemm g, const Sched& S, const Epi& E) {
    const int tid = opaque_tid(), wid = __builtin_amdgcn_readfirstlane(tid >> 6), lane = tid & 63, wr = wid >> 2, wc = wid & 3, fr = lane & 15, fq = lane >> 4;
    const int K = g.K, nt = K / BK;
    unsigned voffA[2], voffB[2];
#pragma unroll
    for (int i = 0; i < 2; ++i) { int R, C; stage_rc(tid * 16 + i * 8192, R, C); const int Rb = Epi::PERM ? ((R & ~31) + perm32(R & 31)) : R;
        voffA[i] = (unsigned)(R * g.lda + C) * 2u; voffB[i] = (unsigned)(Rb * g.ldb + C) * 2u; }
    const size_t kstep = (size_t)(BK * 2);
    const size_t hstepA = (size_t)HALF * g.lda * 2, hstepB = (size_t)HALF * g.ldb * 2;
    const unsigned ldsw = (unsigned)wid * 1024u;
    const int aoff = lds_byte(wr * 64 + fr, fq * 8), boff = lds_byte(wc * 32 + fr, fq * 8);
#define PG8_SA(b, h) (((b) * 2 + (h)) * HTB)
#define PG8_SB(b, h) ((4 + (b) * 2 + (h)) * HTB)
#define PG8_STAGE(bufoff, gbase, voff) do { _Pragma("unroll") for (int _i = 0; _i < 2; ++_i) \
        __builtin_amdgcn_global_load_lds((const unsigned*)((const char*)(gbase) + (voff)[_i]), (LAS unsigned*)(lds + (bufoff) + ldsw + _i * 8192), 16, 0, 0); } while (0)
#define PG8_LDA(dst, b, h) do { _Pragma("unroll") for (int m = 0; m < 4; ++m) _Pragma("unroll") for (int k = 0; k < 2; ++k) dst[m][k] = *(const LAS bf16x8*)(lds + PG8_SA(b, h) + aoff + m * 2048 + k * 1024); } while (0)
#define PG8_LDB(dst, b, h) do { _Pragma("unroll") for (int n = 0; n < 2; ++n) _Pragma("unroll") for (int k = 0; k < 2; ++k) dst[n][k] = *(const LAS bf16x8*)(lds + PG8_SB(b, h) + boff + n * 2048 + k * 1024); } while (0)
#define PG8_MMA(ai, bj, At, Bt) do { __builtin_amdgcn_s_setprio(1); _Pragma("unroll") for (int m = 0; m < 4; ++m) _Pragma("unroll") for (int n = 0; n < 2; ++n) _Pragma("unroll") for (int k = 0; k < 2; ++k) \
        acc[ai][bj][m][n] = __builtin_amdgcn_mfma_f32_16x16x32_bf16(Bt[n][k], At[m][k], acc[ai][bj][m][n], 0, 0, 0); __builtin_amdgcn_s_setprio(0); } while (0)
#define PG8_WAIT_V(n) asm volatile("s_waitcnt vmcnt(" #n ")" ::: "memory")
#define PG8_WAIT_L(n) asm volatile("s_waitcnt lgkmcnt(" #n ")" ::: "memory")
#define PG8_BAR __builtin_amdgcn_s_barrier()
#define PG8_SCHED __builtin_amdgcn_sched_barrier(0)
    __builtin_amdgcn_sched_barrier(0);
    Unit cur, nxt; int ui = 0;
    if (!S.next(0, cur)) return;
    f32x4 acc[2][2][4][2];
#pragma unroll
    for (int a = 0; a < 2; ++a)
#pragma unroll
        for (int b = 0; b < 2; ++b)
#pragma unroll
            for (int m = 0; m < 4; ++m)
#pragma unroll
                for (int n = 0; n < 2; ++n) acc[a][b][m][n] = (f32x4){0.f, 0.f, 0.f, 0.f};
    bf16x8 At[4][2], B0[2][2], B1[2][2];
    const char* cA; const char* cB; { long long ao, bo; S.offs(cur, ao, bo); cA = (const char*)g.A + ao; cB = (const char*)g.Bt + bo; }
    S.a_ready(cur);
    if constexpr (SP2) {
        PG8_STAGE(PG8_SB(0, 0), cB, voffB); PG8_STAGE(PG8_SB(0, 1), cB + hstepB, voffB); PG8_STAGE(PG8_SA(0, 0), cA, voffA); PG8_STAGE(PG8_SA(0, 1), cA + hstepA, voffA);
        if (wr == 1) PG8_BAR;
        PG8_WAIT_V(2); PG8_BAR;
        PG8_STAGE(PG8_SB(1, 0), cB + kstep, voffB); PG8_STAGE(PG8_SA(1, 0), cA + kstep, voffA); PG8_STAGE(PG8_SB(1, 1), cB + hstepB + kstep, voffB);
        PG8_WAIT_V(6); PG8_BAR;
    } else {
        PG8_STAGE(PG8_SB(0, 0), cB, voffB); PG8_STAGE(PG8_SA(0, 0), cA, voffA); PG8_STAGE(PG8_SB(0, 1), cB + hstepB, voffB); PG8_STAGE(PG8_SA(0, 1), cA + hstepA, voffA);
        if (wr == 1) PG8_BAR;
        PG8_WAIT_V(4); PG8_BAR;
        PG8_STAGE(PG8_SB(1, 0), cB + kstep, voffB); PG8_STAGE(PG8_SA(1, 0), cA + kstep, voffA); PG8_STAGE(PG8_SB(1, 1), cB + hstepB + kstep, voffB);
        PG8_WAIT_V(6); PG8_BAR;
    }
    for (;;) {
        const bool has_next = S.next(ui + 1, nxt);
        const char* nA = cA; const char* nB = cB; if (has_next) { long long ao, bo; S.offs(nxt, ao, bo); nA = (const char*)g.A + ao; nB = (const char*)g.Bt + bo; }
#pragma nounroll
        for (int t = 0; t < nt; t += 2) {
            const bool last = (t == nt - 2);
            const char* a1 = cA + (size_t)(t + 1) * kstep;
            const char* a2 = last ? nA : cA + (size_t)(t + 2) * kstep; const char* b2 = last ? nB : cB + (size_t)(t + 2) * kstep;
            const char* a3 = a2 + kstep; const char* b3 = b2 + kstep;
            if (last && has_next) S.a_ready(nxt);
            if constexpr (SP2) {
            PG8_LDB(B0, 0, 0); PG8_LDB(B1, 0, 1); PG8_SCHED; PG8_LDA(At, 0, 0); PG8_STAGE(PG8_SA(1, 1), a1 + hstepA, voffA);
            PG8_WAIT_V(8); PG8_WAIT_L(0); PG8_BAR; PG8_MMA(0, 0, At, B0); PG8_MMA(0, 1, At, B1); PG8_BAR; PG8_SCHED;
            PG8_LDA(At, 0, 1); PG8_STAGE(PG8_SB(0, 0), b2, voffB); PG8_STAGE(PG8_SB(0, 1), b2 + hstepB, voffB); PG8_STAGE(PG8_SA(0, 0), a2, voffA);
            PG8_WAIT_V(8); PG8_WAIT_L(0); PG8_BAR; PG8_MMA(1, 0, At, B0); PG8_MMA(1, 1, At, B1); PG8_BAR; PG8_SCHED;
            PG8_LDB(B0, 1, 0); PG8_LDB(B1, 1, 1); PG8_SCHED; PG8_LDA(At, 1, 0); PG8_STAGE(PG8_SA(0, 1), a2 + hstepA, voffA);
            PG8_WAIT_V(8); PG8_WAIT_L(0); PG8_BAR; PG8_MMA(0, 0, At, B0); PG8_MMA(0, 1, At, B1); PG8_BAR; PG8_SCHED;
            PG8_LDA(At, 1, 1); PG8_STAGE(PG8_SB(1, 0), b3, voffB); PG8_STAGE(PG8_SB(1, 1), b3 + hstepB, voffB); PG8_STAGE(PG8_SA(1, 0), a3, voffA);
            PG8_WAIT_V(8); PG8_WAIT_L(0); PG8_BAR; PG8_MMA(1, 0, At, B0); PG8_MMA(1, 1, At, B1); PG8_BAR; PG8_SCHED;
            } else {
            PG8_LDB(B0, 0, 0); PG8_SCHED; PG8_LDA(At, 0, 0); PG8_STAGE(PG8_SA(1, 1), a1 + hstepA, voffA);
            PG8_WAIT_L(8); PG8_BAR; PG8_WAIT_L(0); PG8_MMA(0, 0, At, B0); PG8_BAR; PG8_SCHED;
            PG8_LDB(B1, 0, 1); PG8_STAGE(PG8_SB(0, 0), b2, voffB);
            PG8_BAR; PG8_WAIT_L(0); PG8_MMA(0, 1, At, B1); PG8_BAR;
            PG8_LDA(At, 0, 1); PG8_STAGE(PG8_SA(0, 0), a2, voffA);
            PG8_BAR; PG8_WAIT_L(0); PG8_MMA(1, 0, At, B0); PG8_BAR; PG8_SCHED;
            PG8_STAGE(PG8_SB(0, 1), b2 + hstepB, voffB);
            PG8_WAIT_V(6); PG8_BAR; PG8_MMA(1, 1, At, B1); PG8_BAR;
            PG8_LDB(B0, 1, 0); PG8_SCHED; PG8_LDA(At, 1, 0); PG8_STAGE(PG8_SA(0, 1), a2 + hstepA, voffA);
            PG8_WAIT_L(8); PG8_BAR; PG8_WAIT_L(0); PG8_MMA(0, 0, At, B0); PG8_BAR; PG8_SCHED;
            PG8_LDB(B1, 1, 1); PG8_STAGE(PG8_SB(1, 0), b3, voffB);
            PG8_BAR; PG8_WAIT_L(0); PG8_MMA(0, 1, At, B1); PG8_BAR;
            PG8_LDA(At, 1, 1); PG8_STAGE(PG8_SA(1, 0), a3, voffA);
            PG8_BAR; PG8_WAIT_L(0); PG8_MMA(1, 0, At, B0); PG8_BAR; PG8_SCHED;
            PG8_STAGE(PG8_SB(1, 1), b3 + hstepB, voffB);
            PG8_WAIT_V(6); PG8_BAR; PG8_MMA(1, 1, At, B1); PG8_BAR;
            }
        }
        if constexpr (ALIGN_EPI) { if (wr == 0) PG8_BAR; }
        E(acc, cur, wr, wc, fr, fq, lds);
        if (!has_next) break;
#pragma unroll
        for (int a = 0; a < 2; ++a)
#pragma unroll
            for (int b = 0; b < 2; ++b)
#pragma unroll
                for (int m = 0; m < 4; ++m)
#pragma unroll
                    for (int n = 0; n < 2; ++n) acc[a][b][m][n] = (f32x4){0.f, 0.f, 0.f, 0.f};
        cur = nxt; cA = nA; cB = nB; ++ui;
        if constexpr (ALIGN_EPI) { if (wr == 1) PG8_BAR; }
    }
    PG8_WAIT_V(0);
    if constexpr (!ALIGN_EPI) { if (wr == 0) PG8_BAR; }
    PG8_BAR;
    PG8_SCHED;
#undef PG8_SA
#undef PG8_SB
#undef PG8_STAGE
#undef PG8_LDA
#undef PG8_LDB
#undef PG8_MMA
#undef PG8_WAIT_V
#undef PG8_WAIT_L
#undef PG8_BAR
#undef PG8_SCHED
}

template <class Epi, class Sched>
__device__ __forceinline__ void gemm_phase_gather(LAS unsigned char* lds, const Gemm g, const Sched& S, const Epi& E, const int* tok) {
    const int tid = opaque_tid(), wid = __builtin_amdgcn_readfirstlane(tid >> 6), lane = tid & 63, wr = wid >> 2, wc = wid & 3, fr = lane & 15, fq = lane >> 4;
    const int K = g.K, nt = K / BK;
    unsigned voffB[2]; int rA[2], cA2[2];
#pragma unroll
    for (int i = 0; i < 2; ++i) { int R, C; stage_rc(tid * 16 + i * 8192, R, C); const int Rb = Epi::PERM ? ((R & ~31) + perm32(R & 31)) : R; rA[i] = R; cA2[i] = C * 2; voffB[i] = (unsigned)(Rb * g.ldb + C) * 2u; }
    const size_t kstep = (size_t)(BK * 2); const size_t hstepB = (size_t)HALF * g.ldb * 2;
    const unsigned ldsw = (unsigned)wid * 1024u;
    const int aoff = lds_byte(wr * 64 + fr, fq * 8), boff = lds_byte(wc * 32 + fr, fq * 8);
#define PG8_SA(b, h) (((b) * 2 + (h)) * HTB)
#define PG8_SB(b, h) ((4 + (b) * 2 + (h)) * HTB)
#define PG8_STAGE(bufoff, gbase, voff) do { _Pragma("unroll") for (int _i = 0; _i < 2; ++_i) \
        __builtin_amdgcn_global_load_lds((const unsigned*)((const char*)(gbase) + (voff)[_i]), (LAS unsigned*)(lds + (bufoff) + ldsw + _i * 8192), 16, 0, 0); } while (0)
#define PG8_STAGEA(bufoff, go_, kb_) do { _Pragma("unroll") for (int _i = 0; _i < 2; ++_i) \
        __builtin_amdgcn_global_load_lds((const unsigned*)((const char*)g.A + (go_)[_i] + (kb_)), (LAS unsigned*)(lds + (bufoff) + ldsw + _i * 8192), 16, 0, 0); } while (0)
#define PG8_LDA(dst, b, h) do { _Pragma("unroll") for (int m = 0; m < 4; ++m) _Pragma("unroll") for (int k = 0; k < 2; ++k) dst[m][k] = *(const LAS bf16x8*)(lds + PG8_SA(b, h) + aoff + m * 2048 + k * 1024); } while (0)
#define PG8_LDB(dst, b, h) do { _Pragma("unroll") for (int n = 0; n < 2; ++n) _Pragma("unroll") for (int k = 0; k < 2; ++k) dst[n][k] = *(const LAS bf16x8*)(lds + PG8_SB(b, h) + boff + n * 2048 + k * 1024); } while (0)
#define PG8_MMA(ai, bj, At, Bt) do { __builtin_amdgcn_s_setprio(1); _Pragma("unroll") for (int m = 0; m < 4; ++m) _Pragma("unroll") for (int n = 0; n < 2; ++n) _Pragma("unroll") for (int k = 0; k < 2; ++k) \
        acc[ai][bj][m][n] = __builtin_amdgcn_mfma_f32_16x16x32_bf16(Bt[n][k], At[m][k], acc[ai][bj][m][n], 0, 0, 0); __builtin_amdgcn_s_setprio(0); } while (0)
#define PG8_WAIT_V(n) asm volatile("s_waitcnt vmcnt(" #n ")" ::: "memory")
#define PG8_WAIT_L(n) asm volatile("s_waitcnt lgkmcnt(" #n ")" ::: "memory")
#define PG8_BAR __builtin_amdgcn_s_barrier()
#define PG8_SCHED __builtin_amdgcn_sched_barrier(0)
#define PG8_GOFF(dst, u_) do { _Pragma("unroll") for (int _h = 0; _h < 2; ++_h) _Pragma("unroll") for (int _i = 0; _i < 2; ++_i) \
        dst[_h][_i] = (unsigned)tok[(u_).pm * 256 + _h * 128 + rA[_i]] * (unsigned)(g.lda * 2) + (unsigned)cA2[_i]; } while (0)
    __builtin_amdgcn_sched_barrier(0);
    Unit cur, nxt; int ui = 0;
    if (!S.next(0, cur)) return;
    f32x4 acc[2][2][4][2];
#pragma unroll
    for (int a = 0; a < 2; ++a)
#pragma unroll
        for (int b = 0; b < 2; ++b)
#pragma unroll
            for (int m = 0; m < 4; ++m)
#pragma unroll
                for (int n = 0; n < 2; ++n) acc[a][b][m][n] = (f32x4){0.f, 0.f, 0.f, 0.f};
    bf16x8 At[4][2], B0[2][2], B1[2][2];
    unsigned goC[2][2], goN[2][2];
    PG8_GOFF(goC, cur);
    const char* cB; { long long ao, bo; S.offs(cur, ao, bo); cB = (const char*)g.Bt + bo; }
    PG8_STAGE(PG8_SB(0, 0), cB, voffB); PG8_STAGE(PG8_SB(0, 1), cB + hstepB, voffB); PG8_STAGEA(PG8_SA(0, 0), goC[0], 0); PG8_STAGEA(PG8_SA(0, 1), goC[1], 0);
    if (wr == 1) PG8_BAR;
    PG8_WAIT_V(2); PG8_BAR;
    PG8_STAGE(PG8_SB(1, 0), cB + kstep, voffB); PG8_STAGEA(PG8_SA(1, 0), goC[0], kstep); PG8_STAGE(PG8_SB(1, 1), cB + hstepB + kstep, voffB);
    PG8_WAIT_V(6); PG8_BAR;
    for (;;) {
        const bool has_next = S.next(ui + 1, nxt);
        const char* nB = cB; if (has_next) { long long ao, bo; S.offs(nxt, ao, bo); nB = (const char*)g.Bt + bo; PG8_GOFF(goN, nxt); }
        else {
#pragma unroll
            for (int _h = 0; _h < 2; ++_h)
#pragma unroll
                for (int _i = 0; _i < 2; ++_i) goN[_h][_i] = goC[_h][_i]; }
#pragma nounroll
        for (int t = 0; t < nt; t += 2) {
            const bool last = (t == nt - 2);
            const size_t k1 = (size_t)(t + 1) * kstep, k2 = last ? 0 : (size_t)(t + 2) * kstep, k3 = k2 + kstep;
            const char* b2 = last ? nB : cB + (size_t)(t + 2) * kstep; const char* b3 = b2 + kstep;
            unsigned g2[2][2];
#pragma unroll
            for (int _h = 0; _h < 2; ++_h)
#pragma unroll
                for (int _i = 0; _i < 2; ++_i) g2[_h][_i] = last ? goN[_h][_i] : goC[_h][_i];
            PG8_LDB(B0, 0, 0); PG8_LDB(B1, 0, 1); PG8_SCHED; PG8_LDA(At, 0, 0); PG8_STAGEA(PG8_SA(1, 1), goC[1], k1);
            PG8_WAIT_V(8); PG8_WAIT_L(0); PG8_BAR; PG8_MMA(0, 0, At, B0); PG8_MMA(0, 1, At, B1); PG8_BAR; PG8_SCHED;
            PG8_LDA(At, 0, 1); PG8_STAGE(PG8_SB(0, 0), b2, voffB); PG8_STAGE(PG8_SB(0, 1), b2 + hstepB, voffB); PG8_STAGEA(PG8_SA(0, 0), g2[0], k2);
            PG8_WAIT_V(8); PG8_WAIT_L(0); PG8_BAR; PG8_MMA(1, 0, At, B0); PG8_MMA(1, 1, At, B1); PG8_BAR; PG8_SCHED;
            PG8_LDB(B0, 1, 0); PG8_LDB(B1, 1, 1); PG8_SCHED; PG8_LDA(At, 1, 0); PG8_STAGEA(PG8_SA(0, 1), g2[1], k2);
            PG8_WAIT_V(8); PG8_WAIT_L(0); PG8_BAR; PG8_MMA(0, 0, At, B0); PG8_MMA(0, 1, At, B1); PG8_BAR; PG8_SCHED;
            PG8_LDA(At, 1, 1); PG8_STAGE(PG8_SB(1, 0), b3, voffB); PG8_STAGE(PG8_SB(1, 1), b3 + hstepB, voffB); PG8_STAGEA(PG8_SA(1, 0), g2[0], k3);
            PG8_WAIT_V(8); PG8_WAIT_L(0); PG8_BAR; PG8_MMA(1, 0, At, B0); PG8_MMA(1, 1, At, B1); PG8_BAR; PG8_SCHED;
        }
        if (wr == 0) PG8_BAR;
        E(acc, cur, wr, wc, fr, fq, lds);
        if (!has_next) break;
#pragma unroll
        for (int a = 0; a < 2; ++a)
#pragma unroll
            for (int b = 0; b < 2; ++b)
#pragma unroll
                for (int m = 0; m < 4; ++m)
#pragma unroll
                    for (int n = 0; n < 2; ++n) acc[a][b][m][n] = (f32x4){0.f, 0.f, 0.f, 0.f};
        cur = nxt; cB = nB; ++ui;
#pragma unroll
        for (int _h = 0; _h < 2; ++_h)
#pragma unroll
            for (int _i = 0; _i < 2; ++_i) goC[_h][_i] = goN[_h][_i];
        if (wr == 1) PG8_BAR;
    }
    PG8_WAIT_V(0);
    PG8_BAR;
    PG8_SCHED;
#undef PG8_SA
#undef PG8_SB
#undef PG8_STAGE
#undef PG8_STAGEA
#undef PG8_LDA
#undef PG8_LDB
#undef PG8_MMA
#undef PG8_WAIT_V
#undef PG8_WAIT_L
#undef PG8_BAR
#undef PG8_SCHED
#undef PG8_GOFF
}
}
using pg8::Unit;
typedef const f32x4 (&AccRef)[2][2][4][2];

struct SchedPlain : pg8::OrderCore {
    long long astr, bstr;
    __device__ __forceinline__ bool next(int i, Unit& u) const { return map(i, u.pm, u.pn); }
    __device__ __forceinline__ void offs(const Unit& u, long long& ao, long long& bo) const { ao = (long long)u.pm * astr; bo = (long long)u.pn * bstr; }
};
struct SchedRange : pg8::OrderCore {
    long long astr, bstr; int base, count;
    __device__ __forceinline__ bool next(int i, Unit& u) const { const long L = (long)i * G + c; if (c < 0 || L >= count) return false; return map_lin(base + L, u.pm, u.pn); }
    __device__ __forceinline__ void offs(const Unit& u, long long& ao, long long& bo) const { ao = (long long)u.pm * astr; bo = (long long)u.pn * bstr; }
};
struct SchedHP : pg8::OrderCore {
    __device__ __forceinline__ bool next(int i, Unit& u) const { return map(i, u.pm, u.pn); }
    __device__ __forceinline__ void offs(const Unit& u, long long& ao, long long& bo) const {
        ao = ((long long)(u.pm >> 5) * (S + 1) + (long long)(u.pm & 31) * 256) * (D * 2); bo = (long long)u.pn * 256 * (2 * D) * 2; }
};
struct SchedRKV : pg8::OrderCore {
    long long aoff0, aoff1;
    __device__ __forceinline__ bool next(int i, Unit& u) const { return map(i, u.pm, u.pn); }
    __device__ __forceinline__ void offs(const Unit& u, long long& ao, long long& bo) const {
        const int t = u.pn >> 2; long long base = aoff1 + (long long)(t - 1) * ((long long)T * D * 2); if (t == 0) base = aoff0; ao = base + (long long)u.pm * 256 * D * 2; bo = (long long)u.pn * 256 * D * 2; }
};
struct SchedMoE : pg8::OrderCore {
    const int* tile_expert; int mode;
    __device__ __forceinline__ bool next(int i, Unit& u) const { return map(i, u.pm, u.pn); }
    __device__ __forceinline__ void offs(const Unit& u, long long& ao, long long& bo) const {
        const int e = tile_expert[u.pm];
        if (mode == 0) { ao = (long long)u.pm * 256 * D * 2; bo = ((long long)e * 512 + u.pn * 256) * D * 2; }
        else { ao = (long long)u.pm * 256 * 256 * 2; bo = ((long long)e * 1024 + u.pn * 256) * 256 * 2; } }
};

__device__ __forceinline__ u32x4 pack8v4(const f32x4 v0, const f32x4 v1) { u32x4 w; w.x = cvt_pk_c(v0[0], v0[1]); w.y = cvt_pk_c(v0[2], v0[3]); w.z = cvt_pk_c(v1[0], v1[1]); w.w = cvt_pk_c(v1[2], v1[3]); return w; }
__device__ __forceinline__ u32x4 pack8(const f32x4 v0, const f32x4 v1) { u32x4 w; w.x = cvt_pk_c(v0[0], v0[1]); w.y = cvt_pk_c(v0[2], v0[3]); w.z = cvt_pk_c(v1[0], v1[1]); w.w = cvt_pk_c(v1[2], v1[3]); return w; }

struct EpiCat {
    static constexpr bool PERM = true;
    bf16_t *R, *L; long long tstride; int pn_off;
    __device__ __forceinline__ void operator()(AccRef acc, const Unit& u, int wr, int wc, int fr, int fq, LAS unsigned char*) const {
        const int row0 = u.pm * 256 + wr * 64 + fr; const int pn = u.pn + pn_off;
        if (pn < 12) {
            const int t = pn >> 2; bf16_t* base = R + (long long)t * tstride; const int col0 = (pn & 3) * 256 + wc * 32 + 8 * fq;
#pragma unroll
            for (int ai = 0; ai < 2; ++ai)
#pragma unroll
                for (int m = 0; m < 4; ++m) { bf16_t* rowp = base + (size_t)(row0 + ai * 128 + m * 16) * D + col0;
#pragma unroll
                    for (int bj = 0; bj < 2; ++bj) *(u32x4*)(rowp + bj * 128) = pack8(acc[ai][bj][m][0], acc[ai][bj][m][1]); }
        } else {
            const int ct = wc * 32 + 8 * fq, lcol0 = (pn - 12) * 256 + ct;
#pragma unroll
            for (int ai = 0; ai < 2; ++ai)
#pragma unroll
                for (int m = 0; m < 4; ++m) { bf16_t* rowp = L + (size_t)(row0 + ai * 128 + m * 16) * 512 + lcol0;
#pragma unroll
                    for (int bj = 0; bj < 2; ++bj) { f32x4 v0 = acc[ai][bj][m][0], v1 = acc[ai][bj][m][1];
                        const int mode = (pn == 13) ? 2 : ((ct + bj * 128) < 64 ? 1 : 0);
                        if (mode == 1) {
#pragma unroll
                            for (int j = 0; j < 4; ++j) { v0[j] = fast_tanh(v0[j]); v1[j] = fast_tanh(v1[j]); } }
                        else if (mode == 2) {
#pragma unroll
                            for (int j = 0; j < 4; ++j) { v0[j] = fast_sigmoid(v0[j]); v1[j] = fast_sigmoid(v1[j]); } }
                        *(u32x4*)(rowp + bj * 128) = pack8(v0, v1); } }
        }
    }
};
struct EpiAct {
    static constexpr bool PERM = true;
    bf16_t* O0; long long ostride; const float* bias0; long long bstride; float sc0, dsc;
    __device__ __forceinline__ void operator()(AccRef acc, const Unit& u, int wr, int wc, int fr, int fq, LAS unsigned char*) const {
        const int t = u.pn >> 2; const int row0 = u.pm * 256 + wr * 64 + fr, col0 = (u.pn & 3) * 256 + wc * 32 + 8 * fq;
        bf16_t* base = O0 + (long long)t * ostride; const float* bs = bias0 + (long long)t * bstride;
        f32x4 bv[2][2];
#pragma unroll
        for (int bj = 0; bj < 2; ++bj)
#pragma unroll
            for (int n = 0; n < 2; ++n) bv[bj][n] = bias0 ? *(const f32x4*)(bs + col0 + bj * 128 + 4 * n) : (f32x4){0.f, 0.f, 0.f, 0.f};
#pragma unroll
        for (int ai = 0; ai < 2; ++ai)
#pragma unroll
            for (int m = 0; m < 4; ++m) { bf16_t* rowp = base + (size_t)(row0 + ai * 128 + m * 16) * D + col0;
#pragma unroll
                for (int bj = 0; bj < 2; ++bj) { f32x4 v0 = acc[ai][bj][m][0] + bv[bj][0], v1 = acc[ai][bj][m][1] + bv[bj][1];
                    if (bias0) { const float sc = sc0 + (float)t * dsc;
#pragma unroll
                        for (int j = 0; j < 4; ++j) { v0[j] = sc * fast_sigmoid(v0[j]); v1[j] = sc * fast_sigmoid(v1[j]); } }
                    *(u32x4*)(rowp + bj * 128) = pack8(v0, v1); } }
    }
};
struct EpiResid {
    static constexpr bool PERM = true;
    const float* resid_f32; bf16_t* xb; float* ssq; float bscale;
    __device__ __forceinline__ void operator()(AccRef acc, const Unit& u, int wr, int wc, int fr, int fq, LAS unsigned char*) const {
        const int row0 = u.pm * 256 + wr * 64 + fr, col0 = u.pn * 256 + wc * 32 + 8 * fq;
        if (resid_f32) {
#pragma unroll
            for (int bt = 0; bt < 4; ++bt) { f32x4 rr[2][2][2];
#pragma unroll
                for (int mm = 0; mm < 2; ++mm)
#pragma unroll
                    for (int bj = 0; bj < 2; ++bj) { const size_t off = (size_t)(row0 + (bt >> 1) * 128 + ((bt & 1) * 2 + mm) * 16) * D + col0 + bj * 128;
                        rr[mm][bj][0] = *(const f32x4*)(resid_f32 + off); rr[mm][bj][1] = *(const f32x4*)(resid_f32 + off + 4); }
                float s[2];
#pragma unroll
                for (int mm = 0; mm < 2; ++mm) { const int ai = bt >> 1, m = (bt & 1) * 2 + mm; const size_t off = (size_t)(row0 + ai * 128 + m * 16) * D + col0; s[mm] = 0.f;
#pragma unroll
                    for (int bj = 0; bj < 2; ++bj) { const f32x4 o0 = rr[mm][bj][0] + acc[ai][bj][m][0] * bscale, o1 = rr[mm][bj][1] + acc[ai][bj][m][1] * bscale;
                        *(u32x4*)(xb + off + bj * 128) = pack8(o0, o1);
                        s[mm] += ((o0[0] * o0[0] + o0[1] * o0[1]) + (o0[2] * o0[2] + o0[3] * o0[3])) + ((o1[0] * o1[0] + o1[1] * o1[1]) + (o1[2] * o1[2] + o1[3] * o1[3])); } }
#pragma unroll
                for (int mm = 0; mm < 2; ++mm) { s[mm] += __shfl_xor(s[mm], 16); s[mm] += __shfl_xor(s[mm], 32);
                    if (fq == 0) ssq[(size_t)(row0 + (bt >> 1) * 128 + ((bt & 1) * 2 + mm) * 16) * 16 + u.pn * 4 + wc] = s[mm]; }
                asm volatile("" ::: "memory"); }
        } else {
#pragma unroll
            for (int ai = 0; ai < 2; ++ai) { u32x4 rw[4][2];
#pragma unroll
                for (int m = 0; m < 4; ++m)
#pragma unroll
                    for (int bj = 0; bj < 2; ++bj) rw[m][bj] = *(const u32x4*)(xb + (size_t)(row0 + ai * 128 + m * 16) * D + col0 + bj * 128);
                float s[4];
#pragma unroll
                for (int m = 0; m < 4; ++m) { const size_t off = (size_t)(row0 + ai * 128 + m * 16) * D + col0; s[m] = 0.f;
#pragma unroll
                    for (int bj = 0; bj < 2; ++bj) { const u32x4 w = rw[m][bj];
                        const f32x4 r0 = (f32x4){bf_lo(w.x), bf_hi(w.x), bf_lo(w.y), bf_hi(w.y)}, r1 = (f32x4){bf_lo(w.z), bf_hi(w.z), bf_lo(w.w), bf_hi(w.w)};
                        const f32x4 o0 = r0 + acc[ai][bj][m][0] * bscale, o1 = r1 + acc[ai][bj][m][1] * bscale;
                        *(u32x4*)(xb + off + bj * 128) = pack8(o0, o1);
                        s[m] += ((o0[0] * o0[0] + o0[1] * o0[1]) + (o0[2] * o0[2] + o0[3] * o0[3])) + ((o1[0] * o1[0] + o1[1] * o1[1]) + (o1[2] * o1[2] + o1[3] * o1[3])); } }
#pragma unroll
                for (int m = 0; m < 4; ++m) { s[m] += __shfl_xor(s[m], 16); s[m] += __shfl_xor(s[m], 32);
                    if (fq == 0) ssq[(size_t)(row0 + ai * 128 + m * 16) * 16 + u.pn * 4 + wc] = s[m]; }
                asm volatile("" ::: "memory"); }
        }
    }
};
struct EpiRstd {
    static constexpr bool PERM = true;
    bf16_t* O0; long long tstride; const float* ssq;
    __device__ __forceinline__ void operator()(AccRef acc, const Unit& u, int wr, int wc, int fr, int fq, LAS unsigned char*) const {
        const int t = u.pn >> 2; bf16_t* base = O0 + (long long)t * tstride;
        const int row0 = u.pm * 256 + wr * 64 + fr, col0 = (u.pn & 3) * 256 + wc * 32 + 8 * fq;
#pragma unroll
        for (int ai = 0; ai < 2; ++ai)
#pragma unroll
            for (int m = 0; m < 4; ++m) { const int row = row0 + ai * 128 + m * 16; const f32x4* sp = (const f32x4*)(ssq + (size_t)row * 16);
                const f32x4 s4 = (sp[0] + sp[1]) + (sp[2] + sp[3]); const float rstd = __builtin_amdgcn_rsqf(((s4[0] + s4[1]) + (s4[2] + s4[3])) * (1.0f / D) + NORM_EPS);
                bf16_t* rowp = base + (size_t)row * D + col0;
#pragma unroll
                for (int bj = 0; bj < 2; ++bj) *(u32x4*)(rowp + bj * 128) = pack8(acc[ai][bj][m][0] * rstd, acc[ai][bj][m][1] * rstd); }
    }
};
struct EpiSwiGLU {
    static constexpr bool PERM = true;
    bf16_t* H; const float* slot_info;
    __device__ __forceinline__ void operator()(AccRef acc, const Unit& u, int wr, int wc, int fr, int fq, LAS unsigned char*) const {
        const int row0 = u.pm * 256 + wr * 64 + fr, col0 = u.pn * 128 + wc * 32 + 8 * fq;
#pragma unroll
        for (int ai = 0; ai < 2; ++ai)
#pragma unroll
            for (int m = 0; m < 4; ++m) { const int row = row0 + ai * 128 + m * 16; const float rstd = slot_info[(size_t)row * 2 + 1];
                f32x4 h0, h1;
#pragma unroll
                for (int j = 0; j < 4; ++j) { const float g0 = acc[ai][0][m][0][j] * rstd, g1 = acc[ai][0][m][1][j] * rstd;
                    h0[j] = g0 * fast_sigmoid(g0) * (acc[ai][1][m][0][j] * rstd); h1[j] = g1 * fast_sigmoid(g1) * (acc[ai][1][m][1][j] * rstd); }
                *(u32x4*)(H + (size_t)row * 256 + col0) = pack8(h0, h1); }
    }
};
struct EpiGate {
    static constexpr bool PERM = true;
    bf16_t* Y; const float* slot_info;
    __device__ __forceinline__ void operator()(AccRef acc, const Unit& u, int wr, int wc, int fr, int fq, LAS unsigned char*) const {
        const int row0 = u.pm * 256 + wr * 64 + fr, col0 = u.pn * 256 + wc * 32 + 8 * fq;
#pragma unroll
        for (int ai = 0; ai < 2; ++ai)
#pragma unroll
            for (int m = 0; m < 4; ++m) { const int row = row0 + ai * 128 + m * 16; const float gt = slot_info[(size_t)row * 2];
                bf16_t* rowp = Y + (size_t)row * D + col0;
#pragma unroll
                for (int bj = 0; bj < 2; ++bj) *(u32x4*)(rowp + bj * 128) = pack8(acc[ai][bj][m][0] * gt, acc[ai][bj][m][1] * gt); }
    }
};
struct EpiMemKV {
    static constexpr bool PERM = true;
    bf16_t* KM; bf16_t* VM;
    __device__ __forceinline__ void operator()(AccRef acc, const Unit& u, int wr, int wc, int fr, int fq, LAS unsigned char*) const {
        const int l = u.pm >> 3, prow0 = (u.pm & 7) * 256 + wr * 64 + fr, ct0 = u.pn * 256 + wc * 32 + 8 * fq;
#pragma unroll
        for (int ai = 0; ai < 2; ++ai)
#pragma unroll
            for (int m = 0; m < 4; ++m) { const int row = prow0 + ai * 128 + m * 16;
#pragma unroll
                for (int bj = 0; bj < 2; ++bj) { const int col = ct0 + bj * 128; bf16_t* dst = (col < 1024 ? KM : VM - 1024) + ((size_t)l * 2048 + row) * D + col;
                    *(u32x4*)dst = pack8(acc[ai][bj][m][0], acc[ai][bj][m][1]); } }
    }
};
struct SchedMemKV : pg8::OrderCore {
    __device__ __forceinline__ bool next(int i, Unit& u) const { return map(i, u.pm, u.pn); }
    __device__ __forceinline__ void offs(const Unit& u, long long& ao, long long& bo) const { ao = (long long)(u.pm & 7) * 256 * D * 2; bo = ((long long)(u.pm >> 3) * 2048 + u.pn * 256) * D * 2; }
};

struct SchedMemPre : pg8::OrderCore {
    int mode;
    __device__ __forceinline__ bool next(int i, Unit& u) const { return map(i, u.pm, u.pn); }
    __device__ __forceinline__ void offs(const Unit& u, long long& ao, long long& bo) const {
        const int lb = u.pm >> 2, q = u.pm & 3, l = lb >> 3;
        if (mode == 0) { ao = ((long long)lb * 256 * D + q * 256) * 2; bo = ((long long)l * D * D + (long long)u.pn * 256 * D + q * 256) * 2; }
        else { ao = ((long long)l * D * D + (long long)q * 256 * D + u.pn * 256) * 2; bo = ((long long)lb * 256 * D + u.pn * 256) * 2; } }
};
struct EpiMemPre {
    static constexpr bool PERM = true;
    bf16_t* O;
    __device__ __forceinline__ void operator()(AccRef acc, const Unit& u, int wr, int wc, int fr, int fq, LAS unsigned char*) const {
        const int row0 = (u.pm >> 2) * 1024 + (u.pm & 3) * 256 + wr * 64 + fr, col0 = u.pn * 256 + wc * 32 + 8 * fq;
#pragma unroll
        for (int ai = 0; ai < 2; ++ai)
#pragma unroll
            for (int m = 0; m < 4; ++m) { bf16_t* rowp = O + (size_t)(row0 + ai * 128 + m * 16) * D + col0;
#pragma unroll
                for (int bj = 0; bj < 2; ++bj) *(u32x4*)(rowp + bj * 128) = pack8(acc[ai][bj][m][0], acc[ai][bj][m][1]); }
    }
};
struct SchedBatchB : pg8::OrderCore {
    __device__ __forceinline__ bool next(int i, Unit& u) const { return map(i, u.pm, u.pn); }
    __device__ __forceinline__ void offs(const Unit& u, long long& ao, long long& bo) const { ao = (long long)u.pm * 256 * D * 2; bo = ((long long)(u.pm >> 5) * 1024 + u.pn * 256) * D * 2; }
};
struct EpiSoftmax {
    static constexpr bool PERM = true;
    bf16_t* P; const float* ssq;
    __device__ __forceinline__ void operator()(AccRef acc_c, const Unit& u, int wr, int wc, int fr, int fq, LAS unsigned char* lds) const {
        f32x4 (&acc)[2][2][4][2] = const_cast<f32x4 (&)[2][2][4][2]>(acc_c);
        LAS f32x2* ex = (LAS f32x2*)(lds + LDS_EPI);
#pragma unroll
        for (int ai = 0; ai < 2; ++ai)
#pragma unroll
            for (int m = 0; m < 4; ++m) { const int rl = ai * 128 + wr * 64 + m * 16 + fr; const f32x4* sp = (const f32x4*)(ssq + (size_t)(u.pm * 256 + rl) * 16);
                const f32x4 s4 = (sp[0] + sp[1]) + (sp[2] + sp[3]); const float rstd = __builtin_amdgcn_rsqf(((s4[0] + s4[1]) + (s4[2] + s4[3])) * (1.0f / D) + NORM_EPS);
                float mx = -3.0e38f;
#pragma unroll
                for (int bj = 0; bj < 2; ++bj)
#pragma unroll
                    for (int n = 0; n < 2; ++n) { acc[ai][bj][m][n] = acc[ai][bj][m][n] * rstd; mx = fmaxf(mx, fmaxf(fmaxf(acc[ai][bj][m][n][0], acc[ai][bj][m][n][1]), fmaxf(acc[ai][bj][m][n][2], acc[ai][bj][m][n][3]))); }
                mx = fmaxf(mx, __shfl_xor(mx, 16)); mx = fmaxf(mx, __shfl_xor(mx, 32));
                float sm = 0.f;
#pragma unroll
                for (int bj = 0; bj < 2; ++bj)
#pragma unroll
                    for (int n = 0; n < 2; ++n) {
#pragma unroll
                        for (int j = 0; j < 4; ++j) { const float pj = __builtin_amdgcn_exp2f(acc[ai][bj][m][n][j] - mx); acc[ai][bj][m][n][j] = pj; sm += pj; } }
                sm += __shfl_xor(sm, 16); sm += __shfl_xor(sm, 32);
                if (fq == 0) ex[rl * 4 + wc] = (f32x2){mx, sm}; }
        lds_barrier();
#pragma unroll
        for (int ai = 0; ai < 2; ++ai)
#pragma unroll
            for (int m = 0; m < 4; ++m) { const int rl = ai * 128 + wr * 64 + m * 16 + fr;
                const f32x4 e01 = *(const LAS f32x4*)(ex + rl * 4), e23 = *(const LAS f32x4*)(ex + rl * 4 + 2);
                const float gm = fmaxf(fmaxf(e01[0], e01[2]), fmaxf(e23[0], e23[2]));
                const float tot = (e01[1] * __builtin_amdgcn_exp2f(e01[0] - gm) + e01[3] * __builtin_amdgcn_exp2f(e01[2] - gm)) + (e23[1] * __builtin_amdgcn_exp2f(e23[0] - gm) + e23[3] * __builtin_amdgcn_exp2f(e23[2] - gm));
                const float own = wc == 0 ? e01[0] : wc == 1 ? e01[2] : wc == 2 ? e23[0] : e23[2];
                const float f = __builtin_amdgcn_exp2f(own - gm) * __builtin_amdgcn_rcpf(tot);
                bf16_t* rowp = P + (size_t)(u.pm * 256 + rl) * D + u.pn * 256 + wc * 32 + 8 * fq;
#pragma unroll
                for (int bj = 0; bj < 2; ++bj) *(u32x4*)(rowp + bj * 128) = pack8(acc[ai][bj][m][0] * f, acc[ai][bj][m][1] * f); }
    }
};
struct EpiRouter {
    static constexpr bool PERM = true;
    const float* ssq; const float* brg; const float* bre; u32x4* tok;
    __device__ __forceinline__ void operator()(AccRef acc, const Unit& u, int wr, int wc, int fr, int fq, LAS unsigned char* lds) const {
        LAS f32x4* gl = (LAS f32x4*)(lds + LDS_EPI); LAS int* lc = (LAS int*)(lds + LDS_EPI + 4096);
        auto row_rstd = [&](int row) { const f32x4* sp = (const f32x4*)(ssq + (size_t)row * 16); const f32x4 s4 = (sp[0] + sp[1]) + (sp[2] + sp[3]);
            return __builtin_amdgcn_rsqf(((s4[0] + s4[1]) + (s4[2] + s4[3])) * (1.0f / D) + NORM_EPS); };
        if (wc == 1 && fq == 0) { const f32x4 bg = *(const f32x4*)brg;
#pragma unroll
            for (int ai = 0; ai < 2; ++ai)
#pragma unroll
                for (int m = 0; m < 4; ++m) { const int rl = ai * 128 + wr * 64 + m * 16 + fr; gl[rl] = (acc[ai][0][m][0] + acc[ai][1][m][0]) * row_rstd(u.pm * 256 + rl) + bg; } }
        lds_barrier();
        if (wc == 0) {
#pragma unroll
            for (int ai = 0; ai < 2; ++ai)
#pragma unroll
                for (int m = 0; m < 4; ++m) { const int rl = ai * 128 + wr * 64 + m * 16 + fr; const f32x4 g = gl[rl];
                    int grp = 0; float gm = g[0];
#pragma unroll
                    for (int c = 1; c < 4; ++c) if (g[c] > gm) { gm = g[c]; grp = c; }
                    if (fq == grp) {
                        float gden = 0.f;
#pragma unroll
                        for (int c = 0; c < 4; ++c) gden += __expf(g[c] - gm);
                        const float gw = 1.0f / gden;
                        const f32x4 b0 = *(const f32x4*)(bre + grp * 8), b1 = *(const f32x4*)(bre + grp * 8 + 4);
                        const float rs = row_rstd(u.pm * 256 + rl);
                        const f32x4 e0 = (acc[ai][0][m][0] + acc[ai][1][m][0]) * rs + b0, e1v = (acc[ai][0][m][1] + acc[ai][1][m][1]) * rs + b1;
                        const float el[8] = {e0[0], e0[1], e0[2], e0[3], e1v[0], e1v[1], e1v[2], e1v[3]};
                        int i1 = 0; float m1 = el[0];
#pragma unroll
                        for (int c = 1; c < 8; ++c) if (el[c] > m1) { m1 = el[c]; i1 = c; }
                        int i2 = -1; float m2 = -3.0e38f;
#pragma unroll
                        for (int c = 0; c < 8; ++c) if (c != i1 && el[c] > m2) { m2 = el[c]; i2 = c; }
                        if (i2 < 0) i2 = i1 ? 0 : 1;
                        const float ex = __expf(m2 - m1); const float w1 = 1.0f / (1.0f + ex), w2 = ex * w1;
                        const int x1 = grp * 8 + i1, x2 = grp * 8 + i2;
                        u32x4 o; o.x = (unsigned)x1 | ((unsigned)x2 << 8); o.y = __builtin_bit_cast(unsigned, gw * w1); o.z = __builtin_bit_cast(unsigned, gw * w2); o.w = __builtin_bit_cast(unsigned, rs);
                        tok[u.pm * 256 + rl] = o; atomicAdd((int*)&lc[x1], 1); atomicAdd((int*)&lc[x2], 1); } } }
    }
};

struct Args { const float* in[37]; float* out; unsigned char* ws; int ph_lo, ph_hi; };
typedef const __attribute__((address_space(4))) Args* KArgs;
__device__ __forceinline__ KArgs kargs() { KArgs p = (KArgs)__builtin_amdgcn_kernarg_segment_ptr(); asm volatile("" : "+s"(p)); return p; }
enum { I_X = 0, I_MEM, I_NORM_MIX, I_NORM_MEM, I_NORM_FFN, I_NORM_FINAL, I_MU, I_WRKV, I_W0, I_W1, I_W2, I_A0, I_A1, I_A2, I_G1, I_G2, I_KK, I_KA, I_RK, I_LNG, I_LNB, I_WO,
       I_KVNORM, I_WKVS, I_SBWQ, I_SBWO, I_MEMNORMKV, I_MEMWQ, I_MEMWKV, I_MEMWO, I_WRG, I_BRG, I_WRE, I_BRE, I_WGATE, I_WUP, I_WDOWN };

struct ConvJob { const float* src; bf16_t* dst; const float* g; const float* mu; int K, N, lds, ldd, mumode; float cst; };
constexpr int NJOBS = 25 + 320;
__device__ __forceinline__ ConvJob get_job(KArgs a, int j) {
    ConvJob J; J.g = nullptr; J.mu = nullptr; J.mumode = 0; J.cst = 1.f;
    unsigned char* ws = a->ws;
    if (j < 12) { const int i = j >> 1, part = j & 1; J.K = D; J.g = a->in[I_NORM_MIX];
        if (i < 3) {
            J.src = a->in[I_WRKV] + (size_t)i * D * D; J.N = part ? 0 : D; J.lds = D; J.ldd = D; J.dst = (bf16_t*)(ws + WS_WCAT) + (size_t)(i * 1024) * D; return J; }
        J.ldd = 2 * D; J.mu = a->in[I_MU] + i * D; J.mumode = part ? 2 : 1;
        bf16_t* base = (bf16_t*)(ws + WS_WCAT) + part * D;
        if (i == 3) { J.src = a->in[I_W1]; J.N = 64; J.lds = 64; J.dst = base + (size_t)3072 * 2 * D; }
        else if (i == 4) { J.src = a->in[I_A1]; J.N = 64; J.lds = 64; J.dst = base + (size_t)(3072 + 64) * 2 * D; }
        else { J.src = a->in[I_G1]; J.N = 160; J.lds = 160; J.dst = base + (size_t)3328 * 2 * D; }
        return J; }
    if (j == 12) { J.src = a->in[I_W2]; J.K = 64; J.N = D; J.lds = D; J.dst = (bf16_t*)(ws + WS_WWA2); J.ldd = 256; return J; }
    if (j == 13) { J.src = a->in[I_A2]; J.K = 64; J.N = D; J.lds = D; J.dst = (bf16_t*)(ws + WS_WWA2) + (size_t)1024 * 256 + 64; J.ldd = 256; return J; }
    if (j == 14) { J.src = a->in[I_G2]; J.K = 160; J.N = D; J.lds = D; J.dst = (bf16_t*)(ws + WS_WG2); J.ldd = 256; return J; }
    if (j == 15) { J.src = a->in[I_WO]; J.K = D; J.N = D; J.lds = D; J.dst = (bf16_t*)(ws + WS_WO0); J.ldd = D; return J; }
    if (j == 16) { J.src = a->in[I_WKVS]; J.K = D; J.N = 2 * D; J.lds = 2 * D; J.dst = (bf16_t*)(ws + WS_WKVQ); J.ldd = D; J.g = a->in[I_KVNORM]; return J; }
    if (j == 17) { J.src = a->in[I_SBWQ]; J.K = D; J.N = D; J.lds = D; J.dst = (bf16_t*)(ws + WS_WKVQ) + (size_t)2048 * D; J.ldd = D; J.g = a->in[I_NORM_MIX] + D; J.cst = 0.125f * 1.44269504f; return J; }
    if (j == 18) { J.src = a->in[I_SBWO]; J.K = D; J.N = D; J.lds = D; J.dst = (bf16_t*)(ws + WS_WOSB); J.ldd = D; return J; }
    if (j < 25) { const int l = (j - 19) / 3, w = (j - 19) % 3; J.K = D; J.ldd = D;
        if (w == 0) { J.src = a->in[I_MEMWQ]; J.N = 0; J.lds = D; J.dst = (bf16_t*)(ws + WS_WMQ); }
        else if (w == 1) { J.src = a->in[I_MEMWKV] + (size_t)l * D * 2 * D; J.N = 2 * D; J.lds = 2 * D; J.dst = (bf16_t*)(ws + WS_WMKV) + (size_t)l * 2 * D * D; J.g = a->in[I_MEMNORMKV] + l * D; }
        else { J.src = a->in[I_MEMWO] + (size_t)l * D * D; J.N = D; J.lds = D; J.dst = (bf16_t*)(ws + WS_WMO) + (size_t)l * D * D; }
        return J; }
    const int mI = j - 25, l = mI / 160, e = (mI % 160) / 5, part = mI % 5;
    if (part < 4) { const int up = part >> 1, hh = part & 1; J.src = a->in[up ? I_WUP : I_WGATE] + ((size_t)l * 32 + e) * D * 256 + hh * 128; J.K = D; J.N = 128; J.lds = 256;
        J.dst = (bf16_t*)(ws + WS_WGU) + (((size_t)l * 32 + e) * 512 + hh * 256 + up * 128) * D; J.ldd = D; J.g = a->in[I_NORM_FFN] + l * D; }
    else { J.src = a->in[I_WDOWN] + ((size_t)l * 32 + e) * 256 * D; J.K = 256; J.N = D; J.lds = D; J.dst = (bf16_t*)(ws + WS_WDN) + ((size_t)l * 32 + e) * D * 256; J.ldd = 256; }
    return J;
}
__device__ __forceinline__ void conv_load(const ConvJob& J, int tile, float (&v)[64], float& gk, float& mk, int lane) {
    const int ntn = (J.N + 63) >> 6, kb = tile / ntn, nb = tile % ntn, k0 = kb * 64, n0 = nb * 64;
    const int nc = (n0 + lane) < J.N ? n0 + lane : J.N - 1;
    { const int kc = (k0 + lane) < J.K ? k0 + lane : J.K - 1; gk = J.g ? J.g[kc] : 1.0f; mk = J.mu ? J.mu[kc] : 0.0f; }
    const float* sp = J.src + nc;
#pragma unroll
    for (int u = 0; u < 64; ++u) { const int kr = (k0 + u) < J.K ? k0 + u : J.K - 1; v[u] = __builtin_nontemporal_load(sp + (size_t)kr * J.lds); }
}
__device__ __forceinline__ void conv_store(const ConvJob& J, int tile, const float (&v)[64], float gk, float mk, LAS float* scr, int lane) {
    const int ntn = (J.N + 63) >> 6, kb = tile / ntn, nb = tile % ntn, k0 = kb * 64, n0 = nb * 64;
    float sk = 0.f;
    if (k0 + lane < J.K) { sk = J.cst * gk; if (J.mumode == 1) sk *= mk; else if (J.mumode == 2) sk *= (1.0f - mk); }
#pragma unroll
    for (int u = 0; u < 64; ++u) { const float s = __builtin_bit_cast(float, __builtin_amdgcn_readlane(__builtin_bit_cast(int, sk), u)); scr[u * 65 + lane] = v[u] * s; }
    asm volatile("s_waitcnt lgkmcnt(0)" ::: "memory");
    const int c = lane & 7;
#pragma unroll
    for (int it = 0; it < 8; ++it) { const int n = (lane >> 3) + 8 * it; const LAS float* s = scr + (8 * c) * 65 + n;
        if (n0 + n < J.N && k0 + 8 * c < J.K) { u32x4 o; o.x = cvt_pk_bf16(s[0], s[65]); o.y = cvt_pk_bf16(s[130], s[195]); o.z = cvt_pk_bf16(s[260], s[325]); o.w = cvt_pk_bf16(s[390], s[455]);
            *(u32x4*)(J.dst + (size_t)(n0 + n) * J.ldd + k0 + 8 * c) = o; } }
    asm volatile("s_waitcnt lgkmcnt(0)" ::: "memory");
}
struct ConvIter { int j, t, ntiles, tbase; };
__device__ __forceinline__ bool conv_next(KArgs a, ConvIter& it, ConvJob& J, int& tile, int gw, int NGW) {
    for (;;) {
        if (it.j >= NJOBS) return false;
        if (it.t < it.ntiles) { J = get_job(a, it.j); tile = it.t; it.t += NGW; return true; }
        it.tbase = (it.tbase + it.ntiles) % NGW; ++it.j;
        if (it.j < NJOBS) { const ConvJob Jn = get_job(a, it.j); it.ntiles = ((Jn.K + 63) >> 6) * ((Jn.N + 63) >> 6); int t0 = (gw - it.tbase) % NGW; if (t0 < 0) t0 += NGW; it.t = t0; }
    }
}
__device__ __forceinline__ void rms_row_to_bf16(const float* xrow, bf16_t* orow, int lane) {
    const f32x4* xr = (const f32x4*)xrow + lane; f32x4 v[4]; float s = 0.f;
#pragma unroll
    for (int j = 0; j < 4; ++j) { v[j] = xr[64 * j]; s += (v[j][0] * v[j][0] + v[j][1] * v[j][1]) + (v[j][2] * v[j][2] + v[j][3] * v[j][3]); }
    const float rstd = __builtin_amdgcn_rsqf(wave_sum(s) * (1.0f / D) + NORM_EPS);
    u32x2* o8 = (u32x2*)orow + lane;
#pragma unroll
    for (int j = 0; j < 4; ++j) { u32x2 w; w.x = cvt_pk_bf16(v[j][0] * rstd, v[j][1] * rstd); w.y = cvt_pk_bf16(v[j][2] * rstd, v[j][3] * rstd); o8[64 * j] = w; }
}
__device__ __forceinline__ void prologue_phase(KArgs a, LAS unsigned char* lds, int bid, int nb) {
    const int tid = opaque_tid(), lane = tid & 63, wave = __builtin_amdgcn_readfirstlane(tid >> 6);
    const int gw = bid * 8 + wave, NGW = nb * 8;
    LAS float* scr = (LAS float*)(lds + wave * 16896);
    {   ConvIter it; it.j = 0; it.tbase = 0; { const ConvJob J0 = get_job(a, 0); it.ntiles = ((J0.K + 63) >> 6) * ((J0.N + 63) >> 6); it.t = gw; }
        ConvJob JA, JB, JC; int tA = 0, tB = 0, tC = 0; float vA[64], vB[64], vC[64], gA = 1.f, mA = 0.f, gB = 1.f, mB = 0.f, gC = 1.f, mC = 0.f;
        bool okA = conv_next(a, it, JA, tA, gw, NGW); if (okA) conv_load(JA, tA, vA, gA, mA, lane);
        bool okB = okA && conv_next(a, it, JB, tB, gw, NGW); if (okB) conv_load(JB, tB, vB, gB, mB, lane);
        while (okA) {
            const bool okC = okB && conv_next(a, it, JC, tC, gw, NGW); if (okC) conv_load(JC, tC, vC, gC, mC, lane);
            conv_store(JA, tA, vA, gA, mA, scr, lane);
            okA = okC && conv_next(a, it, JA, tA, gw, NGW); if (okA) conv_load(JA, tA, vA, gA, mA, lane);
            if (!okB) break;
            conv_store(JB, tB, vB, gB, mB, scr, lane);
            okB = okA && conv_next(a, it, JB, tB, gw, NGW); if (okB) conv_load(JB, tB, vB, gB, mB, lane);
            if (!okC) break;
            conv_store(JC, tC, vC, gC, mC, scr, lane);
        }
    }
    { bf16_t* wq = (bf16_t*)(a->ws + WS_WMQ);
      for (int i = bid * 512 + tid; i < 2 * D * D / 4; i += nb * 512) { const int l = i >> 18, k = (i >> 8) & 1023;
          const f32x4 v = *(const f32x4*)(a->in[I_MEMWQ] + (size_t)i * 4) * (a->in[I_NORM_MEM][l * D + k] * (0.0625f * 1.44269504f));
          u32x2 o; o.x = cvt_pk_bf16(v[0], v[1]); o.y = cvt_pk_bf16(v[2], v[3]); *(u32x2*)(wq + (size_t)i * 4) = o; } }
    bf16_t* wr2 = (bf16_t*)(a->ws + WS_RS);
    for (int i = bid * 512 + tid; i < 2 * 256 * 1024; i += nb * 512) { const int l = i >> 18, c = (i >> 10) & 255, k = i & 1023, cc = c & 127;
        float w = 0.f;
        if (cc < 36) w = a->in[I_NORM_FFN][l * D + k] * (cc < 32 ? a->in[I_WRE][((size_t)l * D + k) * 32 + cc] : a->in[I_WRG][((size_t)l * D + k) * 4 + (cc - 32)]);
        const unsigned hi = f2bf(w); const unsigned lo = f2bf(w - __builtin_bit_cast(float, hi << 16));
        wr2[i] = (bf16_t)((c >> 7) ? lo : hi); }
    bf16_t* mn = (bf16_t*)(a->ws + WS_MN);
    for (int r = gw; r < 2048; r += NGW) rms_row_to_bf16(a->in[I_MEM] + (size_t)r * D, mn + (size_t)r * D, lane);
    bf16_t* hp = (bf16_t*)(a->ws + R0);
    { bf16_t* L0 = (bf16_t*)(a->ws + R6); bf16_t* L1 = (bf16_t*)a->out; bf16_t* L2 = (bf16_t*)a->out + (size_t)T * D;
      constexpr int RPW = 32;
      const int e0 = lane * 8, e1 = lane * 8 + 4, e2 = 512 + lane * 8, e3 = 512 + lane * 8 + 4;
      for (int r0 = gw * RPW; r0 < T; r0 += NGW * RPW) {
          f32x4 mu[3][4];
#pragma unroll
          for (int i = 0; i < 3; ++i) { const float* mp = a->in[I_MU] + i * D; mu[i][0] = *(const f32x4*)(mp + e0); mu[i][1] = *(const f32x4*)(mp + e1); mu[i][2] = *(const f32x4*)(mp + e2); mu[i][3] = *(const f32x4*)(mp + e3); }
          f32x4 hprev[4];
          { const int t0 = r0 & (S - 1);
            if (t0 == 0) {
#pragma unroll
                for (int j = 0; j < 4; ++j) hprev[j] = (f32x4){0.f, 0.f, 0.f, 0.f}; }
            else { const float* xr = a->in[I_X] + (size_t)(r0 - 1) * D; float s = 0.f;
                hprev[0] = *(const f32x4*)(xr + e0); hprev[1] = *(const f32x4*)(xr + e1); hprev[2] = *(const f32x4*)(xr + e2); hprev[3] = *(const f32x4*)(xr + e3);
#pragma unroll
                for (int j = 0; j < 4; ++j) s += (hprev[j][0] * hprev[j][0] + hprev[j][1] * hprev[j][1]) + (hprev[j][2] * hprev[j][2] + hprev[j][3] * hprev[j][3]);
                const float rstd = __builtin_amdgcn_rsqf(wave_sum(s) * (1.0f / D) + NORM_EPS);
#pragma unroll
                for (int j = 0; j < 4; ++j) hprev[j] = hprev[j] * rstd; } }
          f32x4 va[4], vb[4];
          { const float* xr = a->in[I_X] + (size_t)r0 * D; va[0] = __builtin_nontemporal_load((const f32x4*)(xr + e0)); va[1] = __builtin_nontemporal_load((const f32x4*)(xr + e1)); va[2] = __builtin_nontemporal_load((const f32x4*)(xr + e2)); va[3] = __builtin_nontemporal_load((const f32x4*)(xr + e3));
            xr += D; vb[0] = __builtin_nontemporal_load((const f32x4*)(xr + e0)); vb[1] = __builtin_nontemporal_load((const f32x4*)(xr + e1)); vb[2] = __builtin_nontemporal_load((const f32x4*)(xr + e2)); vb[3] = __builtin_nontemporal_load((const f32x4*)(xr + e3)); }
#define PRO_ROW(V_, rr_) { const int r = r0 + (rr_), b = r >> 13, t = r & (S - 1); \
              f32x4 v[4]; float s = 0.f; \
              _Pragma("unroll") for (int j = 0; j < 4; ++j) { v[j] = V_[j]; s += (v[j][0] * v[j][0] + v[j][1] * v[j][1]) + (v[j][2] * v[j][2] + v[j][3] * v[j][3]); } \
              { const int rn = ((rr_) + 2 < RPW) ? r + 2 : r; const float* xr = a->in[I_X] + (size_t)rn * D; \
                V_[0] = __builtin_nontemporal_load((const f32x4*)(xr + e0)); V_[1] = __builtin_nontemporal_load((const f32x4*)(xr + e1)); V_[2] = __builtin_nontemporal_load((const f32x4*)(xr + e2)); V_[3] = __builtin_nontemporal_load((const f32x4*)(xr + e3)); } \
              const float rstd = __builtin_amdgcn_rsqf(wave_sum(s) * (1.0f / D) + NORM_EPS); \
              bf16_t* oh = hp + ((size_t)b * (S + 1) + 1 + t) * D + e0; bf16_t* o0 = L0 + (size_t)r * D + e0; bf16_t* o1 = L1 + (size_t)r * D + e0; bf16_t* o2 = L2 + (size_t)r * D + e0; \
              _Pragma("unroll") for (int jh = 0; jh < 2; ++jh) { const f32x4 ha = v[2 * jh] * rstd, hb = v[2 * jh + 1] * rstd, da = hprev[2 * jh] - ha, db = hprev[2 * jh + 1] - hb; \
                  *(u32x4*)(oh + 512 * jh) = pack8(ha, hb); \
                  *(u32x4*)(o0 + 512 * jh) = pack8(ha + da * mu[0][2 * jh], hb + db * mu[0][2 * jh + 1]); \
                  *(u32x4*)(o1 + 512 * jh) = pack8(ha + da * mu[1][2 * jh], hb + db * mu[1][2 * jh + 1]); \
                  *(u32x4*)(o2 + 512 * jh) = pack8(ha + da * mu[2][2 * jh], hb + db * mu[2][2 * jh + 1]); \
                  hprev[2 * jh] = ha; hprev[2 * jh + 1] = hb; } }
#pragma unroll 1
          for (int rr = 0; rr < RPW; rr += 2) { PRO_ROW(va, rr) PRO_ROW(vb, rr + 1) }
#undef PRO_ROW
      } }
    if (gw < NB) { u32x4* z = (u32x4*)(hp + (size_t)gw * (S + 1) * D); z[lane] = (u32x4){0u, 0u, 0u, 0u}; z[64 + lane] = (u32x4){0u, 0u, 0u, 0u}; }
}

namespace rw {
constexpr int RB = 144, SLOT = 64 * RB;
enum { S_AT = 0, S_BT, S_KT, S_RT, S_ATT, S_VT, S_BHT, S_KHT, S_TM, S_APT0, S_APT1, S_AAK, S_XT0, S_TRI, NSLOTS };
constexpr int S_AP0 = S_BT, S_AP1 = S_KT, S_XT1 = S_RT, S_ARB = S_BHT, S_ARK = S_KHT;
constexpr int MISC = NSLOTS * SLOT;
__device__ __forceinline__ int rowmap(int q, int h) { return (q & 3) + 8 * (q >> 2) + 4 * h; }
__device__ __forceinline__ f32x16 zero16() { f32x16 z;
#pragma unroll
    for (int i = 0; i < 16; ++i) z[i] = 0.f;
    return z; }
__device__ __forceinline__ bf16x8 tr_frag(const LAS unsigned char* T, int row0, int ks, int r, int h) {
    const int q = (r & 15) >> 2, p = r & 3, blk = (r >> 4) & 1, sw = (q >> 1) & 1;
    const LAS unsigned char* a0 = T + (16 * ks + 8 * h + q) * 128 + ((((row0 >> 5) ^ sw) * 4 + 2 * blk + (p >> 1)) << 4) + 8 * (p & 1);
    return __builtin_shufflevector(__builtin_amdgcn_ds_read_tr16_b64_v4i16((LAS s16x4*)a0), __builtin_amdgcn_ds_read_tr16_b64_v4i16((LAS s16x4*)(a0 + 4 * 128)), 0, 1, 2, 3, 4, 5, 6, 7); }
template <bool SX = false, bool SY = false>
__device__ __forceinline__ f32x16 mm(f32x16 acc, const LAS unsigned char* X, int xrow0, const LAS unsigned char* Yt, int yrow0, int r, int h, int nks) {
#pragma unroll
    for (int ks = 0; ks < 4; ++ks) if (ks < nks) {
        const bf16x8 a = SX ? tr_frag(X, xrow0, ks, r, h) : *(const LAS bf16x8*)(X + (xrow0 + r) * RB + (16 * ks + 8 * h) * 2);
        const bf16x8 b = SY ? tr_frag(Yt, yrow0, ks, r, h) : *(const LAS bf16x8*)(Yt + (yrow0 + r) * RB + (16 * ks + 8 * h) * 2);
        acc = __builtin_amdgcn_mfma_f32_32x32x16_bf16(a, b, acc, 0, 0, 0); }
    return acc; }
__device__ __forceinline__ void write_T(LAS unsigned char* buf, int col0, int row0, const f32x16& acc, int r, int h) {
#pragma unroll
    for (int m = 0; m < 4; ++m) { u32x2 w; w.x = cvt_pk_c(acc[4 * m], acc[4 * m + 1]); w.y = cvt_pk_c(acc[4 * m + 2], acc[4 * m + 3]);
        *(LAS u32x2*)(buf + (col0 + r) * RB + (row0 + 8 * m + 4 * h) * 2) = w; } }
__device__ __forceinline__ void write_R(LAS unsigned char* buf, int row0, int col0, const f32x16& acc, int r, int h) {
#pragma unroll
    for (int q = 0; q < 16; q += 2) { const unsigned p = cvt_pk_c(acc[q], acc[q + 1]);
        *(LAS unsigned short*)(buf + (row0 + rowmap(q, h)) * RB + (col0 + r) * 2) = (unsigned short)p; *(LAS unsigned short*)(buf + (row0 + rowmap(q + 1, h)) * RB + (col0 + r) * 2) = (unsigned short)(p >> 16); } }
__device__ __forceinline__ void zero_tile(LAS unsigned char* buf, int row0, int col0, int lane) {
#pragma unroll
    for (int i = 0; i < 4; ++i) { const int idx = i * 64 + lane, row = idx >> 3, ch = idx & 7; *(LAS u32x2*)(buf + (row0 + row) * RB + col0 * 2 + ch * 8) = (u32x2){0u, 0u}; } }

#define RW_P8(v_, s_) pack8c(v_[8 * (s_)], v_[8 * (s_) + 1], v_[8 * (s_) + 2], v_[8 * (s_) + 3], v_[8 * (s_) + 4], v_[8 * (s_) + 5], v_[8 * (s_) + 6], v_[8 * (s_) + 7])
__device__ __forceinline__ void inv32(const f32x16 A, const f32x16 AT, f32x16& Tt, f32x16& TtT, int r, int h) {
    f32x16 X = A, Y = AT; Tt = A; TtT = AT;
#pragma unroll
    for (int q = 0; q < 16; ++q) if (rowmap(q, h) == r) { Tt[q] += 1.0f; TtT[q] += 1.0f; }
#pragma unroll
    for (int k = 0; k < 4; ++k) {
        const bf16x8 x0 = RW_P8(X, 0), x1 = RW_P8(X, 1), y0 = RW_P8(Y, 0), y1 = RW_P8(Y, 1);
        f32x16 Sx = zero16(), Sy = zero16();
        Sx = __builtin_amdgcn_mfma_f32_32x32x16_bf16(y0, x0, Sx, 0, 0, 0); if (k < 3) Sy = __builtin_amdgcn_mfma_f32_32x32x16_bf16(x0, y0, Sy, 0, 0, 0);
        Sx = __builtin_amdgcn_mfma_f32_32x32x16_bf16(y1, x1, Sx, 0, 0, 0); if (k < 3) Sy = __builtin_amdgcn_mfma_f32_32x32x16_bf16(x1, y1, Sy, 0, 0, 0);
        const bf16x8 s0 = RW_P8(Sx, 0), s1 = RW_P8(Sx, 1), t0 = RW_P8(TtT, 0), t1 = RW_P8(TtT, 1);
        Tt = __builtin_amdgcn_mfma_f32_32x32x16_bf16(t0, s0, Tt, 0, 0, 0); TtT = __builtin_amdgcn_mfma_f32_32x32x16_bf16(s0, t0, TtT, 0, 0, 0);
        Tt = __builtin_amdgcn_mfma_f32_32x32x16_bf16(t1, s1, Tt, 0, 0, 0); TtT = __builtin_amdgcn_mfma_f32_32x32x16_bf16(s1, t1, TtT, 0, 0, 0);
        X = Sx; Y = Sy;
    }
}
__device__ __forceinline__ void tri_init(LAS unsigned char* lds, int tid) {
    const int row = tid >> 3, kb = (tid & 7) * 8; u32x4 v; unsigned ww[4];
#pragma unroll
    for (int q = 0; q < 4; ++q) ww[q] = ((kb + 2 * q <= row) ? 0x3F80u : 0u) | ((kb + 2 * q + 1 <= row) ? 0x3F800000u : 0u);
    v.x = ww[0]; v.y = ww[1]; v.z = ww[2]; v.w = ww[3]; *(LAS u32x4*)(lds + S_TRI * SLOT + row * RB + kb * 2) = v; }
struct Raw { u32x4 r, k, v, e, a; };
template <bool NEED_R>
__device__ __forceinline__ void raw_load(KArgs a, Raw& R, int item, int tid) {
    const int lane = tid & 63, w = __builtin_amdgcn_readfirstlane(tid >> 6); const int bh = item >> 7, c = item & 127, b = bh >> 4, hd = bh & 15;
    const size_t g0 = ((size_t)b * S + c * 64 + 8 * w) * D + hd * 64;
    const unsigned o = (unsigned)((lane >> 3) * D + (lane & 7) * 8);
    if (NEED_R) R.r = *(const u32x4*)((const bf16_t*)(a->ws + R1) + g0 + o);
    R.k = *(const u32x4*)((const bf16_t*)(a->ws + R2) + g0 + o); R.v = *(const u32x4*)((const bf16_t*)(a->ws + R3) + g0 + o);
    R.e = *(const u32x4*)((const bf16_t*)(a->ws + R4) + g0 + o); R.a = *(const u32x4*)((const bf16_t*)a->out + g0 + o); }
__device__ __forceinline__ void unpack8(const u32x4 w, float (&f)[8]) { f[0] = bf_lo(w.x); f[1] = bf_hi(w.x); f[2] = bf_lo(w.y); f[3] = bf_hi(w.y); f[4] = bf_lo(w.z); f[5] = bf_hi(w.z); f[6] = bf_lo(w.w); f[7] = bf_hi(w.w); }
__device__ __forceinline__ void store_tm(LAS unsigned char* p, const float (&f)[8]) {
    u32x2 lo, hi; lo.x = cvt_pk_c(f[0], f[1]); lo.y = cvt_pk_c(f[2], f[3]); hi.x = cvt_pk_c(f[4], f[5]); hi.y = cvt_pk_c(f[6], f[7]);
    *(LAS u32x2*)p = lo; *(LAS u32x2*)(p + 16) = hi; }
template <bool STAGE_C>
__device__ __forceinline__ void chunk_front(KArgs a, LAS unsigned char* lds, int b, int hd, int c, int tid, Raw& RW, int next_item, u32x4& vraw) {
    const int lane = tid & 63, w = __builtin_amdgcn_readfirstlane(tid >> 6), r = lane & 31, h = lane >> 5;
    LAS float* WLf = (LAS float*)(lds + MISC); LAS float* bon = WLf + 64;
    LAS float* CL = (LAS float*)(lds + S_APT0 * SLOT); constexpr int CS = 68;
    LAS unsigned char* LWT = lds + S_XT0 * SLOT;
    {
        const int tq = lane >> 3, cg = lane & 7, tk = 8 * w + tq, ch = hd * 64 + cg * 8;
        const f32x4 kc0 = *(const f32x4*)(a->in[I_KK] + ch), kc1 = *(const f32x4*)(a->in[I_KK] + ch + 4), ac0 = *(const f32x4*)(a->in[I_KA] + ch), ac1 = *(const f32x4*)(a->in[I_KA] + ch + 4);
        f32x4 rc0 = {0.f, 0.f, 0.f, 0.f}, rc1 = rc0; if (STAGE_C) { rc0 = *(const f32x4*)(a->in[I_RK] + ch); rc1 = *(const f32x4*)(a->in[I_RK] + ch + 4); }
        u32x4 rr, kr4, vr, er, ar;
        if (STAGE_C) { rr.x = pin_u32(RW.r.x); rr.y = pin_u32(RW.r.y); rr.z = pin_u32(RW.r.z); rr.w = pin_u32(RW.r.w); } else rr = (u32x4){0u, 0u, 0u, 0u};
        kr4.x = pin_u32(RW.k.x); kr4.y = pin_u32(RW.k.y); kr4.z = pin_u32(RW.k.z); kr4.w = pin_u32(RW.k.w);
        vr.x = pin_u32(RW.v.x); vr.y = pin_u32(RW.v.y); vr.z = pin_u32(RW.v.z); vr.w = pin_u32(RW.v.w); er.x = pin_u32(RW.e.x); er.y = pin_u32(RW.e.y); er.z = pin_u32(RW.e.z); er.w = pin_u32(RW.e.w);
        ar.x = pin_u32(RW.a.x); ar.y = pin_u32(RW.a.y); ar.z = pin_u32(RW.a.z); ar.w = pin_u32(RW.a.w);
        vraw = vr;
        raw_load<STAGE_C>(a, RW, next_item >= 0 ? next_item : ((b << 4) + hd) * 128 + c, tid);
        const int cmo = tk * 128 + ((cg ^ (((tq >> 1) & 1) << 2)) << 4);
        *(LAS u32x4*)(LWT + cmo) = er;
        *(LAS u32x4*)(lds + S_VT * SLOT + cmo) = vr;
        lds_barrier();
        if (w < 4) { const int ti = w >> 1, cj = w & 1; f32x16 acc = zero16(); acc = mm<false, true>(acc, lds + S_TRI * SLOT, 32 * ti, LWT, 32 * cj, r, h, ti ? 4 : 2);
#pragma unroll
            for (int q = 0; q < 16; ++q) CL[(32 * ti + rowmap(q, h)) * CS + 32 * cj + r] = acc[q]; }
        float rv[8], kv[8], lw[8], lr[8], kk[8], kp[8];
        unpack8(rr, rv); unpack8(kr4, kv); unpack8(er, lw); unpack8(ar, lr);
        { const float kkc[8] = {kc0[0], kc0[1], kc0[2], kc0[3], kc1[0], kc1[1], kc1[2], kc1[3]}, kac[8] = {ac0[0], ac0[1], ac0[2], ac0[3], ac1[0], ac1[1], ac1[2], ac1[3]};
          float ss = 0.f;
#pragma unroll
          for (int j = 0; j < 8; ++j) { kk[j] = kv[j] * kkc[j]; ss += kk[j] * kk[j]; kp[j] = kv[j] * (1.0f + (lr[j] - 1.0f) * kac[j]); }
          const float rn = __builtin_amdgcn_rsqf(fmaxf(sum8(ss), 1e-24f));
#pragma unroll
          for (int j = 0; j < 8; ++j) kk[j] *= rn;
          if (STAGE_C) { const float rkc[8] = {rc0[0], rc0[1], rc0[2], rc0[3], rc1[0], rc1[1], rc1[2], rc1[3]};
              float bs = 0.f;
#pragma unroll
              for (int j = 0; j < 8; ++j) bs += rv[j] * kp[j] * rkc[j];
              bs = sum8(bs); if (cg == 0) bon[tk] = bs; } }
        lds_barrier();
        const f32x4 c10 = *(const LAS f32x4*)(CL + tk * CS + cg * 8), c11 = *(const LAS f32x4*)(CL + tk * CS + cg * 8 + 4), ct0 = *(const LAS f32x4*)(CL + 63 * CS + cg * 8), ct1 = *(const LAS f32x4*)(CL + 63 * CS + cg * 8 + 4);
        const float c1[8] = {c10[0], c10[1], c10[2], c10[3], c11[0], c11[1], c11[2], c11[3]}, ct[8] = {ct0[0], ct0[1], ct0[2], ct0[3], ct1[0], ct1[1], ct1[2], ct1[3]};
        if (!STAGE_C && tk == 63) {
            f32x4 w0, w1;
#pragma unroll
            for (int j = 0; j < 4; ++j) { w0[j] = __builtin_amdgcn_exp2f(1.44269504f * ct[j]); w1[j] = __builtin_amdgcn_exp2f(1.44269504f * ct[4 + j]); }
            *(LAS f32x4*)(WLf + cg * 8) = w0; *(LAS f32x4*)(WLf + cg * 8 + 4) = w1; }
        float at[8], bt[8], kt[8], rt[8], bh[8], kh[8];
#pragma unroll
        for (int j = 0; j < 8; ++j) { const float c0 = c1[j] - lw[j]; const float ep = __builtin_amdgcn_exp2f(1.44269504f * c1[j]), em = __builtin_amdgcn_rcpf(ep);
            at[j] = -kk[j] * __builtin_amdgcn_exp2f(1.44269504f * c0); const float kl = kk[j] * lr[j]; bt[j] = kl * em; kt[j] = kp[j] * em; rt[j] = rv[j] * ep;
            if (!STAGE_C) { const float ew = __builtin_amdgcn_exp2f(1.44269504f * (ct[j] - c1[j])); bh[j] = kl * ew; kh[j] = kp[j] * ew; } }
        { const int tmo = tk * RB + (32 * (cg >> 1) + 8 * (cg & 1));
          store_tm(lds + S_AT * SLOT + tmo, at); store_tm(lds + S_BT * SLOT + tmo, bt); store_tm(lds + S_KT * SLOT + tmo, kt); if (STAGE_C) store_tm(lds + S_RT * SLOT + tmo, rt); }
        if (!STAGE_C) { *(LAS u32x4*)(lds + S_ATT * SLOT + cmo) = __builtin_bit_cast(u32x4, pack8c(at[0], at[1], at[2], at[3], at[4], at[5], at[6], at[7]));
            *(LAS u32x4*)(lds + S_BHT * SLOT + cmo) = __builtin_bit_cast(u32x4, pack8c(bh[0], bh[1], bh[2], bh[3], bh[4], bh[5], bh[6], bh[7]));
            *(LAS u32x4*)(lds + S_KHT * SLOT + cmo) = __builtin_bit_cast(u32x4, pack8c(kh[0], kh[1], kh[2], kh[3], kh[4], kh[5], kh[6], kh[7])); }
    }
    lds_barrier();
    if (w < 2) { f32x16 A = zero16(), AT = zero16(); A = mm(A, lds + S_AT * SLOT, 32 * w, lds + S_BT * SLOT, 32 * w, r, h, 4); AT = mm(AT, lds + S_BT * SLOT, 32 * w, lds + S_AT * SLOT, 32 * w, r, h, 4);
#pragma unroll
        for (int q = 0; q < 16; ++q) { A[q] = (rowmap(q, h) > r) ? A[q] : 0.f; AT[q] = (rowmap(q, h) < r) ? AT[q] : 0.f; }
        f32x16 Ti, TiT; inv32(A, AT, Ti, TiT, r, h);
        write_T(lds + S_TM * SLOT, 32 * w, 32 * w, TiT, r, h);
        if (w == 0) write_T(lds + S_APT1 * SLOT + 32 * RB, 0, 0, Ti, r, h); }
    else if (w == 2) { f32x16 A = zero16(); A = mm(A, lds + S_AT * SLOT, 32, lds + S_BT * SLOT, 0, r, h, 4); write_R(lds + S_APT1 * SLOT, 0, 0, A, r, h); }
    else if (w < 6) { const int ti = (w == 3) ? 0 : 1, tj = (w == 5) ? 1 : 0; f32x16 x = zero16(); x = mm(x, lds + S_AT * SLOT, 32 * ti, lds + S_KT * SLOT, 32 * tj, r, h, 4);
#pragma unroll
        for (int q = 0; q < 16; ++q) { const bool keep = (ti != tj) || (rowmap(q, h) > r); x[q] = keep ? x[q] : 0.f; }
        write_R(lds + S_AAK * SLOT, 32 * ti, 32 * tj, x, r, h); }
    else if (w == 6) { zero_tile(lds + S_AAK * SLOT, 0, 32, lane); zero_tile(lds + S_TM * SLOT, 0, 32, lane); }
    if (STAGE_C && w >= 2) {
        const int t6 = w - 2, t3 = t6 % 3, ti = t3 == 0 ? 0 : 1, tj = t3 == 2 ? 1 : 0; const bool isk = t6 >= 3;
        f32x16 x = zero16(); x = mm(x, lds + S_RT * SLOT, 32 * ti, lds + (isk ? S_KT : S_BT) * SLOT, 32 * tj, r, h, 4);
#pragma unroll
        for (int q = 0; q < 16; ++q) { const bool keep = (ti != tj) || (rowmap(q, h) >= r); x[q] = keep ? x[q] : 0.f; }
        write_R(lds + (isk ? S_ARK : S_ARB) * SLOT, 32 * ti, 32 * tj, x, r, h);
        if (w == 7) { zero_tile(lds + S_ARB * SLOT, 0, 32, lane); zero_tile(lds + S_ARK * SLOT, 0, 32, lane); } }
    lds_barrier();
}
__device__ __forceinline__ void t10_step(LAS unsigned char* lds, int r, int h) {
    f32x16 X = zero16(); X = mm(X, lds + S_APT1 * SLOT, 0, lds + S_APT1 * SLOT + 32 * RB, 0, r, h, 2);
    f32x16 T10 = zero16();
#pragma unroll
    for (int s2 = 0; s2 < 2; ++s2) { const LAS unsigned char* p = lds + S_TM * SLOT + (32 + r) * RB + (32 + 16 * s2 + 4 * h) * 2; const u32x2 lo = *(const LAS u32x2*)p, hi = *(const LAS u32x2*)(p + 16);
        u32x4 aw; aw.x = lo.x; aw.y = lo.y; aw.z = hi.x; aw.w = hi.y;
        const bf16x8 bfr = s2 == 0 ? pack8c(X[0], X[1], X[2], X[3], X[4], X[5], X[6], X[7]) : pack8c(X[8], X[9], X[10], X[11], X[12], X[13], X[14], X[15]);
        T10 = __builtin_amdgcn_mfma_f32_32x32x16_bf16(__builtin_bit_cast(bf16x8, aw), bfr, T10, 0, 0, 0); }
    write_R(lds + S_TM * SLOT, 32, 0, T10, r, h);
}

__device__ __forceinline__ void stage_a(KArgs a, LAS unsigned char* lds, int bid, int nb) {
    const int tid = opaque_tid(), lane = tid & 63, w = __builtin_amdgcn_readfirstlane(tid >> 6), r = lane & 31, h = lane >> 5;
    unsigned char* MF = a->ws + R6; unsigned char* GF = a->ws + R0;
    const LAS float* WLf = (const LAS float*)(lds + MISC);
    const int per = (NB * 16 * 128 + nb - 1) / nb, item0 = bid * per, item1 = (item0 + per < NB * 16 * 128) ? item0 + per : NB * 16 * 128;
    Raw RW; if (item0 < item1) raw_load<false>(a, RW, item0, tid);
    tri_init(lds, tid);
    for (int item = item0; item < item1; ++item) {
        const int bh = item >> 7, c = item & 127, b = bh >> 4, hd = bh & 15;
        lds_barrier();
        u32x4 vdummy; chunk_front<false>(a, lds, b, hd, c, tid, RW, (item + 1 < item1) ? item + 1 : -1, vdummy);
        const int ti = (w >> 1) & 1, tj = w & 1;
        if (w == 2) t10_step(lds, r, h);
        else if (w >= 4) { f32x16 x = zero16(); x = mm<false, true>(x, lds + S_AAK * SLOT, 32 * ti, lds + S_VT * SLOT, 32 * tj, r, h, 4); write_T(lds + S_XT1 * SLOT, 32 * tj, 32 * ti, x, r, h); }
        lds_barrier();
        if (w < 4) { f32x16 p = zero16(); p = mm<false, true>(p, lds + S_TM * SLOT, 32 * ti, lds + S_ATT * SLOT, 32 * tj, r, h, 4); write_T(lds + S_XT0 * SLOT, 32 * tj, 32 * ti, p, r, h); }
        else { f32x16 q2 = zero16(); q2 = mm(q2, lds + S_TM * SLOT, 32 * ti, lds + S_XT1 * SLOT, 32 * tj, r, h, 4); write_T(lds + S_APT0 * SLOT, 32 * tj, 32 * ti, q2, r, h); }
        lds_barrier();
        f32x16 res = zero16();
        if (w < 4) { res = mm<false, true>(res, lds + S_XT0 * SLOT, 32 * ti, lds + S_BHT * SLOT, 32 * tj, r, h, 4);
            if (ti == tj) {
#pragma unroll
                for (int q = 0; q < 16; ++q) if (rowmap(q, h) == r) res[q] += WLf[32 * ti + r]; } }
        else { res = mm<true, false>(res, lds + S_BHT * SLOT, 32 * ti, lds + S_APT0 * SLOT, 32 * tj, r, h, 4); res = mm<true, true>(res, lds + S_KHT * SLOT, 32 * ti, lds + S_VT * SLOT, 32 * tj, r, h, 4); }
        { unsigned char* d0 = (w < 4) ? MF + (size_t)item * 8192 + (tj * 4 + 2 * ti) * 1024 + lane * 16 : GF + (size_t)item * 8192 + (tj * 2 + ti) * 2048 + lane * 16;
          unsigned char* d1 = d0 + 1024;
          { *(u32x4*)d0 = __builtin_bit_cast(u32x4, pack8c(res[0], res[1], res[2], res[3], res[4], res[5], res[6], res[7]));
                         *(u32x4*)d1 = __builtin_bit_cast(u32x4, pack8c(res[8], res[9], res[10], res[11], res[12], res[13], res[14], res[15])); } }
    }
    __syncthreads();
}

__device__ __forceinline__ void stage_b(KArgs a, LAS unsigned char* lds, int bh) {
    const int tid = opaque_tid(), lane = tid & 63, w = __builtin_amdgcn_readfirstlane(tid >> 6);
    constexpr int DD = 7, NS = 9, NSTEP = 128;
    const unsigned char* MF = a->ws + R6 + (size_t)bh * NSTEP * 8192; unsigned char* GF = a->ws + R0 + (size_t)bh * NSTEP * 8192;
    f32x16 H0 = zero16(), H1 = zero16();
#define RW_ISSUE(step_) do { const int step__ = (step_); const int st = step__ < NSTEP ? step__ : NSTEP - 1; LAS unsigned char* slot = lds + (step__ % NS) * 16384; \
        _Pragma("unroll") for (int p = 0; p < 4; ++p) { const int pc = (w - 4) * 4 + p; const unsigned char* src = (pc < 8 ? MF + (size_t)st * 8192 + pc * 1024 : GF + (size_t)st * 8192 + (pc - 8) * 1024) + lane * 16; \
            __builtin_amdgcn_global_load_lds((const unsigned*)src, (LAS unsigned*)(slot + pc * 1024), 16, 0, 0); } } while (0)
    if (w >= 4) {
#pragma unroll 1
        for (int s0 = 0; s0 < DD; ++s0) RW_ISSUE(s0); }
#pragma unroll 1
    for (int c = 0; c < NSTEP; ++c) {
        if (w >= 4) { RW_ISSUE(c + DD); asm volatile("s_waitcnt vmcnt(28)" ::: "memory"); }
        __builtin_amdgcn_s_barrier(); asm volatile("" ::: "memory");
        if (w < 2) {
            const LAS unsigned char* slot = lds + (c % NS) * 16384;
            bf16x8 f[4];
            f[0] = pack8c(H0[0], H0[1], H0[2], H0[3], H0[4], H0[5], H0[6], H0[7]); f[1] = pack8c(H0[8], H0[9], H0[10], H0[11], H0[12], H0[13], H0[14], H0[15]);
            f[2] = pack8c(H1[0], H1[1], H1[2], H1[3], H1[4], H1[5], H1[6], H1[7]); f[3] = pack8c(H1[8], H1[9], H1[10], H1[11], H1[12], H1[13], H1[14], H1[15]);
            const u32x4 g00 = *(const LAS u32x4*)(slot + 8192 + (w * 2 + 0) * 2048 + lane * 16), g01 = *(const LAS u32x4*)(slot + 8192 + (w * 2 + 0) * 2048 + 1024 + lane * 16);
            const u32x4 g10 = *(const LAS u32x4*)(slot + 8192 + (w * 2 + 1) * 2048 + lane * 16), g11 = *(const LAS u32x4*)(slot + 8192 + (w * 2 + 1) * 2048 + 1024 + lane * 16);
            f32x16 n0, n1;
            { const unsigned ww[8] = {g00.x, g00.y, g00.z, g00.w, g01.x, g01.y, g01.z, g01.w};
#pragma unroll
              for (int q = 0; q < 8; ++q) { n0[2 * q] = bf_lo(ww[q]); n0[2 * q + 1] = bf_hi(ww[q]); } }
            { const unsigned ww[8] = {g10.x, g10.y, g10.z, g10.w, g11.x, g11.y, g11.z, g11.w};
#pragma unroll
              for (int q = 0; q < 8; ++q) { n1[2 * q] = bf_lo(ww[q]); n1[2 * q + 1] = bf_hi(ww[q]); } }
#pragma unroll
            for (int ks = 0; ks < 4; ++ks) { n0 = __builtin_amdgcn_mfma_f32_32x32x16_bf16(*(const LAS bf16x8*)(slot + (0 * 4 + ks) * 1024 + lane * 16), f[ks], n0, 0, 0, 0);
                                             n1 = __builtin_amdgcn_mfma_f32_32x32x16_bf16(*(const LAS bf16x8*)(slot + (1 * 4 + ks) * 1024 + lane * 16), f[ks], n1, 0, 0, 0); }
            unsigned char* hdst = GF + (size_t)c * 8192;
#pragma unroll
            for (int ks = 0; ks < 4; ++ks) *(u32x4*)(hdst + ((w * 4 + ks) * 64 + lane) * 16) = __builtin_bit_cast(u32x4, f[ks]);
            H0 = n0; H1 = n1;
        }
    }
    asm volatile("s_waitcnt vmcnt(0)" ::: "memory");
    lds_barrier();
}

__device__ __forceinline__ void stage_c(KArgs a, LAS unsigned char* lds, int bid, int nb) {
    const int tid = opaque_tid(), lane = tid & 63, w = __builtin_amdgcn_readfirstlane(tid >> 6), r = lane & 31, h = lane >> 5;
    const unsigned char* HF = a->ws + R0; bf16_t* Yg = (bf16_t*)(a->ws + R6);
    const bf16_t* Vg = (const bf16_t*)(a->ws + R3); const bf16_t* Gg = (const bf16_t*)a->out + (size_t)T * D;
    const LAS float* bon = (const LAS float*)(lds + MISC) + 64;
    LAS float* yb = (LAS float*)(lds + S_AP0 * SLOT); constexpr int YS = 68;
    const int per = (NB * 16 * 128 + nb - 1) / nb, item0 = bid * per, item1 = (item0 + per < NB * 16 * 128) ? item0 + per : NB * 16 * 128;
    Raw RW; if (item0 < item1) raw_load<true>(a, RW, item0, tid);
    tri_init(lds, tid);
    for (int item = item0; item < item1; ++item) {
        const int bh = item >> 7, c = item & 127, b = bh >> 4, hd = bh & 15;
        lds_barrier();
        u32x4 pvv; chunk_front<true>(a, lds, b, hd, c, tid, RW, (item + 1 < item1) ? item + 1 : -1, pvv);
        const int ptk = 8 * w + (lane >> 3), pcg = lane & 7;
        const size_t po = ((size_t)b * S + c * 64 + ptk) * D + hd * 64 + pcg * 8;
        const u32x4 pgv = *(const u32x4*)(Gg + po);
        const int ytile = w - 4, rtile = (w == 0) ? 0 : (w == 1) ? 1 : (w == 3) ? 2 : (w == 5) ? 3 : -1;
        const int tjw = (w >= 4) ? (w & 1) : (w == 1 ? 1 : 0);
        bf16x8 hf[4];
        { const unsigned char* hsrc = HF + (size_t)item * 8192;
#pragma unroll
          for (int ks = 0; ks < 4; ++ks) hf[ks] = *(const bf16x8*)(hsrc + ((tjw * 4 + ks) * 64 + lane) * 16); }
        f32x16 y = zero16();
        if (w == 2) t10_step(lds, r, h);
        if (w >= 4) { const int ti = (ytile >> 1) & 1;
#pragma unroll
            for (int ks = 0; ks < 4; ++ks) y = __builtin_amdgcn_mfma_f32_32x32x16_bf16(*(const LAS bf16x8*)(lds + S_RT * SLOT + (32 * ti + r) * RB + (16 * ks + 8 * h) * 2), hf[ks], y, 0, 0, 0);
            y = mm<false, true>(y, lds + S_ARK * SLOT, 32 * ti, lds + S_VT * SLOT, 32 * tjw, r, h, 4); }
        if (rtile >= 0) { const int ti = (rtile >> 1) & 1; f32x16 x = zero16();
#pragma unroll
            for (int ks = 0; ks < 4; ++ks) x = __builtin_amdgcn_mfma_f32_32x32x16_bf16(*(const LAS bf16x8*)(lds + S_AT * SLOT + (32 * ti + r) * RB + (16 * ks + 8 * h) * 2), hf[ks], x, 0, 0, 0);
            x = mm<false, true>(x, lds + S_AAK * SLOT, 32 * ti, lds + S_VT * SLOT, 32 * tjw, r, h, 4);
            write_T(lds + S_XT0 * SLOT, 32 * tjw, 32 * ti, x, r, h); }
        lds_barrier();
        if (w < 4) { const int ti = (w >> 1) & 1, tj = w & 1; f32x16 u = zero16(); u = mm(u, lds + S_TM * SLOT, 32 * ti, lds + S_XT0 * SLOT, 32 * tj, r, h, 4); write_T(lds + S_APT0 * SLOT, 32 * tj, 32 * ti, u, r, h); }
        lds_barrier();
        if (w >= 4) { const int ti = (ytile >> 1) & 1; y = mm(y, lds + S_ARB * SLOT, 32 * ti, lds + S_APT0 * SLOT, 32 * tjw, r, h, 4);
#pragma unroll
            for (int q = 0; q < 16; ++q) yb[(32 * ti + rowmap(q, h)) * YS + 32 * tjw + r] = y[q]; }
        lds_barrier();
        {
            const int ch = hd * 64 + pcg * 8;
            const f32x4 y0 = *(const LAS f32x4*)(yb + ptk * YS + pcg * 8), y1 = *(const LAS f32x4*)(yb + ptk * YS + pcg * 8 + 4);
            const f32x4 g0 = *(const f32x4*)(a->in[I_LNG] + ch), g1 = *(const f32x4*)(a->in[I_LNG] + ch + 4), b0 = *(const f32x4*)(a->in[I_LNB] + ch), b1 = *(const f32x4*)(a->in[I_LNB] + ch + 4);
            const float mean = sum8(((y0[0] + y0[1]) + (y0[2] + y0[3])) + ((y1[0] + y1[1]) + (y1[2] + y1[3]))) * (1.0f / 64.0f);
            const f32x4 d0 = y0 - mean, d1 = y1 - mean;
            const float var = sum8(((d0[0] * d0[0] + d0[1] * d0[1]) + (d0[2] * d0[2] + d0[3] * d0[3])) + ((d1[0] * d1[0] + d1[1] * d1[1]) + (d1[2] * d1[2] + d1[3] * d1[3]))) * (1.0f / 64.0f);
            const float rs = __builtin_amdgcn_rsqf(var + 64e-5f), bn = bon[ptk];
            const f32x4 v0 = (f32x4){bf_lo(pvv.x), bf_hi(pvv.x), bf_lo(pvv.y), bf_hi(pvv.y)}, v1 = (f32x4){bf_lo(pvv.z), bf_hi(pvv.z), bf_lo(pvv.w), bf_hi(pvv.w)};
            const f32x4 q0 = (f32x4){bf_lo(pgv.x), bf_hi(pgv.x), bf_lo(pgv.y), bf_hi(pgv.y)}, q1 = (f32x4){bf_lo(pgv.z), bf_hi(pgv.z), bf_lo(pgv.w), bf_hi(pgv.w)};
            const f32x4 o0 = ((d0 * rs) * g0 + b0 + v0 * bn) * q0, o1 = ((d1 * rs) * g1 + b1 + v1 * bn) * q1;
            *(u32x4*)(Yg + po) = pack8(o0, o1);
        }
    }
    __syncthreads();
}
}

template <bool DIAG>
__device__ __forceinline__ void sb_block(const f32x16& s, const bf16x8 (&tri)[2], float R, int r, int hh, bf16x8& pb0, bf16x8& pb1, float& tsum) {
    f32x2 X2[8], zr2[8], ts2 = {0.f, 0.f};
#pragma unroll
    for (int qp = 0; qp < 8; ++qp) { const int q0 = 2 * qp, q1 = q0 + 1; const f32x2 z2 = {s[q0], s[q1]};
        const f32x2 e2 = {__builtin_amdgcn_exp2f(-fabsf(z2.x)), __builtin_amdgcn_exp2f(-fabsf(z2.y))};
        const f32x2 u2 = e2 + 1.0f;
        const f32x2 l2 = {__builtin_amdgcn_logf(u2.x), __builtin_amdgcn_logf(u2.y)}, m2 = {fmaxf(z2.x, 0.f), fmaxf(z2.y, 0.f)};
        const f32x2 sp2 = m2 + l2;
        f32x2 x2 = -sp2;
        if (DIAG) { const int k0 = (q0 & 3) + 8 * (q0 >> 2) + 4 * hh, k1 = (q1 & 3) + 8 * (q1 >> 2) + 4 * hh; x2.x = (k0 < r) ? x2.x : 0.f; x2.y = (k1 < r) ? x2.y : 0.f; }
        X2[qp] = x2; ts2 += x2; zr2[qp] = (z2 - sp2) + R; }
    tsum = ts2.x + ts2.y;
    const bf16x8 xb0 = pack8c(X2[0].x, X2[0].y, X2[1].x, X2[1].y, X2[2].x, X2[2].y, X2[3].x, X2[3].y), xb1 = pack8c(X2[4].x, X2[4].y, X2[5].x, X2[5].y, X2[6].x, X2[6].y, X2[7].x, X2[7].y);
    f32x16 c = rw::zero16();
    c = __builtin_amdgcn_mfma_f32_32x32x16_bf16(tri[0], xb0, c, 0, 0, 0); c = __builtin_amdgcn_mfma_f32_32x32x16_bf16(tri[1], xb1, c, 0, 0, 0);
    float P[16];
#pragma unroll
    for (int qp = 0; qp < 8; ++qp) { const int q0 = 2 * qp, q1 = q0 + 1; const f32x2 a2 = zr2[qp] + (f32x2){c[q0], c[q1]};
        float p0 = __builtin_amdgcn_exp2f(a2.x), p1 = __builtin_amdgcn_exp2f(a2.y);
        if (DIAG) { const int k0 = (q0 & 3) + 8 * (q0 >> 2) + 4 * hh, k1 = (q1 & 3) + 8 * (q1 >> 2) + 4 * hh; p0 = (k0 < r) ? p0 : 0.f; p1 = (k1 < r) ? p1 : 0.f; }
        P[q0] = p0; P[q1] = p1; }
    pb0 = pack8c(P[0], P[1], P[2], P[3], P[4], P[5], P[6], P[7]); pb1 = pack8c(P[8], P[9], P[10], P[11], P[12], P[13], P[14], P[15]);
}
__device__ __forceinline__ void sbattn_phase(KArgs a, LAS unsigned char* lds, int bid, int nb) {
    const int tid = opaque_tid(), lane = tid & 63, w = __builtin_amdgcn_readfirstlane(tid >> 6), r = lane & 31, hh = lane >> 5;
    constexpr int NR = 10, KROWB = 144, KBLK = 32 * KROWB, VROWB = 192, VBLK = 32 * VROWB;
    LAS unsigned char* Kr = lds; LAS unsigned char* Vr = lds + NR * KBLK; LAS unsigned char* Ost = Vr + NR * VBLK; volatile LAS int* flag = (volatile LAS int*)(Ost + 8 * 4608);
    const bf16_t* Kg = (const bf16_t*)(a->ws + R2); const bf16_t* Vg = (const bf16_t*)(a->ws + R3); const bf16_t* Qg = (const bf16_t*)(a->ws + R4); bf16_t* Og = (bf16_t*)(a->ws + R0);
    bf16x8 tri[2];
#pragma unroll
    for (int ks = 0; ks < 2; ++ks) {
#pragma unroll
        for (int jj = 0; jj < 8; ++jj) { const int key = 16 * ks + 8 * (jj >> 2) + 4 * hh + (jj & 3); tri[ks][jj] = (key > r) ? (short)0x3F80 : (short)0; } }
    const int skey = (tid & 255) >> 3, sch = tid & 7; const bool isv = tid >= 256;
    u32x4 pre[8];
#define SB_REQUEST(unit_) do { const int u_ = (unit_); const int b_ = u_ >> 9, h_ = (u_ >> 5) & 15, qt_ = u_ & 31; const size_t hb_ = (size_t)b_ * S * D + h_ * 64; \
        _Pragma("unroll") for (int m = 0; m < 8; ++m) { const size_t go = hb_ + (size_t)((qt_ * 8 + m) * 32 + skey) * D + sch * 8; pre[m] = isv ? *(const u32x4*)(Vg + go) : *(const u32x4*)(Kg + go); } } while (0)
    if (bid < NB * 16 * 32) SB_REQUEST(bid);
    for (int unit = bid; unit < NB * 16 * 32; unit += nb) {
        const int b = unit >> 9, h = (unit >> 5) & 15, qt = unit & 31, q0 = qt * 256, kb0 = qt * 8;
        const size_t hbase = (size_t)b * S * D + h * 64;
        lds_barrier();
        if (tid < 3) flag[tid] = 0;
        bf16x8 Qf[4];
        { const bf16_t* qp = Qg + hbase + (size_t)(q0 + 32 * w + r) * D + 8 * hh;
#pragma unroll
          for (int ks = 0; ks < 4; ++ks) Qf[ks] = *(const bf16x8*)(qp + 16 * ks); }
        {
#pragma unroll
            for (int m = 0; m < 8; ++m) { const int slot = (kb0 + m) % NR; const u32x4 v = pre[m];
                if (!isv) *(LAS u32x4*)(Kr + slot * KBLK + skey * KROWB + sch * 16) = v;
                else *(LAS u32x4*)(Vr + slot * VBLK + skey * VROWB + sch * 16) = v; }
        }
        f32x16 o0, o1;
#pragma unroll
        for (int i = 0; i < 16; ++i) { o0[i] = 0.f; o1[i] = 0.f; }
        float R = 0.f; bool wdone = false;
        u32x4 sg0 = (u32x4){0u, 0u, 0u, 0u}, sg1 = sg0, sg2 = sg0;
        { const int n0 = kb0 - 1, n1 = kb0 - 2, n2 = kb0 - 3;
          if (n0 >= 0) { const size_t go = hbase + (size_t)(n0 * 32 + skey) * D + sch * 8; sg0 = isv ? *(const u32x4*)(Vg + go) : *(const u32x4*)(Kg + go); }
          if (n1 >= 0) { const size_t go = hbase + (size_t)(n1 * 32 + skey) * D + sch * 8; sg1 = isv ? *(const u32x4*)(Vg + go) : *(const u32x4*)(Kg + go); }
          if (n2 >= 0) { const size_t go = hbase + (size_t)(n2 * 32 + skey) * D + sch * 8; sg2 = isv ? *(const u32x4*)(Vg + go) : *(const u32x4*)(Kg + go); } }
        if (unit + nb < NB * 16 * 32) SB_REQUEST(unit + nb);
        for (int i = 0;; ++i) {
            lds_barrier();
            if (i > 0 && flag[(i - 1) % 3] == 0) break;
            if (tid == 0) flag[(i + 1) % 3] = 0;
            const int nblk = kb0 - i - 1;
            const u32x4 stg = sg0; sg0 = sg1; sg1 = sg2;
            { const int nf = kb0 - i - 4; sg2 = (u32x4){0u, 0u, 0u, 0u};
              if (nf >= 0) { const size_t go = hbase + (size_t)(nf * 32 + skey) * D + sch * 8; sg2 = isv ? *(const u32x4*)(Vg + go) : *(const u32x4*)(Kg + go); } }
            const int kb = kb0 + w - i;
            if (!wdone && kb >= 0) {
                const int slot = kb % NR;
                f32x16 s;
#pragma unroll
                for (int q = 0; q < 16; ++q) s[q] = 0.f;
#pragma unroll
                for (int ks = 0; ks < 4; ++ks) { const bf16x8 kf = *(const LAS bf16x8*)(Kr + slot * KBLK + r * KROWB + (16 * ks + 8 * hh) * 2); s = __builtin_amdgcn_mfma_f32_32x32x16_bf16(kf, Qf[ks], s, 0, 0, 0); }
                bf16x8 pb0, pb1; float tsum;
                if (i == 0) sb_block<true>(s, tri, R, r, hh, pb0, pb1, tsum); else sb_block<false>(s, tri, R, r, hh, pb0, pb1, tsum);
                const LAS unsigned char* vbase = Vr + slot * VBLK + (4 * hh + ((lane & 15) >> 2)) * VROWB + (16 * ((lane >> 4) & 1) + 4 * (lane & 3)) * 2;
#define SB_VT(s_, c_) __builtin_shufflevector(__builtin_amdgcn_ds_read_tr16_b64_v4i16((LAS s16x4*)(vbase + (16 * (s_)) * VROWB + 64 * (c_))), __builtin_amdgcn_ds_read_tr16_b64_v4i16((LAS s16x4*)(vbase + (16 * (s_) + 8) * VROWB + 64 * (c_))), 0, 1, 2, 3, 4, 5, 6, 7)
                { const bf16x8 v00 = SB_VT(0, 0), v10 = SB_VT(1, 0);
                  o0 = __builtin_amdgcn_mfma_f32_32x32x16_bf16(v00, pb0, o0, 0, 0, 0);
                  o0 = __builtin_amdgcn_mfma_f32_32x32x16_bf16(v10, pb1, o0, 0, 0, 0); }
                __builtin_amdgcn_sched_barrier(0);
                { const bf16x8 v01 = SB_VT(0, 1), v11 = SB_VT(1, 1);
                  o1 = __builtin_amdgcn_mfma_f32_32x32x16_bf16(v01, pb0, o1, 0, 0, 0);
                  o1 = __builtin_amdgcn_mfma_f32_32x32x16_bf16(v11, pb1, o1, 0, 0, 0); }
#undef SB_VT
                tsum += __shfl_xor(tsum, 32); R += tsum;
                wdone = (kb == 0) || (__builtin_amdgcn_ballot_w64(R >= -160.0f) == 0ull);
                if (!wdone && lane == 0) flag[i % 3] = 1;
            }
            if (nblk >= 0) { const int slot = nblk % NR;
                if (!isv) *(LAS u32x4*)(Kr + slot * KBLK + skey * KROWB + sch * 16) = stg;
                else *(LAS u32x4*)(Vr + slot * VBLK + skey * VROWB + sch * 16) = stg; }
        }
        { LAS bf16_t* ow = (LAS bf16_t*)(Ost + w * 4608);
#pragma unroll
          for (int m = 0; m < 4; ++m) { u32x2 wa, wb; wa.x = cvt_pk_c(o0[4 * m], o0[4 * m + 1]); wa.y = cvt_pk_c(o0[4 * m + 2], o0[4 * m + 3]); wb.x = cvt_pk_c(o1[4 * m], o1[4 * m + 1]); wb.y = cvt_pk_c(o1[4 * m + 2], o1[4 * m + 3]);
              *(LAS u32x2*)(ow + r * 72 + 8 * m + 4 * hh) = wa; *(LAS u32x2*)(ow + r * 72 + 32 + 8 * m + 4 * hh) = wb; }
          asm volatile("s_waitcnt lgkmcnt(0)" ::: "memory");
#pragma unroll
          for (int c4 = 0; c4 < 4; ++c4) { const int idx = c4 * 64 + lane, row = idx >> 3, ch = idx & 7; const u32x4 v = *(const LAS u32x4*)(ow + row * 72 + ch * 8);
              *(u32x4*)(Og + hbase + (size_t)(q0 + 32 * w + row) * D + ch * 8) = v; }
          asm volatile("s_waitcnt lgkmcnt(0)" ::: "memory"); }
    }
#undef SB_REQUEST
    __syncthreads();
}

__device__ __forceinline__ void assign_phase(KArgs a, int l, LAS unsigned char* lds, int bid, int nb) {
    const int tid = opaque_tid(), lane = tid & 63, wave = tid >> 6;
    LAS int* pst = (LAS int*)lds; LAS int* lc = pst + 64; LAS int* lbase = lc + 32; LAS int* a_tok = lbase + 32; LAS int* a_slot = a_tok + 512;
    unsigned* ctl = (unsigned*)a->ws;
    if (tid == 0) { int accv = 0; for (int e = 0; e < 32; ++e) { pst[e] = accv; accv += (int)((__hip_atomic_load(ctl + CW_CNT + 64 * l + e, __ATOMIC_RELAXED, __HIP_MEMORY_SCOPE_AGENT) + 255u) / 256u * 256u); } pst[32] = accv; }
    if (tid < 32) lc[tid] = 0;
    __syncthreads();
    int* tile_expert = (int*)(a->ws + WS_TILEEXP);
    if (bid == 0) { const int ntl = pst[32] >> 8; if (tid == 0) ctl[CW_NT + 64 * l] = (unsigned)ntl;
        for (int ti = tid; ti < ntl; ti += 512) { int e = 0; for (int q = 1; q < 32; ++q) if (pst[q] <= ti * 256) e = q; tile_expert[ti] = e; } }
    const u32x4* tok = (const u32x4*)(a->ws + WS_TOK); int* slot_of = (int*)(a->ws + WS_SLOTOF); float* slot_info = (float*)(a->ws + WS_SLOTINFO);
    int* slot_tok = (int*)(a->ws + WS_SLOTTOK);
    for (int chunk = bid; chunk < T / 256; chunk += nb) {
        const int t = chunk * 256 + (tid >> 1), kk = tid & 1;
        const u32x4 info = tok[t]; const int e = kk ? (int)((info.x >> 8) & 0xff) : (int)(info.x & 0xff);
        const unsigned gbits = kk ? info.z : info.y, rbits = info.w;
        const float gate = __uint_as_float(gbits), rstd = __uint_as_float(rbits);
        const int rank = atomicAdd((int*)&lc[e], 1);
        __syncthreads();
        if (tid < 32) lbase[tid] = (int)__hip_atomic_fetch_add(ctl + CW_FILL + 64 * l + tid, (unsigned)lc[tid], __ATOMIC_RELAXED, __HIP_MEMORY_SCOPE_AGENT);
        __syncthreads();
        const int slot = pst[e] + lbase[e] + rank;
        slot_of[t * 2 + kk] = slot; slot_info[(size_t)slot * 2] = gate; slot_info[(size_t)slot * 2 + 1] = rstd; slot_tok[slot] = t;
        __syncthreads();
        if (tid < 32) lc[tid] = 0;
        __syncthreads();
    }
}

__device__ __forceinline__ void combine_phase(KArgs a, bool fin, int bid, int nb, float msc = 1.f) {
    const int tid = opaque_tid(), lane = tid & 63, wave = tid >> 6;
    float* x = a->out; const bf16_t* ys = (const bf16_t*)(a->ws + R2); const int* slot_of = (const int*)(a->ws + WS_SLOTOF);
    bf16_t* xb = (bf16_t*)(a->ws + R1); float* ssq = (float*)(a->ws + WS_SSQ); const float* nf = a->in[I_NORM_FINAL];
    u32x4 px[2], py1[2], py2[2];
    { const int row0 = bid * 8 + wave; const int s1 = slot_of[row0 * 2], s2 = slot_of[row0 * 2 + 1];
#pragma unroll
      for (int k = 0; k < 2; ++k) { px[k] = *(const u32x4*)(xb + (size_t)row0 * D + k * 512 + lane * 8); py1[k] = *(const u32x4*)(ys + (size_t)s1 * D + k * 512 + lane * 8); py2[k] = *(const u32x4*)(ys + (size_t)s2 * D + k * 512 + lane * 8); } }
    for (int row = bid * 8 + wave; row < T; row += nb * 8) {
        f32x4 xv[4]; float ss = 0.f;
        const int nrow = (row + nb * 8 < T) ? row + nb * 8 : row; const int ns1 = slot_of[nrow * 2], ns2 = slot_of[nrow * 2 + 1];
#pragma unroll
        for (int k = 0; k < 2; ++k) { u32x4 xw, y1, y2;
            xw.x = pin_u32(px[k].x); xw.y = pin_u32(px[k].y); xw.z = pin_u32(px[k].z); xw.w = pin_u32(px[k].w); y1.x = pin_u32(py1[k].x); y1.y = pin_u32(py1[k].y); y1.z = pin_u32(py1[k].z); y1.w = pin_u32(py1[k].w);
            y2.x = pin_u32(py2[k].x); y2.y = pin_u32(py2[k].y); y2.z = pin_u32(py2[k].z); y2.w = pin_u32(py2[k].w);
            const float ms = msc;
            xv[2 * k] = (f32x4){bf_lo(xw.x) + ms * (bf_lo(y1.x) + bf_lo(y2.x)), bf_hi(xw.x) + ms * (bf_hi(y1.x) + bf_hi(y2.x)), bf_lo(xw.y) + ms * (bf_lo(y1.y) + bf_lo(y2.y)), bf_hi(xw.y) + ms * (bf_hi(y1.y) + bf_hi(y2.y))};
            xv[2 * k + 1] = (f32x4){bf_lo(xw.z) + ms * (bf_lo(y1.z) + bf_lo(y2.z)), bf_hi(xw.z) + ms * (bf_hi(y1.z) + bf_hi(y2.z)), bf_lo(xw.w) + ms * (bf_lo(y1.w) + bf_lo(y2.w)), bf_hi(xw.w) + ms * (bf_hi(y1.w) + bf_hi(y2.w))};
            ss += ((xv[2 * k][0] * xv[2 * k][0] + xv[2 * k][1] * xv[2 * k][1]) + (xv[2 * k][2] * xv[2 * k][2] + xv[2 * k][3] * xv[2 * k][3])) + ((xv[2 * k + 1][0] * xv[2 * k + 1][0] + xv[2 * k + 1][1] * xv[2 * k + 1][1]) + (xv[2 * k + 1][2] * xv[2 * k + 1][2] + xv[2 * k + 1][3] * xv[2 * k + 1][3])); }
        if (nrow != row) {
#pragma unroll
            for (int k = 0; k < 2; ++k) { px[k] = *(const u32x4*)(xb + (size_t)nrow * D + k * 512 + lane * 8); py1[k] = *(const u32x4*)(ys + (size_t)ns1 * D + k * 512 + lane * 8); py2[k] = *(const u32x4*)(ys + (size_t)ns2 * D + k * 512 + lane * 8); } }
        ss = wave_sum(ss);
        if (fin) { const float rstd = __builtin_amdgcn_rsqf(ss * (1.0f / D) + NORM_EPS);
#pragma unroll
            for (int k = 0; k < 2; ++k) { const f32x4 ga = *(const f32x4*)(nf + k * 512 + lane * 8), gb = *(const f32x4*)(nf + k * 512 + lane * 8 + 4);
                *(f32x4*)(x + (size_t)row * D + k * 512 + lane * 8) = xv[2 * k] * rstd * ga; *(f32x4*)(x + (size_t)row * D + k * 512 + lane * 8 + 4) = xv[2 * k + 1] * rstd * gb; } }
        else {
#pragma unroll
            for (int k = 0; k < 2; ++k) *(u32x4*)(xb + (size_t)row * D + k * 512 + lane * 8) = pack8v4(xv[2 * k], xv[2 * k + 1]);
            if (lane < 16) ssq[(size_t)row * 16 + lane] = lane == 0 ? ss : 0.f; }
    }
}

#define GRID_BAR() do { XcdBarrier b_; b_.bar = (unsigned*)a->ws + CW_BAR; b_.x = xb_xcc_id(); b_.st = (volatile LAS unsigned*)(lds + LDS_MISC) + 8; xcd_barrier(b_); } while (0)
#define IN(k) true
#define SEAM(k) do { if (IN(k) && IN((k) + 1)) GRID_BAR(); } while (0)
template <int l> __device__ __forceinline__ void layer_body(KArgs a, LAS unsigned char* lds, const int lo, const int hi) {
    const int bid = blockIdx.x, nb = gridDim.x; unsigned char* ws = a->ws;

        const int pb = 1 + 13 * l;
        if constexpr (l == 0) {
            if (IN(pb + 0)) {
                { pg8::Gemm g{(const bf16_t*)ws, (const bf16_t*)(ws + WS_WCAT), D, D, D};
                  SchedRKV Sd; Sd.init(T / 256, 12, nb, bid); Sd.aoff0 = (long long)R6; Sd.aoff1 = (long long)((const unsigned char*)a->out - ws);
                  EpiCat E{(bf16_t*)(ws + R1), (bf16_t*)(ws + R5), (long long)(R2 - R1) / 2, 0};
                  pg8::gemm_phase(lds, g, Sd, E); }
                { pg8::Gemm g{(const bf16_t*)(ws + R0), (const bf16_t*)(ws + WS_WCAT) + (size_t)3072 * 2 * D, D, 2 * D, 2 * D};
                  SchedHP Sd; Sd.init(T / 256, 2, nb, bid);
                  EpiCat E{(bf16_t*)(ws + R1), (bf16_t*)(ws + R5), (long long)(R2 - R1) / 2, 12};
                  pg8::gemm_phase(lds, g, Sd, E); }
            }
            SEAM(pb + 0);
            if (IN(pb + 1)) {
                { pg8::Gemm g{(const bf16_t*)(ws + R5), (const bf16_t*)(ws + WS_WWA2), 512, 256, 256};
                  SchedPlain Sd; Sd.init(T / 256, 8, nb, bid); Sd.astr = (long long)256 * 512 * 2; Sd.bstr = (long long)256 * 256 * 2;
                  const float* b0 = a->in[I_W0]; const float* b1 = a->in[I_A0]; bf16_t* o0 = (bf16_t*)(ws + R4); bf16_t* o1 = (bf16_t*)a->out;
                  EpiAct E{o0, (long long)(o1 - o0), b0, (long long)(b1 - b0), -0.60653066f, 1.60653066f};
                  pg8::gemm_phase(lds, g, Sd, E); }
            }
            SEAM(pb + 1);
            if (IN(pb + 2)) {
                rw::stage_a(a, lds, bid, nb);
                GRID_BAR();
                if (bid < 128) rw::stage_b(a, lds, bid);
                else {
                    pg8::Gemm g{(const bf16_t*)(ws + WS_MN), (const bf16_t*)(ws + WS_WMKV), D, D, D};
                    SchedMemKV Sd; Sd.init(16, 8, nb - 128, bid - 128);
                    EpiMemKV E{(bf16_t*)(ws + WS_KMEM), (bf16_t*)(ws + WS_VT)};
                    pg8::gemm_phase(lds, g, Sd, E); }
                {
                    constexpr int NU = (T / 256) * 4, NSCAN = NU * 2 / 8;
                    pg8::Gemm g{(const bf16_t*)(ws + R5) + 256, (const bf16_t*)(ws + WS_WG2), 512, 256, 256};
                    SchedRange Sd; Sd.init(T / 256, 4, bid < 128 ? 128 : nb - 128, bid < 128 ? bid : bid - 128); Sd.astr = (long long)256 * 512 * 2; Sd.bstr = (long long)256 * 256 * 2;
                    Sd.base = bid < 128 ? 0 : NSCAN; Sd.count = bid < 128 ? NSCAN : NU - NSCAN;
                    EpiAct E{(bf16_t*)a->out + (size_t)T * D, 0, nullptr, 0, 1.f, 0.f};
                    pg8::gemm_phase(lds, g, Sd, E); }
                GRID_BAR();
                rw::stage_c(a, lds, bid, nb);
            }
            SEAM(pb + 2);
        } else {
            if (IN(pb + 0)) {
                pg8::Gemm g{(const bf16_t*)(ws + R1), (const bf16_t*)(ws + WS_WKVQ), D, D, D};
                SchedPlain Sd; Sd.init(T / 256, 12, nb, bid); Sd.astr = (long long)256 * D * 2; Sd.bstr = (long long)256 * D * 2;
                EpiRstd E{(bf16_t*)(ws + R2), (long long)(R3 - R2) / 2, (const float*)(ws + WS_SSQ)};
                pg8::gemm_phase(lds, g, Sd, E);
            }
            SEAM(pb + 0);
            if (IN(pb + 1)) { sbattn_phase(a, lds, bid, nb);
            }
            if (IN(pb + 1) && IN(pb + 3)) GRID_BAR();
        }
        if (IN(pb + 3)) {
            pg8::Gemm g{(const bf16_t*)(ws + (l ? R0 : R6)), (const bf16_t*)(ws + (l ? WS_WOSB : WS_WO0)), D, D, D};
            SchedPlain Sd; Sd.init(T / 256, 4, nb, bid); Sd.astr = (long long)256 * D * 2; Sd.bstr = (long long)256 * D * 2;
            EpiResid E{l ? (const float*)nullptr : a->in[I_X], (bf16_t*)(ws + R1), (float*)(ws + WS_SSQ), 1.f};
            pg8::gemm_phase(lds, g, Sd, E);
            if constexpr (l == 0) {
                { pg8::Gemm g2{(const bf16_t*)(ws + WS_KMEM), (const bf16_t*)(ws + WS_WMQ), D, D, 256};
                  SchedMemPre S2; S2.init(64, 4, nb, bid); S2.mode = 0; EpiMemPre E2{(bf16_t*)a->out};
                  pg8::gemm_phase(lds, g2, S2, E2); }
                { pg8::Gemm g2{(const bf16_t*)(ws + WS_WMO), (const bf16_t*)(ws + WS_VT), D, D, 256};
                  SchedMemPre S2; S2.init(64, 4, nb, bid); S2.mode = 1; EpiMemPre E2{(bf16_t*)a->out + (size_t)16 * D * D};
                  pg8::gemm_phase(lds, g2, S2, E2); } }
        }
        SEAM(pb + 3);
        if (IN(pb + 4)) {
            pg8::Gemm g{(const bf16_t*)(ws + R1), (const bf16_t*)a->out + (size_t)l * 8 * D * D, D, D, D};
            SchedBatchB Sd; Sd.init(T / 256, 4, nb, bid);
            EpiSoftmax E{(bf16_t*)(ws + R2), (const float*)(ws + WS_SSQ)};
            pg8::gemm_phase(lds, g, Sd, E);
        }
        SEAM(pb + 4);
        if (IN(pb + 7)) {
            pg8::Gemm g{(const bf16_t*)(ws + R2), (const bf16_t*)a->out + (size_t)(16 + l * 8) * D * D, D, D, D};
            SchedBatchB Sd; Sd.init(T / 256, 4, nb, bid);
            EpiResid E{(const float*)nullptr, (bf16_t*)(ws + R1), (float*)(ws + WS_SSQ), 1.f};
            pg8::gemm_phase(lds, g, Sd, E);
        }
        SEAM(pb + 7);
        if (IN(pb + 8)) {
            LAS int* lc = (LAS int*)(lds + LDS_EPI + 4096);
            if (threadIdx.x < 32) lc[threadIdx.x] = 0;
            __syncthreads();
            { pg8::Gemm g{(const bf16_t*)(ws + R1), (const bf16_t*)(ws + WS_RS) + (size_t)l * 256 * D, D, D, D};
              SchedPlain Sd; Sd.init(T / 256, 1, nb, bid); Sd.astr = (long long)256 * D * 2; Sd.bstr = 0;
              EpiRouter E{(const float*)(ws + WS_SSQ), a->in[I_BRG] + l * 4, a->in[I_BRE] + l * 32, (u32x4*)(ws + WS_TOK)};
              pg8::gemm_phase(lds, g, Sd, E); }
            __syncthreads();
            if (threadIdx.x < 32) atomicAdd((unsigned*)ws + CW_CNT + 64 * l + threadIdx.x, (unsigned)lc[threadIdx.x]);
        }
        SEAM(pb + 8);
        if (IN(pb + 9)) { assign_phase(a, l, lds, bid, nb);
        }
        SEAM(pb + 9);
        if (IN(pb + 10)) {
            const int ntl = (int)__hip_atomic_load((unsigned*)ws + CW_NT + 64 * l, __ATOMIC_RELAXED, __HIP_MEMORY_SCOPE_AGENT);
            pg8::Gemm g{(const bf16_t*)(ws + R1), (const bf16_t*)(ws + WS_WGU) + (size_t)l * 32 * 512 * D, D, D, D};
            SchedMoE Sd; Sd.init(ntl, 2, nb, bid); Sd.tile_expert = (const int*)(ws + WS_TILEEXP); Sd.mode = 0;
            EpiSwiGLU E{(bf16_t*)(ws + R0), (const float*)(ws + WS_SLOTINFO)};
            pg8::gemm_phase_gather(lds, g, Sd, E, (const int*)(ws + WS_SLOTTOK));
        }
        SEAM(pb + 10);
        if (IN(pb + 11)) {
            const int ntl = (int)__hip_atomic_load((unsigned*)ws + CW_NT + 64 * l, __ATOMIC_RELAXED, __HIP_MEMORY_SCOPE_AGENT);
            pg8::Gemm g{(const bf16_t*)(ws + R0), (const bf16_t*)(ws + WS_WDN) + (size_t)l * 32 * D * 256, 256, 256, 256};
            SchedMoE Sd; Sd.init(ntl, 4, nb, bid); Sd.tile_expert = (const int*)(ws + WS_TILEEXP); Sd.mode = 1;
            EpiGate E{(bf16_t*)(ws + R2), (const float*)(ws + WS_SLOTINFO)};
            pg8::gemm_phase(lds, g, Sd, E);
        }
        SEAM(pb + 11);
        combine_phase(a, l == 1, bid, nb);
        if (l == 0) SEAM(pb + 12);
    }
constexpr int NPHASE = 27;
__global__ void __launch_bounds__(512, 2) fwd_kernel(Args a_unused) {
    extern __shared__ __attribute__((aligned(16))) unsigned char lds_raw[];
    LAS unsigned char* lds = (LAS unsigned char*)lds_raw;
    const int tid = threadIdx.x, bid = blockIdx.x, nb = gridDim.x;
    KArgs a = kargs();
    unsigned char* ws = a->ws;
    volatile LAS unsigned* MISC = (volatile LAS unsigned*)(lds + LDS_MISC);
    if (tid < 64) MISC[tid] = 0u;
    __syncthreads();
    (void)xcd_barrier_post((unsigned*)ws + CW_BAR, MISC + 8);
    const int lo = a->ph_lo, hi = a->ph_hi;
    prologue_phase(a, lds, bid, nb);
    SEAM(0);
    layer_body<0>(a, lds, lo, hi);
    layer_body<1>(a, lds, lo, hi);
#undef IN
#undef SEAM
}

extern "C" void kernel_launch(void* const* d_in, const int* in_sizes, int n_in, void* d_out, int out_size, void* d_ws, size_t ws_size, hipStream_t stream) {
    static int grid = 0;
    if (grid == 0) {
        if (n_in != 37 || in_sizes[0] != T * D || out_size != T * D || ws_size < WS_END) { fprintf(stderr, "kernel_launch: unexpected shapes (n_in %d, ws %zu < %zu)\n", n_in, ws_size, (size_t)WS_END); grid = -1; return; }
        int dev = 0, cus = 0, per_cu = 0;
        if (hipGetDevice(&dev) != hipSuccess || hipDeviceGetAttribute(&cus, hipDeviceAttributeMultiprocessorCount, dev) != hipSuccess) { grid = -1; return; }
        if (hipFuncSetAttribute((const void*)fwd_kernel, hipFuncAttributeMaxDynamicSharedMemorySize, LDS_BYTES) != hipSuccess) { fprintf(stderr, "kernel_launch: hipFuncSetAttribute failed\n"); grid = -1; return; }
        if (hipOccupancyMaxActiveBlocksPerMultiprocessor(&per_cu, (const void*)fwd_kernel, 512, LDS_BYTES) != hipSuccess || per_cu < 1) fprintf(stderr, "kernel_launch: occupancy query reports %d\n", per_cu);
        (void)hipGetLastError();
        grid = cus;
    }
    if (grid < 0) return;
    hipMemsetAsync((char*)d_ws + WS_CTL, 0, CTL_BYTES, stream);
    hipMemsetAsync((char*)d_ws + WS_WCAT + (size_t)3072 * 2048 * 2, 0, (size_t)512 * 2048 * 2, stream);
    hipMemsetAsync((char*)d_ws + WS_WWA2, 0, (size_t)3072 * 256 * 2, stream);
    hipMemsetAsync((char*)d_ws + WS_SLOTTOK, 0, (size_t)NSLOT_MAX * 4, stream);
    Args ha{};
    for (int i = 0; i < 37; ++i) ha.in[i] = (const float*)d_in[i];
    ha.out = (float*)d_out; ha.ws = (unsigned char*)d_ws;
    ha.ph_lo = 0; ha.ph_hi = NPHASE;
    hipLaunchKernelGGL(fwd_kernel, dim3(grid), dim3(512), LDS_BYTES, stream, ha);
}
```

```cpp
#include <hip/hip_runtime.h>
#include <cstdio>
#include <cstdint>

#define LAS __attribute__((address_space(3)))
typedef unsigned short bf16_t;
typedef short bf16x8 __attribute__((ext_vector_type(8)));
typedef float f32x4 __attribute__((ext_vector_type(4)));
typedef float f32x2 __attribute__((ext_vector_type(2)));
typedef short s16x4 __attribute__((ext_vector_type(4)));
typedef unsigned u32x4 __attribute__((ext_vector_type(4)));
typedef unsigned u32x2 __attribute__((ext_vector_type(2)));

constexpr int NB = 8, S = 8192, D = 1024, T = NB * S;
constexpr int HP_ROWS = NB * (S + 1);
constexpr int NSLOT_MAX = 2 * T + 32 * 256;
constexpr int NTILE_MAX = NSLOT_MAX / 256;
constexpr float NORM_EPS = 1e-6f;

constexpr size_t MiB = 1u << 20;
constexpr size_t WS_CTL = 0, CTL_BYTES = 1 * MiB;
constexpr size_t WS_WCAT = 1 * MiB;
constexpr size_t WS_WWA2 = WS_WCAT + (size_t)3584 * 2048 * 2;
constexpr size_t WS_WG2 = WS_WWA2 + (size_t)2048 * 256 * 2;
constexpr size_t WS_WO0 = WS_WG2 + (size_t)1024 * 256 * 2;
constexpr size_t WS_WKVQ = WS_WO0 + (size_t)1024 * 1024 * 2;
constexpr size_t WS_WOSB = WS_WKVQ + (size_t)3072 * 1024 * 2;
constexpr size_t WS_WMQ = WS_WOSB + (size_t)1024 * 1024 * 2;
constexpr size_t WS_WMKV = WS_WMQ + (size_t)2 * 1024 * 1024 * 2;
constexpr size_t WS_WMO = WS_WMKV + (size_t)2 * 2048 * 1024 * 2;
constexpr size_t WS_WGU = WS_WMO + (size_t)2 * 1024 * 1024 * 2;
constexpr size_t WS_WDN = WS_WGU + (size_t)2 * 32 * 512 * 1024 * 2;
constexpr size_t WS_WR = WS_WDN + (size_t)2 * 32 * 1024 * 256 * 2;
constexpr size_t WS_WEND = WS_WR + (size_t)2 * 36 * 1024 * 4;
constexpr size_t WS_MN = (WS_WEND + 4095) / 4096 * 4096;
constexpr size_t WS_KMEM = WS_MN + (size_t)2048 * 1024 * 2;
constexpr size_t WS_VT = WS_KMEM + (size_t)2 * 2048 * 1024 * 2;
constexpr size_t WS_SSQ = WS_VT + (size_t)2 * 2048 * 1024 * 2;
constexpr size_t WS_RS = WS_SSQ + (size_t)T * 16 * 4;
constexpr size_t WS_TOK = WS_RS + (size_t)T * 16 * 4;
constexpr size_t WS_SLOTOF = WS_TOK + (size_t)T * 16;
constexpr size_t WS_SLOTINFO = WS_SLOTOF + (size_t)T * 8;
constexpr size_t WS_TILEEXP = WS_SLOTINFO + (size_t)NSLOT_MAX * 8;
constexpr size_t WS_SLOTTOK = WS_TILEEXP + 4096;
constexpr size_t WS_ARENA = (WS_SLOTTOK + (size_t)NSLOT_MAX * 4 + MiB - 1) / MiB * MiB;
constexpr size_t R0 = WS_ARENA;
constexpr size_t R1 = R0 + 129 * MiB;
constexpr size_t R2 = R1 + 128 * MiB;
constexpr size_t R3 = R2 + 128 * MiB;
constexpr size_t R4 = R3 + 128 * MiB;
constexpr size_t R5 = R4 + 128 * MiB;
constexpr size_t R6 = R5 + 64 * MiB;
constexpr size_t WS_END = R6 + 128 * MiB;
static_assert((size_t)HP_ROWS * D * 2 <= 129 * MiB, "hp");
static_assert((size_t)NSLOT_MAX * D * 2 <= 3 * 128 * MiB, "xs/ys");
static_assert(WS_END <= (size_t)1024 * MiB, "workspace over 1 GiB");

constexpr int CW_BAR = 4096;
constexpr int CW_CNT = 16384;
constexpr int CW_FILL = 16384 + 256;
constexpr int CW_NT = 16384 + 512;

constexpr int LDS_BYTES = 161792;
constexpr int LDS_EPI = 131072;
constexpr int LDS_MISC = LDS_BYTES - 256;

__device__ __forceinline__ unsigned f2bf(float f) { unsigned u = __builtin_bit_cast(unsigned, f); return (u + 0x7fffu + ((u >> 16) & 1u)) >> 16; }
typedef __bf16 bf16v2_t __attribute__((ext_vector_type(2)));
__device__ __forceinline__ unsigned cvt_pk_c(float lo, float hi) { const f32x2 v = {lo, hi}; const bf16v2_t b = __builtin_convertvector(v, bf16v2_t); return __builtin_bit_cast(unsigned, b); }
__device__ __forceinline__ unsigned cvt_pk_bf16(float lo, float hi) { return cvt_pk_c(lo, hi); }
typedef float f32x16 __attribute__((ext_vector_type(16)));
__device__ __forceinline__ bf16x8 pack8c(float a0, float a1, float a2, float a3, float a4, float a5, float a6, float a7) {
    u32x4 w; w.x = cvt_pk_c(a0, a1); w.y = cvt_pk_c(a2, a3); w.z = cvt_pk_c(a4, a5); w.w = cvt_pk_c(a6, a7); return __builtin_bit_cast(bf16x8, w); }
__device__ __forceinline__ bf16x8 pack8v(float a0, float a1, float a2, float a3, float a4, float a5, float a6, float a7) {
    u32x4 w; w.x = cvt_pk_bf16(a0, a1); w.y = cvt_pk_bf16(a2, a3); w.z = cvt_pk_bf16(a4, a5); w.w = cvt_pk_bf16(a6, a7); return __builtin_bit_cast(bf16x8, w); }
__device__ __forceinline__ float bf_lo(unsigned w) { return __builtin_bit_cast(float, w << 16); }
__device__ __forceinline__ float bf_hi(unsigned w) { return __builtin_bit_cast(float, w & 0xffff0000u); }
__device__ __forceinline__ float wave_sum_shfl(float v) {
#pragma unroll
    for (int o = 1; o < 64; o <<= 1) v += __shfl_xor(v, o);
    return v;
}
__device__ __forceinline__ float dpp_f(float v, const int ctrl_sel) {
    int x = __builtin_bit_cast(int, v), r;
    if (ctrl_sel == 0) r = __builtin_amdgcn_update_dpp(0, x, 0xB1, 0xF, 0xF, true);
    else if (ctrl_sel == 1) r = __builtin_amdgcn_update_dpp(0, x, 0x4E, 0xF, 0xF, true);
    else if (ctrl_sel == 2) r = __builtin_amdgcn_update_dpp(0, x, 0x141, 0xF, 0xF, true);
    else r = __builtin_amdgcn_update_dpp(0, x, 0x140, 0xF, 0xF, true);
    return __builtin_bit_cast(float, r);
}
__device__ __forceinline__ float sum8(float v) { v += dpp_f(v, 0); v += dpp_f(v, 1); v += dpp_f(v, 2); return v; }
__device__ __forceinline__ float sum16(float v) { v = sum8(v); v += dpp_f(v, 3); return v; }
__device__ __forceinline__ float wave_sum(float v) { v = sum16(v);
    v += __builtin_bit_cast(float, __builtin_amdgcn_update_dpp(0, __builtin_bit_cast(int, v), 0x142, 0xF, 0xF, true));
    v += __builtin_bit_cast(float, __builtin_amdgcn_update_dpp(0, __builtin_bit_cast(int, v), 0x143, 0xF, 0xF, true));
    return __builtin_bit_cast(float, __builtin_amdgcn_readlane(__builtin_bit_cast(int, v), 63)); }
__device__ __forceinline__ float fast_sigmoid(float x) { return __builtin_amdgcn_rcpf(1.0f + __builtin_amdgcn_exp2f(-1.44269504f * x)); }
__device__ __forceinline__ float fast_tanh(float x) { return 1.0f - 2.0f * __builtin_amdgcn_rcpf(1.0f + __builtin_amdgcn_exp2f(2.88539008f * x)); }

__device__ __forceinline__ unsigned pin_u32(unsigned x) { asm volatile("" : "+v"(x)); return x; }
__device__ __forceinline__ int opaque_tid() { int t = threadIdx.x; asm volatile("" : "+v"(t)); return t; }
template <class P> __device__ __forceinline__ P* opaque_ptr(P* p) { asm volatile("" : "+s"(p)); return p; }
__device__ __forceinline__ void lds_barrier() { asm volatile("s_waitcnt lgkmcnt(0)" ::: "memory"); __builtin_amdgcn_s_barrier(); asm volatile("" ::: "memory"); }
#define XB_TMO      128
#define XB_XCNT(j)  (256  + 64 * (j))
#define XB_XSUB(j)  (1280 + 64 * (j))
#define XB_XGEN(j)  (2304 + 64 * (j))
#define XB_TOP      3328
#define XB_TOPGEN   3392
#define XCD_BAR_WORDS 3456
#define XB_SPIN_CAP (1u << 22)
__device__ __forceinline__ unsigned xb_ld(unsigned* p)              { return __hip_atomic_load(p, __ATOMIC_RELAXED, __HIP_MEMORY_SCOPE_AGENT); }
__device__ __forceinline__ unsigned xb_add(unsigned* p, unsigned v) { return __hip_atomic_fetch_add(p, v, __ATOMIC_RELAXED, __HIP_MEMORY_SCOPE_AGENT); }
__device__ __forceinline__ unsigned xb_xcc_id() { return (unsigned)__builtin_amdgcn_s_getreg((3 << 11) | 20) & 0xFu; }
#define XB_SPIN(cond, bar) do { unsigned _sp = 0; while (cond) { __builtin_amdgcn_s_sleep(1); \
    if ((++_sp & 255u) == 0u) { if (xb_ld(&(bar)[XB_TMO])) break; if (_sp > XB_SPIN_CAP) { atomicAdd(&(bar)[XB_TMO], 1u); break; } } } } while (0)
struct XcdBarrier { unsigned* bar; unsigned x; volatile LAS unsigned* st; };
__device__ __forceinline__ XcdBarrier xcd_barrier_post(unsigned* bar, volatile LAS unsigned* st) {
    XcdBarrier b; b.bar = bar; b.x = xb_xcc_id(); b.st = st;
    if (threadIdx.x == 0) (void)xb_add(&bar[XB_XCNT(b.x)], 1u);
    return b;
}
__device__ __forceinline__ void xcd_barrier_complete(unsigned* bar, unsigned x, unsigned& nloc, unsigned& nx) {
    const unsigned G = gridDim.x * gridDim.y * gridDim.z;
    unsigned sum, cnt, mine, sp = 0u;
    for (;;) {
        sum = 0u; cnt = 0u; mine = 0u;
#pragma unroll
        for (unsigned j = 0; j < 16; ++j) { const unsigned c = xb_ld(&bar[XB_XCNT(j)]); sum += c; cnt += (c > 0u) ? 1u : 0u; mine = (j == x) ? c : mine; }
        if (sum == G) break;
        __builtin_amdgcn_s_sleep(1);
        if ((++sp & 255u) == 0u) { if (xb_ld(&bar[XB_TMO])) break; if (sp > XB_SPIN_CAP) { atomicAdd(&bar[XB_TMO], 1u); break; } }
    }
    nloc = mine > 0u ? mine : 1u; nx = cnt > 0u ? cnt : 1u;
}
__device__ __forceinline__ void xcd_barrier(const XcdBarrier& b) {
    asm volatile("s_waitcnt vmcnt(0)" ::: "memory");
    __syncthreads();
    if (threadIdx.x == 0) {
        unsigned* bar = b.bar;
        __builtin_amdgcn_s_waitcnt(0);
        unsigned nloc = b.st[0], nx = b.st[1];
        if (nloc == 0u) { xcd_barrier_complete(bar, b.x, nloc, nx); b.st[0] = nloc; b.st[1] = nx; }
        const unsigned old = xb_add(&bar[XB_XSUB(b.x)], 1u);
        const unsigned gen = old / nloc;
        if (old + 1u == (gen + 1u) * nloc) {
            __builtin_amdgcn_fence(__ATOMIC_RELEASE, "agent");
            asm volatile("s_waitcnt vmcnt(0)" ::: "memory");
            const unsigned og = xb_add(&bar[XB_TOP], 1u);
            const unsigned tg = og / nx;
            if (og + 1u == (tg + 1u) * nx) xb_add(&bar[XB_TOPGEN], 1u);
            else XB_SPIN(xb_ld(&bar[XB_TOPGEN]) == tg, bar);
            __builtin_amdgcn_fence(__ATOMIC_ACQUIRE, "agent");
            xb_add(&bar[XB_XGEN(b.x)], 1u);
            asm volatile("s_waitcnt vmcnt(0)" ::: "memory");
        } else {
            XB_SPIN(xb_ld(&bar[XB_XGEN(b.x)]) == gen, bar);
            __builtin_amdgcn_fence(__ATOMIC_ACQUIRE, "agent");
            asm volatile("s_waitcnt vmcnt(0)" ::: "memory");
        }
    }
    __syncthreads();
}

namespace pg8 {
constexpr int BM = 256, BK = 64, HALF = 128, HTB = HALF * BK * 2, STAGE_BYTES = 8 * HTB, NXCD = 8, WGM = 8;
__host__ __device__ __forceinline__ int lds_byte(int r, int c) { const int st = (r >> 4) * 2 + (c >> 5), rr = r & 15, cc = c & 31, ob = rr * 64 + cc * 2; return st * 1024 + (ob ^ (((ob >> 9) & 1) << 5)); }
__host__ __device__ __forceinline__ void stage_rc(int b, int& R, int& C) { const int st = b / 1024, sb = b % 1024, swz = sb ^ (((sb >> 9) & 1) << 5); R = (st >> 1) * 16 + swz / 64; C = (st & 1) * 32 + (swz % 64) / 2; }
__host__ __device__ __forceinline__ int perm32(int rho) { const int n = rho >> 4, i = rho & 15; return 8 * (i >> 2) + 4 * n + (i & 3); }

struct Unit { int pm, pn; };
struct Gemm { const bf16_t* A; const bf16_t* Bt; int lda, ldb, K; };

struct OrderCore {
    int nM, nN, nwg, G, c;
    __device__ __forceinline__ void init(int nM_, int nN_, int G_, int c_) { nM = nM_; nN = nN_; nwg = nM * nN; G = G_; c = c_; }
    __device__ __forceinline__ bool map(int i, int& pm, int& pn) const { const long L = (long)i * G + c; if (c < 0 || L >= nwg) return false; return map_lin(L, pm, pn); }
    __device__ __forceinline__ bool map_lin(long L, int& pm, int& pn) const {
        int wgid = (int)L; { const int q = nwg / NXCD, r = nwg % NXCD, xcd = wgid % NXCD, off = wgid / NXCD; wgid = (xcd < r ? xcd * (q + 1) : r * (q + 1) + (xcd - r) * q) + off; }
        const int nig = WGM * nN, gid = wgid / nig, fm = gid * WGM, gsz = (nM - fm) < WGM ? (nM - fm) : WGM;
        pm = fm + ((wgid % nig) % gsz); pn = (wgid % nig) / gsz; return true;
    }
    __device__ __forceinline__ void a_ready(const Unit&) const {}
    __device__ __forceinline__ void done(const Unit&) const {}
};

template <class Epi, class Sched, bool ALIGN_EPI = true, bool SP2 = true>
__device__ __forceinline__ void gemm_phase(LAS unsigned char* lds, const Gemm g, const Sched& S, const Epi& E) {
    const int tid = opaque_tid(), wid = __builtin_amdgcn_readfirstlane(tid >> 6), lane = tid & 63, wr = wid >> 2, wc = wid & 3, fr = lane & 15, fq = lane >> 4;
    const int K = g.K, nt = K / BK;
    unsigned voffA[2], voffB[2];
#pragma unroll
    for (int i = 0; i < 2; ++i) { int R, C; stage_rc(tid * 16 + i * 8192, R, C); const int Rb = Epi::PERM ? ((R & ~31) + perm32(R & 31)) : R;
        voffA[i] = (unsigned)(R * g.lda + C) * 2u; voffB[i] = (unsigned)(Rb * g.ldb + C) * 2u; }
    const size_t kstep = (size_t)(BK * 2);
    const size_t hstepA = (size_t)HALF * g.lda * 2, hstepB = (size_t)HALF * g.ldb * 2;
    const unsigned ldsw = (unsigned)wid * 1024u;
    const int aoff = lds_byte(wr * 64 + fr, fq * 8), boff = lds_byte(wc * 32 + fr, fq * 8);
#define PG8_SA(b, h) (((b) * 2 + (h)) * HTB)
#define PG8_SB(b, h) ((4 + (b) * 2 + (h)) * HTB)
#define PG8_STAGE(bufoff, gbase, voff) do { _Pragma("unroll") for (int _i = 0; _i < 2; ++_i) \
        __builtin_amdgcn_global_load_lds((const unsigned*)((const char*)(gbase) + (voff)[_i]), (LAS unsigned*)(lds + (bufoff) + ldsw + _i * 8192), 16, 0, 0); } while (0)
#define PG8_LDA(dst, b, h) do { _Pragma("unroll") for (int m = 0; m < 4; ++m) _Pragma("unroll") for (int k = 0; k < 2; ++k) dst[m][k] = *(const LAS bf16x8*)(lds + PG8_SA(b, h) + aoff + m * 2048 + k * 1024); } while (0)
#define PG8_LDB(dst, b, h) do { _Pragma("unroll") for (int n = 0; n < 2; ++n) _Pragma("unroll") for (int k = 0; k < 2; ++k) dst[n][k] = *(const LAS bf16x8*)(lds + PG8_SB(b, h) + boff + n * 2048 + k * 1024); } while (0)
#define PG8_MMA(ai, bj, At, Bt) do { __builtin_amdgcn_s_setprio(1); _Pragma("unroll") for (int m = 0; m < 4; ++m) _Pragma("unroll") for (int n = 0; n < 2; ++n) _Pragma("unroll") for (int k = 0; k < 2; ++k) \
        acc[ai][bj][m][n] = __builtin_amdgcn_mfma_f32_16x16x32_bf16(Bt[n][k], At[m][k], acc[ai][bj][m][n], 0, 0, 0); __builtin_amdgcn_s_setprio(0); } while (0)
#define PG8_WAIT_V(n) asm volatile("s_waitcnt vmcnt(" #n ")" ::: "memory")
#define PG8_WAIT_L(n) asm volatile("s_waitcnt lgkmcnt(" #n ")" ::: "memory")
#define PG8_BAR __builtin_amdgcn_s_barrier()
#define PG8_SCHED __builtin_amdgcn_sched_barrier(0)
    __builtin_amdgcn_sched_barrier(0);
    Unit cur, nxt; int ui = 0;
    if (!S.next(0, cur)) return;
    f32x4 acc[2][2][4][2];
#pragma unroll
    for (int a = 0; a < 2; ++a)
#pragma unroll
        for (int b = 0; b < 2; ++b)
#pragma unroll
            for (int m = 0; m < 4; ++m)
#pragma unroll
                for (int n = 0; n < 2; ++n) acc[a][b][m][n] = (f32x4){0.f, 0.f, 0.f, 0.f};
    bf16x8 At[4][2], B0[2][2], B1[2][2];
    const char* cA; const char* cB; { long long ao, bo; S.offs(cur, ao, bo); cA = (const char*)g.A + ao; cB = (const char*)g.Bt + bo; }
    S.a_ready(cur);
    if constexpr (SP2) {
        PG8_STAGE(PG8_SB(0, 0), cB, voffB); PG8_STAGE(PG8_SB(0, 1), cB + hstepB, voffB); PG8_STAGE(PG8_SA(0, 0), cA, voffA); PG8_STAGE(PG8_SA(0, 1), cA + hstepA, voffA);
        if (wr == 1) PG8_BAR;
        PG8_WAIT_V(2); PG8_BAR;
        PG8_STAGE(PG8_SB(1, 0), cB + kstep, voffB); PG8_STAGE(PG8_SA(1, 0), cA + kstep, voffA); PG8_STAGE(PG8_SB(1, 1), cB + hstepB + kstep, voffB);
        PG8_WAIT_V(6); PG8_BAR;
    } else {
        PG8_STAGE(PG8_SB(0, 0), cB, voffB); PG8_STAGE(PG8_SA(0, 0), cA, voffA); PG8_STAGE(PG8_SB(0, 1), cB + hstepB, voffB); PG8_STAGE(PG8_SA(0, 1), cA + hstepA, voffA);
        if (wr == 1) PG8_BAR;
        PG8_WAIT_V(4); PG8_BAR;
        PG8_STAGE(PG8_SB(1, 0), cB + kstep, voffB); PG8_STAGE(PG8_SA(1, 0), cA + kstep, voffA); PG8_STAGE(PG8_SB(1, 1), cB + hstepB + kstep, voffB);
        PG8_WAIT_V(6); PG8_BAR;
    }
    for (;;) {
        const bool has_next = S.next(ui + 1, nxt);
        const char* nA = cA; const char* nB = cB; if (has_next) { long long ao, bo; S.offs(nxt, ao, bo); nA = (const char*)g.A + ao; nB = (const char*)g.Bt + bo; }
#pragma nounroll
        for (int t = 0; t < nt; t += 2) {
            const bool last = (t == nt - 2);
            const char* a1 = cA + (size_t)(t + 1) * kstep;
            const char* a2 = last ? nA : cA + (size_t)(t + 2) * kstep; const char* b2 = last ? nB : cB + (size_t)(t + 2) * kstep;
            const char* a3 = a2 + kstep; const char* b3 = b2 + kstep;
            if (last && has_next) S.a_ready(nxt);
            if constexpr (SP2) {
            PG8_LDB(B0, 0, 0); PG8_LDB(B1, 0, 1); PG8_SCHED; PG8_LDA(At, 0, 0); PG8_STAGE(PG8_SA(1, 1), a1 + hstepA, voffA);
            PG8_WAIT_V(8); PG8_WAIT_L(0); PG8_BAR; PG8_MMA(0, 0, At, B0); PG8_MMA(0, 1, At, B1); PG8_BAR; PG8_SCHED;
            PG8_LDA(At, 0, 1); PG8_STAGE(PG8_SB(0, 0), b2, voffB); PG8_STAGE(PG8_SB(0, 1), b2 + hstepB, voffB); PG8_STAGE(PG8_SA(0, 0), a2, voffA);
            PG8_WAIT_V(8); PG8_WAIT_L(0); PG8_BAR; PG8_MMA(1, 0, At, B0); PG8_MMA(1, 1, At, B1); PG8_BAR; PG8_SCHED;
            PG8_LDB(B0, 1, 0); PG8_LDB(B1, 1, 1); PG8_SCHED; PG8_LDA(At, 1, 0); PG8_STAGE(PG8_SA(0, 1), a2 + hstepA, voffA);
            PG8_WAIT_V(8); PG8_WAIT_L(0); PG8_BAR; PG8_MMA(0, 0, At, B0); PG8_MMA(0, 1, At, B1); PG8_BAR; PG8_SCHED;
            PG8_LDA(At, 1, 1); PG8_STAGE(PG8_SB(1, 0), b3, voffB); PG8_STAGE(PG8_SB(1, 1), b3 + hstepB, voffB); PG8_STAGE(PG8_SA(1, 0), a3, voffA);
            PG8_WAIT_V(8); PG8_WAIT_L(0); PG8_BAR; PG8_MMA(1, 0, At, B0); PG8_MMA(1, 1, At, B1); PG8_BAR; PG8_SCHED;
            } else {
            PG8_LDB(B0, 0, 0); PG8_SCHED; PG8_LDA(At, 0, 0); PG8_STAGE(PG8_SA(1, 1), a1 + hstepA, voffA);
            PG8_WAIT_L(8); PG8_BAR; PG8_WAIT_L(0); PG8_MMA(0, 0, At, B0); PG8_BAR; PG8_SCHED;
            PG8_LDB(B1, 0, 1); PG8_STAGE(PG8_SB(0, 0), b2, voffB);
            PG8_BAR; PG8_WAIT_L(0); PG8_MMA(0, 1, At, B1); PG8_BAR;
            PG8_LDA(At, 0, 1); PG8_STAGE(PG8_SA(0, 0), a2, voffA);
            PG8_BAR; PG8_WAIT_L(0); PG8_MMA(1, 0, At, B0); PG8_BAR; PG8_SCHED;
            PG8_STAGE(PG8_SB(0, 1), b2 + hstepB, voffB);
            PG8_WAIT_V(6); PG8_BAR; PG8_MMA(1, 1, At, B1); PG8_BAR;
            PG8_LDB(B0, 1, 0); PG8_SCHED; PG8_LDA(At, 1, 0); PG8_STAGE(PG8_SA(0, 1), a2 + hstepA, voffA);
            PG8_WAIT_L(8); PG8_BAR; PG8_WAIT_L(0); PG8_MMA(0, 0, At, B0); PG8_BAR; PG8_SCHED;
            PG8_LDB(B1, 1, 1); PG8_STAGE(PG8_SB(1, 0), b3, voffB);
            PG8_BAR; PG8_WAIT_L(0); PG8_MMA(0, 1, At, B1); PG8_BAR;
            PG8_LDA(At, 1, 1); PG8_STAGE(PG8_SA(1, 0), a3, voffA);
            PG8_BAR; PG8_WAIT_L(0); PG8_MMA(1, 0, At, B0); PG8_BAR; PG8_SCHED;
            PG8_STAGE(PG8_SB(1, 1), b3 + hstepB, voffB);
            PG8_WAIT_V(6); PG8_BAR; PG8_MMA(1, 1, At, B1); PG8_BAR;
            }
        }
        if constexpr (ALIGN_EPI) { if (wr == 0) PG8_BAR; }
        E(acc, cur, wr, wc, fr, fq, lds);
        if (!has_next) break;
#pragma unroll
        for (int a = 0; a < 2; ++a)
#pragma unroll
            for (int b = 0; b < 2; ++b)
#pragma unroll
                for (int m = 0; m < 4; ++m)
#pragma unroll
                    for (int n = 0; n < 2; ++n) acc[a][b][m][n] = (f32x4){0.f, 0.f, 0.f, 0.f};
        cur = nxt; cA = nA; cB = nB; ++ui;
        if constexpr (ALIGN_EPI) { if (wr == 1) PG8_BAR; }
    }
    PG8_WAIT_V(0);
    if constexpr (!ALIGN_EPI) { if (wr == 0) PG8_BAR; }
    PG8_BAR;
    PG8_SCHED;
#undef PG8_SA
#undef PG8_SB
#undef PG8_STAGE
#undef PG8_LDA
#undef PG8_LDB
#undef PG8_MMA
#undef PG8_WAIT_V
#undef PG8_WAIT_L
#undef PG8_BAR
#undef PG8_SCHED
}

template <class Epi, class Sched>
__device__ __forceinline__ void gemm_phase_gather(LAS unsigned char* lds, const Gemm g, const Sched& S, const Epi& E, const int* tok) {
    const int tid = opaque_tid(), wid = __builtin_amdgcn_readfirstlane(tid >> 6), lane = tid & 63, wr = wid >> 2, wc = wid & 3, fr = lane & 15, fq = lane >> 4;
    const int K = g.K, nt = K / BK;
    unsigned voffB[2]; int rA[2], cA2[2];
#pragma unroll
    for (int i = 0; i < 2; ++i) { int R, C; stage_rc(tid * 16 + i * 8192, R, C); const int Rb = Epi::PERM ? ((R & ~31) + perm32(R & 31)) : R; rA[i] = R; cA2[i] = C * 2; voffB[i] = (unsigned)(Rb * g.ldb + C) * 2u; }
    const size_t kstep = (size_t)(BK * 2); const size_t hstepB = (size_t)HALF * g.ldb * 2;
    const unsigned ldsw = (unsigned)wid * 1024u;
    const int aoff = lds_byte(wr * 64 + fr, fq * 8), boff = lds_byte(wc * 32 + fr, fq * 8);
#define PG8_SA(b, h) (((b) * 2 + (h)) * HTB)
#define PG8_SB(b, h) ((4 + (b) * 2 + (h)) * HTB)
#define PG8_STAGE(bufoff, gbase, voff) do { _Pragma("unroll") for (int _i = 0; _i < 2; ++_i) \
        __builtin_amdgcn_global_load_lds((const unsigned*)((const char*)(gbase) + (voff)[_i]), (LAS unsigned*)(lds + (bufoff) + ldsw + _i * 8192), 16, 0, 0); } while (0)
#define PG8_STAGEA(bufoff, go_, kb_) do { _Pragma("unroll") for (int _i = 0; _i < 2; ++_i) \
        __builtin_amdgcn_global_load_lds((const unsigned*)((const char*)g.A + (go_)[_i] + (kb_)), (LAS unsigned*)(lds + (bufoff) + ldsw + _i * 8192), 16, 0, 0); } while (0)
#define PG8_LDA(dst, b, h) do { _Pragma("unroll") for (int m = 0; m < 4; ++m) _Pragma("unroll") for (int k = 0; k < 2; ++k) dst[m][k] = *(const LAS bf16x8*)(lds + PG8_SA(b, h) + aoff + m * 2048 + k * 1024); } while (0)
#define PG8_LDB(dst, b, h) do { _Pragma("unroll") for (int n = 0; n < 2; ++n) _Pragma("unroll") for (int k = 0; k < 2; ++k) dst[n][k] = *(const LAS bf16x8*)(lds + PG8_SB(b, h) + boff + n * 2048 + k * 1024); } while (0)
#define PG8_MMA(ai, bj, At, Bt) do { __builtin_amdgcn_s_setprio(1); _Pragma("unroll") for (int m = 0; m < 4; ++m) _Pragma("unroll") for (int n = 0; n < 2; ++n) _Pragma("unroll") for (int k = 0; k < 2; ++k) \
        acc[ai][bj][m][n] = __builtin_amdgcn_mfma_f32_16x16x32_bf16(Bt[n][k], At[m][k], acc[ai][bj][m][n], 0, 0, 0); __builtin_amdgcn_s_setprio(0); } while (0)
#define PG8_WAIT_V(n) asm volatile("s_waitcnt vmcnt(" #n ")" ::: "memory")
#define PG8_WAIT_L(n) asm volatile("s_waitcnt lgkmcnt(" #n ")" ::: "memory")
#define PG8_BAR __builtin_amdgcn_s_barrier()
#define PG8_SCHED __builtin_amdgcn_sched_barrier(0)
#define PG8_GOFF(dst, u_) do { _Pragma("unroll") for (int _h = 0; _h < 2; ++_h) _Pragma("unroll") for (int _i = 0; _i < 2; ++_i) \
        dst[_h][_i] = (unsigned)tok[(u_).pm * 256 + _h * 128 + rA[_i]] * (unsigned)(g.lda * 2) + (unsigned)cA2[_i]; } while (0)
    __builtin_amdgcn_sched_barrier(0);
    Unit cur, nxt; int ui = 0;
    if (!S.next(0, cur)) return;
    f32x4 acc[2][2][4][2];
#pragma unroll
    for (int a = 0; a < 2; ++a)
#pragma unroll
        for (int b = 0; b < 2; ++b)
#pragma unroll
            for (int m = 0; m < 4; ++m)
#pragma unroll
                for (int n = 0; n < 2; ++n) acc[a][b][m][n] = (f32x4){0.f, 0.f, 0.f, 0.f};
    bf16x8 At[4][2], B0[2][2], B1[2][2];
    unsigned goC[2][2], goN[2][2];
    PG8_GOFF(goC, cur);
    const char* cB; { long long ao, bo; S.offs(cur, ao, bo); cB = (const char*)g.Bt + bo; }
    PG8_STAGE(PG8_SB(0, 0), cB, voffB); PG8_STAGE(PG8_SB(0, 1), cB + hstepB, voffB); PG8_STAGEA(PG8_SA(0, 0), goC[0], 0); PG8_STAGEA(PG8_SA(0, 1), goC[1], 0);
    if (wr == 1) PG8_BAR;
    PG8_WAIT_V(2); PG8_BAR;
    PG8_STAGE(PG8_SB(1, 0), cB + kstep, voffB); PG8_STAGEA(PG8_SA(1, 0), goC[0], kstep); PG8_STAGE(PG8_SB(1, 1), cB + hstepB + kstep, voffB);
    PG8_WAIT_V(6); PG8_BAR;
    for (;;) {
        const bool has_next = S.next(ui + 1, nxt);
        const char* nB = cB; if (has_next) { long long ao, bo; S.offs(nxt, ao, bo); nB = (const char*)g.Bt + bo; PG8_GOFF(goN, nxt); }
        else {
#pragma unroll
            for (int _h = 0; _h < 2; ++_h)
#pragma unroll
                for (int _i = 0; _i < 2; ++_i) goN[_h][_i] = goC[_h][_i]; }
#pragma nounroll
        for (int t = 0; t < nt; t += 2) {
            const bool last = (t == nt - 2);
            const size_t k1 = (size_t)(t + 1) * kstep, k2 = last ? 0 : (size_t)(t + 2) * kstep, k3 = k2 + kstep;
            const char* b2 = last ? nB : cB + (size_t)(t + 2) * kstep; const char* b3 = b2 + kstep;
            unsigned g2[2][2];
#pragma unroll
            for (int _h = 0; _h < 2; ++_h)
#pragma unroll
                for (int _i = 0; _i < 2; ++_i) g2[_h][_i] = last ? goN[_h][_i] : goC[_h][_i];
            PG8_LDB(B0, 0, 0); PG8_LDB(B1, 0, 1); PG8_SCHED; PG8_LDA(At, 0, 0); PG8_STAGEA(PG8_SA(1, 1), goC[1], k1);
            PG8_WAIT_V(8); PG8_WAIT_L(0); PG8_BAR; PG8_MMA(0, 0, At, B0); PG8_MMA(0, 1, At, B1); PG8_BAR; PG8_SCHED;
            PG8_LDA(At, 0, 1); PG8_STAGE(PG8_SB(0, 0), b2, voffB); PG8_STAGE(PG8_SB(0, 1), b2 + hstepB, voffB); PG8_STAGEA(PG8_SA(0, 0), g2[0], k2);
            PG8_WAIT_V(8); PG8_WAIT_L(0); PG8_BAR; PG8_MMA(1, 0, At, B0); PG8_MMA(1, 1, At, B1); PG8_BAR; PG8_SCHED;
            PG8_LDB(B0, 1, 0); PG8_LDB(B1, 1, 1); PG8_SCHED; PG8_LDA(At, 1, 0); PG8_STAGEA(PG8_SA(0, 1), g2[1], k2);
            PG8_WAIT_V(8); PG8_WAIT_L(0); PG8_BAR; PG8_MMA(0, 0, At, B0); PG8_MMA(0, 1, At, B1); PG8_BAR; PG8_SCHED;
            PG8_LDA(At, 1, 1); PG8_STAGE(PG8_SB(1, 0), b3, voffB); PG8_STAGE(PG8_SB(1, 1), b3 + hstepB, voffB); PG8_STAGEA(PG8_SA(1, 0), g2[0], k3);
            PG8_WAIT_V(8); PG8_WAIT_L(0); PG8_BAR; PG8_MMA(1, 0, At, B0); PG8_MMA(1, 1, At, B1); PG8_BAR; PG8_SCHED;
        }
        if (wr == 0) PG8_BAR;
        E(acc, cur, wr, wc, fr, fq, lds);
        if (!has_next) break;
#pragma unroll
        for (int a = 0; a < 2; ++a)
#pragma unroll
            for (int b = 0; b < 2; ++b)
#pragma unroll
                for (int m = 0; m < 4; ++m)
#pragma unroll
                    for (int n = 0; n < 2; ++n) acc[a][b][m][n] = (f32x4){0.f, 0.f, 0.f, 0.f};
        cur = nxt; cB = nB; ++ui;
#pragma unroll
        for (int _h = 0; _h < 2; ++_h)
#pragma unroll
            for (int _i = 0; _i < 2; ++_i) goC[_h][_i] = goN[_h][_i];
        if (wr == 1) PG8_BAR;
    }
    PG8_WAIT_V(0);
    PG8_BAR;
    PG8_SCHED;
#undef PG8_SA
#undef PG8_SB
#undef PG8_STAGE
#undef PG8_STAGEA
#undef PG8_LDA
#undef PG8_LDB
#undef PG8_MMA
#undef PG8_WAIT_V
#undef PG8_WAIT_L
#undef PG8_BAR
#undef PG8_SCHED
#undef PG8_GOFF
}
}
using pg8::Unit;
typedef const f32x4 (&AccRef)[2][2][4][2];

struct SchedPlain : pg8::OrderCore {
    long long astr, bstr;
    __device__ __forceinline__ bool next(int i, Unit& u) const { return map(i, u.pm, u.pn); }
    __device__ __forceinline__ void offs(const Unit& u, long long& ao, long long& bo) const { ao = (long long)u.pm * astr; bo = (long long)u.pn * bstr; }
};
struct SchedRange : pg8::OrderCore {
    long long astr, bstr; int base, count;
    __device__ __forceinline__ bool next(int i, Unit& u) const { const long L = (long)i * G + c; if (c < 0 || L >= count) return false; return map_lin(base + L, u.pm, u.pn); }
    __device__ __forceinline__ void offs(const Unit& u, long long& ao, long long& bo) const { ao = (long long)u.pm * astr; bo = (long long)u.pn * bstr; }
};
struct SchedHP : pg8::OrderCore {
    __device__ __forceinline__ bool next(int i, Unit& u) const { return map(i, u.pm, u.pn); }
    __device__ __forceinline__ void offs(const Unit& u, long long& ao, long long& bo) const {
        ao = ((long long)(u.pm >> 5) * (S + 1) + (long long)(u.pm & 31) * 256) * (D * 2); bo = (long long)u.pn * 256 * (2 * D) * 2; }
};
struct SchedRKV : pg8::OrderCore {
    long long aoff0, aoff1;
    __device__ __forceinline__ bool next(int i, Unit& u) const { return map(i, u.pm, u.pn); }
    __device__ __forceinline__ void offs(const Unit& u, long long& ao, long long& bo) const {
        const int t = u.pn >> 2; long long base = aoff1 + (long long)(t - 1) * ((long long)T * D * 2); if (t == 0) base = aoff0; ao = base + (long long)u.pm * 256 * D * 2; bo = (long long)u.pn * 256 * D * 2; }
};
struct SchedMoE : pg8::OrderCore {
    const int* tile_expert; int mode;
    __device__ __forceinline__ bool next(int i, Unit& u) const { return map(i, u.pm, u.pn); }
    __device__ __forceinline__ void offs(const Unit& u, long long& ao, long long& bo) const {
        const int e = tile_expert[u.pm];
        if (mode == 0) { ao = (long long)u.pm * 256 * D * 2; bo = ((long long)e * 512 + u.pn * 256) * D * 2; }
        else { ao = (long long)u.pm * 256 * 256 * 2; bo = ((long long)e * 1024 + u.pn * 256) * 256 * 2; } }
};

__device__ __forceinline__ u32x4 pack8v4(const f32x4 v0, const f32x4 v1) { u32x4 w; w.x = cvt_pk_c(v0[0], v0[1]); w.y = cvt_pk_c(v0[2], v0[3]); w.z = cvt_pk_c(v1[0], v1[1]); w.w = cvt_pk_c(v1[2], v1[3]); return w; }
__device__ __forceinline__ u32x4 pack8(const f32x4 v0, const f32x4 v1) { u32x4 w; w.x = cvt_pk_c(v0[0], v0[1]); w.y = cvt_pk_c(v0[2], v0[3]); w.z = cvt_pk_c(v1[0], v1[1]); w.w = cvt_pk_c(v1[2], v1[3]); return w; }

struct EpiCat {
    static constexpr bool PERM = true;
    bf16_t *R, *L; long long tstride; int pn_off;
    __device__ __forceinline__ void operator()(AccRef acc, const Unit& u, int wr, int wc, int fr, int fq, LAS unsigned char*) const {
        const int row0 = u.pm * 256 + wr * 64 + fr; const int pn = u.pn + pn_off;
        if (pn < 12) {
            const int t = pn >> 2; bf16_t* base = R + (long long)t * tstride; const int col0 = (pn & 3) * 256 + wc * 32 + 8 * fq;
#pragma unroll
            for (int ai = 0; ai < 2; ++ai)
#pragma unroll
                for (int m = 0; m < 4; ++m) { bf16_t* rowp = base + (size_t)(row0 + ai * 128 + m * 16) * D + col0;
#pragma unroll
                    for (int bj = 0; bj < 2; ++bj) *(u32x4*)(rowp + bj * 128) = pack8(acc[ai][bj][m][0], acc[ai][bj][m][1]); }
        } else {
            const int ct = wc * 32 + 8 * fq, lcol0 = (pn - 12) * 256 + ct;
#pragma unroll
            for (int ai = 0; ai < 2; ++ai)
#pragma unroll
                for (int m = 0; m < 4; ++m) { bf16_t* rowp = L + (size_t)(row0 + ai * 128 + m * 16) * 512 + lcol0;
#pragma unroll
                    for (int bj = 0; bj < 2; ++bj) { f32x4 v0 = acc[ai][bj][m][0], v1 = acc[ai][bj][m][1];
                        const int mode = (pn == 13) ? 2 : ((ct + bj * 128) < 64 ? 1 : 0);
                        if (mode == 1) {
#pragma unroll
                            for (int j = 0; j < 4; ++j) { v0[j] = fast_tanh(v0[j]); v1[j] = fast_tanh(v1[j]); } }
                        else if (mode == 2) {
#pragma unroll
                            for (int j = 0; j < 4; ++j) { v0[j] = fast_sigmoid(v0[j]); v1[j] = fast_sigmoid(v1[j]); } }
                        *(u32x4*)(rowp + bj * 128) = pack8(v0, v1); } }
        }
    }
};
struct EpiAct {
    static constexpr bool PERM = true;
    bf16_t* O0; long long ostride; const float* bias0; long long bstride; float sc0, dsc;
    __device__ __forceinline__ void operator()(AccRef acc, const Unit& u, int wr, int wc, int fr, int fq, LAS unsigned char*) const {
        const int t = u.pn >> 2; const int row0 = u.pm * 256 + wr * 64 + fr, col0 = (u.pn & 3) * 256 + wc * 32 + 8 * fq;
        bf16_t* base = O0 + (long long)t * ostride; const float* bs = bias0 + (long long)t * bstride;
        f32x4 bv[2][2];
#pragma unroll
        for (int bj = 0; bj < 2; ++bj)
#pragma unroll
            for (int n = 0; n < 2; ++n) bv[bj][n] = bias0 ? *(const f32x4*)(bs + col0 + bj * 128 + 4 * n) : (f32x4){0.f, 0.f, 0.f, 0.f};
#pragma unroll
        for (int ai = 0; ai < 2; ++ai)
#pragma unroll
            for (int m = 0; m < 4; ++m) { bf16_t* rowp = base + (size_t)(row0 + ai * 128 + m * 16) * D + col0;
#pragma unroll
                for (int bj = 0; bj < 2; ++bj) { f32x4 v0 = acc[ai][bj][m][0] + bv[bj][0], v1 = acc[ai][bj][m][1] + bv[bj][1];
                    if (bias0) { const float sc = sc0 + (float)t * dsc;
#pragma unroll
                        for (int j = 0; j < 4; ++j) { v0[j] = sc * fast_sigmoid(v0[j]); v1[j] = sc * fast_sigmoid(v1[j]); } }
                    *(u32x4*)(rowp + bj * 128) = pack8(v0, v1); } }
    }
};
struct EpiResid {
    static constexpr bool PERM = true;
    const float* resid_f32; bf16_t* xb; float* ssq; float bscale;
    __device__ __forceinline__ void operator()(AccRef acc, const Unit& u, int wr, int wc, int fr, int fq, LAS unsigned char*) const {
        const int row0 = u.pm * 256 + wr * 64 + fr, col0 = u.pn * 256 + wc * 32 + 8 * fq;
        if (resid_f32) {
#pragma unroll
            for (int bt = 0; bt < 4; ++bt) { f32x4 rr[2][2][2];
#pragma unroll
                for (int mm = 0; mm < 2; ++mm)
#pragma unroll
                    for (int bj = 0; bj < 2; ++bj) { const size_t off = (size_t)(row0 + (bt >> 1) * 128 + ((bt & 1) * 2 + mm) * 16) * D + col0 + bj * 128;
                        rr[mm][bj][0] = *(const f32x4*)(resid_f32 + off); rr[mm][bj][1] = *(const f32x4*)(resid_f32 + off + 4); }
                float s[2];
#pragma unroll
                for (int mm = 0; mm < 2; ++mm) { const int ai = bt >> 1, m = (bt & 1) * 2 + mm; const size_t off = (size_t)(row0 + ai * 128 + m * 16) * D + col0; s[mm] = 0.f;
#pragma unroll
                    for (int bj = 0; bj < 2; ++bj) { const f32x4 o0 = rr[mm][bj][0] + acc[ai][bj][m][0] * bscale, o1 = rr[mm][bj][1] + acc[ai][bj][m][1] * bscale;
                        *(u32x4*)(xb + off + bj * 128) = pack8(o0, o1);
                        s[mm] += ((o0[0] * o0[0] + o0[1] * o0[1]) + (o0[2] * o0[2] + o0[3] * o0[3])) + ((o1[0] * o1[0] + o1[1] * o1[1]) + (o1[2] * o1[2] + o1[3] * o1[3])); } }
#pragma unroll
                for (int mm = 0; mm < 2; ++mm) { s[mm] += __shfl_xor(s[mm], 16); s[mm] += __shfl_xor(s[mm], 32);
                    if (fq == 0) ssq[(size_t)(row0 + (bt >> 1) * 128 + ((bt & 1) * 2 + mm) * 16) * 16 + u.pn * 4 + wc] = s[mm]; }
                asm volatile("" ::: "memory"); }
        } else {
#pragma unroll
            for (int ai = 0; ai < 2; ++ai) { u32x4 rw[4][2];
#pragma unroll
                for (int m = 0; m < 4; ++m)
#pragma unroll
                    for (int bj = 0; bj < 2; ++bj) rw[m][bj] = *(const u32x4*)(xb + (size_t)(row0 + ai * 128 + m * 16) * D + col0 + bj * 128);
                float s[4];
#pragma unroll
                for (int m = 0; m < 4; ++m) { const size_t off = (size_t)(row0 + ai * 128 + m * 16) * D + col0; s[m] = 0.f;
#pragma unroll
                    for (int bj = 0; bj < 2; ++bj) { const u32x4 w = rw[m][bj];
                        const f32x4 r0 = (f32x4){bf_lo(w.x), bf_hi(w.x), bf_lo(w.y), bf_hi(w.y)}, r1 = (f32x4){bf_lo(w.z), bf_hi(w.z), bf_lo(w.w), bf_hi(w.w)};
                        const f32x4 o0 = r0 + acc[ai][bj][m][0] * bscale, o1 = r1 + acc[ai][bj][m][1] * bscale;
                        *(u32x4*)(xb + off + bj * 128) = pack8(o0, o1);
                        s[m] += ((o0[0] * o0[0] + o0[1] * o0[1]) + (o0[2] * o0[2] + o0[3] * o0[3])) + ((o1[0] * o1[0] + o1[1] * o1[1]) + (o1[2] * o1[2] + o1[3] * o1[3])); } }
#pragma unroll
                for (int m = 0; m < 4; ++m) { s[m] += __shfl_xor(s[m], 16); s[m] += __shfl_xor(s[m], 32);
                    if (fq == 0) ssq[(size_t)(row0 + ai * 128 + m * 16) * 16 + u.pn * 4 + wc] = s[m]; }
                asm volatile("" ::: "memory"); }
        }
    }
};
struct EpiRstd {
    static constexpr bool PERM = true;
    bf16_t* O0; long long tstride; const float* ssq;
    __device__ __forceinline__ void operator()(AccRef acc, const Unit& u, int wr, int wc, int fr, int fq, LAS unsigned char*) const {
        const int t = u.pn >> 2; bf16_t* base = O0 + (long long)t * tstride;
        const int row0 = u.pm * 256 + wr * 64 + fr, col0 = (u.pn & 3) * 256 + wc * 32 + 8 * fq;
#pragma unroll
        for (int ai = 0; ai < 2; ++ai)
#pragma unroll
            for (int m = 0; m < 4; ++m) { const int row = row0 + ai * 128 + m * 16; const f32x4* sp = (const f32x4*)(ssq + (size_t)row * 16);
                const f32x4 s4 = (sp[0] + sp[1]) + (sp[2] + sp[3]); const float rstd = __builtin_amdgcn_rsqf(((s4[0] + s4[1]) + (s4[2] + s4[3])) * (1.0f / D) + NORM_EPS);
                bf16_t* rowp = base + (size_t)row * D + col0;
#pragma unroll
                for (int bj = 0; bj < 2; ++bj) *(u32x4*)(rowp + bj * 128) = pack8(acc[ai][bj][m][0] * rstd, acc[ai][bj][m][1] * rstd); }
    }
};
struct EpiSwiGLU {
    static constexpr bool PERM = true;
    bf16_t* H; const float* slot_info;
    __device__ __forceinline__ void operator()(AccRef acc, const Unit& u, int wr, int wc, int fr, int fq, LAS unsigned char*) const {
        const int row0 = u.pm * 256 + wr * 64 + fr, col0 = u.pn * 128 + wc * 32 + 8 * fq;
#pragma unroll
        for (int ai = 0; ai < 2; ++ai)
#pragma unroll
            for (int m = 0; m < 4; ++m) { const int row = row0 + ai * 128 + m * 16; const float rstd = slot_info[(size_t)row * 2 + 1];
                f32x4 h0, h1;
#pragma unroll
                for (int j = 0; j < 4; ++j) { const float g0 = acc[ai][0][m][0][j] * rstd, g1 = acc[ai][0][m][1][j] * rstd;
                    h0[j] = g0 * fast_sigmoid(g0) * (acc[ai][1][m][0][j] * rstd); h1[j] = g1 * fast_sigmoid(g1) * (acc[ai][1][m][1][j] * rstd); }
                *(u32x4*)(H + (size_t)row * 256 + col0) = pack8(h0, h1); }
    }
};
struct EpiGate {
    static constexpr bool PERM = true;
    bf16_t* Y; const float* slot_info;
    __device__ __forceinline__ void operator()(AccRef acc, const Unit& u, int wr, int wc, int fr, int fq, LAS unsigned char*) const {
        const int row0 = u.pm * 256 + wr * 64 + fr, col0 = u.pn * 256 + wc * 32 + 8 * fq;
#pragma unroll
        for (int ai = 0; ai < 2; ++ai)
#pragma unroll
            for (int m = 0; m < 4; ++m) { const int row = row0 + ai * 128 + m * 16; const float gt = slot_info[(size_t)row * 2];
                bf16_t* rowp = Y + (size_t)row * D + col0;
#pragma unroll
                for (int bj = 0; bj < 2; ++bj) *(u32x4*)(rowp + bj * 128) = pack8(acc[ai][bj][m][0] * gt, acc[ai][bj][m][1] * gt); }
    }
};
struct EpiMemKV {
    static constexpr bool PERM = true;
    bf16_t* KM; bf16_t* VM;
    __device__ __forceinline__ void operator()(AccRef acc, const Unit& u, int wr, int wc, int fr, int fq, LAS unsigned char*) const {
        const int l = u.pm >> 3, prow0 = (u.pm & 7) * 256 + wr * 64 + fr, ct0 = u.pn * 256 + wc * 32 + 8 * fq;
#pragma unroll
        for (int ai = 0; ai < 2; ++ai)
#pragma unroll
            for (int m = 0; m < 4; ++m) { const int row = prow0 + ai * 128 + m * 16;
#pragma unroll
                for (int bj = 0; bj < 2; ++bj) { const int col = ct0 + bj * 128; bf16_t* dst = (col < 1024 ? KM : VM - 1024) + ((size_t)l * 2048 + row) * D + col;
                    *(u32x4*)dst = pack8(acc[ai][bj][m][0], acc[ai][bj][m][1]); } }
    }
};
struct SchedMemKV : pg8::OrderCore {
    __device__ __forceinline__ bool next(int i, Unit& u) const { return map(i, u.pm, u.pn); }
    __device__ __forceinline__ void offs(const Unit& u, long long& ao, long long& bo) const { ao = (long long)(u.pm & 7) * 256 * D * 2; bo = ((long long)(u.pm >> 3) * 2048 + u.pn * 256) * D * 2; }
};

struct SchedMemPre : pg8::OrderCore {
    int mode;
    __device__ __forceinline__ bool next(int i, Unit& u) const { return map(i, u.pm, u.pn); }
    __device__ __forceinline__ void offs(const Unit& u, long long& ao, long long& bo) const {
        const int lb = u.pm >> 2, q = u.pm & 3, l = lb >> 3;
        if (mode == 0) { ao = ((long long)lb * 256 * D + q * 256) * 2; bo = ((long long)l * D * D + (long long)u.pn * 256 * D + q * 256) * 2; }
        else { ao = ((long long)l * D * D + (long long)q * 256 * D + u.pn * 256) * 2; bo = ((long long)lb * 256 * D + u.pn * 256) * 2; } }
};
struct EpiMemPre {
    static constexpr bool PERM = true;
    bf16_t* O;
    __device__ __forceinline__ void operator()(AccRef acc, const Unit& u, int wr, int wc, int fr, int fq, LAS unsigned char*) const {
        const int row0 = (u.pm >> 2) * 1024 + (u.pm & 3) * 256 + wr * 64 + fr, col0 = u.pn * 256 + wc * 32 + 8 * fq;
#pragma unroll
        for (int ai = 0; ai < 2; ++ai)
#pragma unroll
            for (int m = 0; m < 4; ++m) { bf16_t* rowp = O + (size_t)(row0 + ai * 128 + m * 16) * D + col0;
#pragma unroll
                for (int bj = 0; bj < 2; ++bj) *(u32x4*)(rowp + bj * 128) = pack8(acc[ai][bj][m][0], acc[ai][bj][m][1]); }
    }
};
struct SchedBatchB : pg8::OrderCore {
    __device__ __forceinline__ bool next(int i, Unit& u) const { return map(i, u.pm, u.pn); }
    __device__ __forceinline__ void offs(const Unit& u, long long& ao, long long& bo) const { ao = (long long)u.pm * 256 * D * 2; bo = ((long long)(u.pm >> 5) * 1024 + u.pn * 256) * D * 2; }
};
struct EpiSoftmax {
    static constexpr bool PERM = true;
    bf16_t* P; const float* ssq;
    __device__ __forceinline__ void operator()(AccRef acc_c, const Unit& u, int wr, int wc, int fr, int fq, LAS unsigned char* lds) const {
        f32x4 (&acc)[2][2][4][2] = const_cast<f32x4 (&)[2][2][4][2]>(acc_c);
        LAS f32x2* ex = (LAS f32x2*)(lds + LDS_EPI);
#pragma unroll
        for (int ai = 0; ai < 2; ++ai)
#pragma unroll
            for (int m = 0; m < 4; ++m) { const int rl = ai * 128 + wr * 64 + m * 16 + fr; const f32x4* sp = (const f32x4*)(ssq + (size_t)(u.pm * 256 + rl) * 16);
                const f32x4 s4 = (sp[0] + sp[1]) + (sp[2] + sp[3]); const float rstd = __builtin_amdgcn_rsqf(((s4[0] + s4[1]) + (s4[2] + s4[3])) * (1.0f / D) + NORM_EPS);
                float mx = -3.0e38f;
#pragma unroll
                for (int bj = 0; bj < 2; ++bj)
#pragma unroll
                    for (int n = 0; n < 2; ++n) { acc[ai][bj][m][n] = acc[ai][bj][m][n] * rstd; mx = fmaxf(mx, fmaxf(fmaxf(acc[ai][bj][m][n][0], acc[ai][bj][m][n][1]), fmaxf(acc[ai][bj][m][n][2], acc[ai][bj][m][n][3]))); }
                mx = fmaxf(mx, __shfl_xor(mx, 16)); mx = fmaxf(mx, __shfl_xor(mx, 32));
                float sm = 0.f;
#pragma unroll
                for (int bj = 0; bj < 2; ++bj)
#pragma unroll
                    for (int n = 0; n < 2; ++n) {
#pragma unroll
                        for (int j = 0; j < 4; ++j) { const float pj = __builtin_amdgcn_exp2f(acc[ai][bj][m][n][j] - mx); acc[ai][bj][m][n][j] = pj; sm += pj; } }
                sm += __shfl_xor(sm, 16); sm += __shfl_xor(sm, 32);
                if (fq == 0) ex[rl * 4 + wc] = (f32x2){mx, sm}; }
        lds_barrier();
#pragma unroll
        for (int ai = 0; ai < 2; ++ai)
#pragma unroll
            for (int m = 0; m < 4; ++m) { const int rl = ai * 128 + wr * 64 + m * 16 + fr;
                const f32x4 e01 = *(const LAS f32x4*)(ex + rl * 4), e23 = *(const LAS f32x4*)(ex + rl * 4 + 2);
                const float gm = fmaxf(fmaxf(e01[0], e01[2]), fmaxf(e23[0], e23[2]));
                const float tot = (e01[1] * __builtin_amdgcn_exp2f(e01[0] - gm) + e01[3] * __builtin_amdgcn_exp2f(e01[2] - gm)) + (e23[1] * __builtin_amdgcn_exp2f(e23[0] - gm) + e23[3] * __builtin_amdgcn_exp2f(e23[2] - gm));
                const float own = wc == 0 ? e01[0] : wc == 1 ? e01[2] : wc == 2 ? e23[0] : e23[2];
                const float f = __builtin_amdgcn_exp2f(own - gm) * __builtin_amdgcn_rcpf(tot);
                bf16_t* rowp = P + (size_t)(u.pm * 256 + rl) * D + u.pn * 256 + wc * 32 + 8 * fq;
#pragma unroll
                for (int bj = 0; bj < 2; ++bj) *(u32x4*)(rowp + bj * 128) = pack8(acc[ai][bj][m][0] * f, acc[ai][bj][m][1] * f); }
    }
};
struct EpiRouter {
    static constexpr bool PERM = true;
    const float* ssq; const float* brg; const float* bre; u32x4* tok;
    __device__ __forceinline__ void operator()(AccRef acc, const Unit& u, int wr, int wc, int fr, int fq, LAS unsigned char* lds) const {
        LAS f32x4* gl = (LAS f32x4*)(lds + LDS_EPI); LAS int* lc = (LAS int*)(lds + LDS_EPI + 4096);
        auto row_rstd = [&](int row) { const f32x4* sp = (const f32x4*)(ssq + (size_t)row * 16); const f32x4 s4 = (sp[0] + sp[1]) + (sp[2] + sp[3]);
            return __builtin_amdgcn_rsqf(((s4[0] + s4[1]) + (s4[2] + s4[3])) * (1.0f / D) + NORM_EPS); };
        if (wc == 1 && fq == 0) { const f32x4 bg = *(const f32x4*)brg;
#pragma unroll
            for (int ai = 0; ai < 2; ++ai)
#pragma unroll
                for (int m = 0; m < 4; ++m) { const int rl = ai * 128 + wr * 64 + m * 16 + fr; gl[rl] = (acc[ai][0][m][0] + acc[ai][1][m][0]) * row_rstd(u.pm * 256 + rl) + bg; } }
        lds_barrier();
        if (wc == 0) {
#pragma unroll
            for (int ai = 0; ai < 2; ++ai)
#pragma unroll
                for (int m = 0; m < 4; ++m) { const int rl = ai * 128 + wr * 64 + m * 16 + fr; const f32x4 g = gl[rl];
                    int grp = 0; float gm = g[0];
#pragma unroll
                    for (int c = 1; c < 4; ++c) if (g[c] > gm) { gm = g[c]; grp = c; }
                    if (fq == grp) {
                        float gden = 0.f;
#pragma unroll
                        for (int c = 0; c < 4; ++c) gden += __expf(g[c] - gm);
                        const float gw = 1.0f / gden;
                        const f32x4 b0 = *(const f32x4*)(bre + grp * 8), b1 = *(const f32x4*)(bre + grp * 8 + 4);
                        const float rs = row_rstd(u.pm * 256 + rl);
                        const f32x4 e0 = (acc[ai][0][m][0] + acc[ai][1][m][0]) * rs + b0, e1v = (acc[ai][0][m][1] + acc[ai][1][m][1]) * rs + b1;
                        const float el[8] = {e0[0], e0[1], e0[2], e0[3], e1v[0], e1v[1], e1v[2], e1v[3]};
                        int i1 = 0; float m1 = el[0];
#pragma unroll
                        for (int c = 1; c < 8; ++c) if (el[c] > m1) { m1 = el[c]; i1 = c; }
                        int i2 = -1; float m2 = -3.0e38f;
#pragma unroll
                        for (int c = 0; c < 8; ++c) if (c != i1 && el[c] > m2) { m2 = el[c]; i2 = c; }
                        if (i2 < 0) i2 = i1 ? 0 : 1;
                        const float ex = __expf(m2 - m1); const float w1 = 1.0f / (1.0f + ex), w2 = ex * w1;
                        const int x1 = grp * 8 + i1, x2 = grp * 8 + i2;
                        u32x4 o; o.x = (unsigned)x1 | ((unsigned)x2 << 8); o.y = __builtin_bit_cast(unsigned, gw * w1); o.z = __builtin_bit_cast(unsigned, gw * w2); o.w = __builtin_bit_cast(unsigned, rs);
                        tok[u.pm * 256 + rl] = o; atomicAdd((int*)&lc[x1], 1); atomicAdd((int*)&lc[x2], 1); } } }
    }
};

struct Args { const float* in[37]; float* out; unsigned char* ws; int ph_lo, ph_hi; };
typedef const __attribute__((address_space(4))) Args* KArgs;
__device__ __forceinline__ KArgs kargs() { KArgs p = (KArgs)__builtin_amdgcn_kernarg_segment_ptr(); asm volatile("" : "+s"(p)); return p; }
enum { I_X = 0, I_MEM, I_NORM_MIX, I_NORM_MEM, I_NORM_FFN, I_NORM_FINAL, I_MU, I_WRKV, I_W0, I_W1, I_W2, I_A0, I_A1, I_A2, I_G1, I_G2, I_KK, I_KA, I_RK, I_LNG, I_LNB, I_WO,
       I_KVNORM, I_WKVS, I_SBWQ, I_SBWO, I_MEMNORMKV, I_MEMWQ, I_MEMWKV, I_MEMWO, I_WRG, I_BRG, I_WRE, I_BRE, I_WGATE, I_WUP, I_WDOWN };

struct ConvJob { const float* src; bf16_t* dst; const float* g; const float* mu; int K, N, lds, ldd, mumode; float cst; };
constexpr int NJOBS = 25 + 320;
__device__ __forceinline__ ConvJob get_job(KArgs a, int j) {
    ConvJob J; J.g = nullptr; J.mu = nullptr; J.mumode = 0; J.cst = 1.f;
    unsigned char* ws = a->ws;
    if (j < 12) { const int i = j >> 1, part = j & 1; J.K = D; J.g = a->in[I_NORM_MIX];
        if (i < 3) {
            J.src = a->in[I_WRKV] + (size_t)i * D * D; J.N = part ? 0 : D; J.lds = D; J.ldd = D; J.dst = (bf16_t*)(ws + WS_WCAT) + (size_t)(i * 1024) * D; return J; }
        J.ldd = 2 * D; J.mu = a->in[I_MU] + i * D; J.mumode = part ? 2 : 1;
        bf16_t* base = (bf16_t*)(ws + WS_WCAT) + part * D;
        if (i == 3) { J.src = a->in[I_W1]; J.N = 64; J.lds = 64; J.dst = base + (size_t)3072 * 2 * D; }
        else if (i == 4) { J.src = a->in[I_A1]; J.N = 64; J.lds = 64; J.dst = base + (size_t)(3072 + 64) * 2 * D; }
        else { J.src = a->in[I_G1]; J.N = 160; J.lds = 160; J.dst = base + (size_t)3328 * 2 * D; }
        return J; }
    if (j == 12) { J.src = a->in[I_W2]; J.K = 64; J.N = D; J.lds = D; J.dst = (bf16_t*)(ws + WS_WWA2); J.ldd = 256; return J; }
    if (j == 13) { J.src = a->in[I_A2]; J.K = 64; J.N = D; J.lds = D; J.dst = (bf16_t*)(ws + WS_WWA2) + (size_t)1024 * 256 + 64; J.ldd = 256; return J; }
    if (j == 14) { J.src = a->in[I_G2]; J.K = 160; J.N = D; J.lds = D; J.dst = (bf16_t*)(ws + WS_WG2); J.ldd = 256; return J; }
    if (j == 15) { J.src = a->in[I_WO]; J.K = D; J.N = D; J.lds = D; J.dst = (bf16_t*)(ws + WS_WO0); J.ldd = D; return J; }
    if (j == 16) { J.src = a->in[I_WKVS]; J.K = D; J.N = 2 * D; J.lds = 2 * D; J.dst = (bf16_t*)(ws + WS_WKVQ); J.ldd = D; J.g = a->in[I_KVNORM]; return J; }
    if (j == 17) { J.src = a->in[I_SBWQ]; J.K = D; J.N = D; J.lds = D; J.dst = (bf16_t*)(ws + WS_WKVQ) + (size_t)2048 * D; J.ldd = D; J.g = a->in[I_NORM_MIX] + D; J.cst = 0.125f * 1.44269504f; return J; }
    if (j == 18) { J.src = a->in[I_SBWO]; J.K = D; J.N = D; J.lds = D; J.dst = (bf16_t*)(ws + WS_WOSB); J.ldd = D; return J; }
    if (j < 25) { const int l = (j - 19) / 3, w = (j - 19) % 3; J.K = D; J.ldd = D;
        if (w == 0) { J.src = a->in[I_MEMWQ]; J.N = 0; J.lds = D; J.dst = (bf16_t*)(ws + WS_WMQ); }
        else if (w == 1) { J.src = a->in[I_MEMWKV] + (size_t)l * D * 2 * D; J.N = 2 * D; J.lds = 2 * D; J.dst = (bf16_t*)(ws + WS_WMKV) + (size_t)l * 2 * D * D; J.g = a->in[I_MEMNORMKV] + l * D; }
        else { J.src = a->in[I_MEMWO] + (size_t)l * D * D; J.N = D; J.lds = D; J.dst = (bf16_t*)(ws + WS_WMO) + (size_t)l * D * D; }
        return J; }
    const int mI = j - 25, l = mI / 160, e = (mI % 160) / 5, part = mI % 5;
    if (part < 4) { const int up = part >> 1, hh = part & 1; J.src = a->in[up ? I_WUP : I_WGATE] + ((size_t)l * 32 + e) * D * 256 + hh * 128; J.K = D; J.N = 128; J.lds = 256;
        J.dst = (bf16_t*)(ws + WS_WGU) + (((size_t)l * 32 + e) * 512 + hh * 256 + up * 128) * D; J.ldd = D; J.g = a->in[I_NORM_FFN] + l * D; }
    else { J.src = a->in[I_WDOWN] + ((size_t)l * 32 + e) * 256 * D; J.K = 256; J.N = D; J.lds = D; J.dst = (bf16_t*)(ws + WS_WDN) + ((size_t)l * 32 + e) * D * 256; J.ldd = 256; }
    return J;
}
__device__ __forceinline__ void conv_load(const ConvJob& J, int tile, float (&v)[64], float& gk, float& mk, int lane) {
    const int ntn = (J.N + 63) >> 6, kb = tile / ntn, nb = tile % ntn, k0 = kb * 64, n0 = nb * 64;
    const int nc = (n0 + lane) < J.N ? n0 + lane : J.N - 1;
    { const int kc = (k0 + lane) < J.K ? k0 + lane : J.K - 1; gk = J.g ? J.g[kc] : 1.0f; mk = J.mu ? J.mu[kc] : 0.0f; }
    const float* sp = J.src + nc;
#pragma unroll
    for (int u = 0; u < 64; ++u) { const int kr = (k0 + u) < J.K ? k0 + u : J.K - 1; v[u] = __builtin_nontemporal_load(sp + (size_t)kr * J.lds); }
}
__device__ __forceinline__ void conv_store(const ConvJob& J, int tile, const float (&v)[64], float gk, float mk, LAS float* scr, int lane) {
    const int ntn = (J.N + 63) >> 6, kb = tile / ntn, nb = tile % ntn, k0 = kb * 64, n0 = nb * 64;
    float sk = 0.f;
    if (k0 + lane < J.K) { sk = J.cst * gk; if (J.mumode == 1) sk *= mk; else if (J.mumode == 2) sk *= (1.0f - mk); }
#pragma unroll
    for (int u = 0; u < 64; ++u) { const float s = __builtin_bit_cast(float, __builtin_amdgcn_readlane(__builtin_bit_cast(int, sk), u)); scr[u * 65 + lane] = v[u] * s; }
    asm volatile("s_waitcnt lgkmcnt(0)" ::: "memory");
    const int c = lane & 7;
#pragma unroll
    for (int it = 0; it < 8; ++it) { const int n = (lane >> 3) + 8 * it; const LAS float* s = scr + (8 * c) * 65 + n;
        if (n0 + n < J.N && k0 + 8 * c < J.K) { u32x4 o; o.x = cvt_pk_bf16(s[0], s[65]); o.y = cvt_pk_bf16(s[130], s[195]); o.z = cvt_pk_bf16(s[260], s[325]); o.w = cvt_pk_bf16(s[390], s[455]);
            *(u32x4*)(J.dst + (size_t)(n0 + n) * J.ldd + k0 + 8 * c) = o; } }
    asm volatile("s_waitcnt lgkmcnt(0)" ::: "memory");
}
struct ConvIter { int j, t, ntiles, tbase; };
__device__ __forceinline__ bool conv_next(KArgs a, ConvIter& it, ConvJob& J, int& tile, int gw, int NGW) {
    for (;;) {
        if (it.j >= NJOBS) return false;
        if (it.t < it.ntiles) { J = get_job(a, it.j); tile = it.t; it.t += NGW; return true; }
        it.tbase = (it.tbase + it.ntiles) % NGW; ++it.j;
        if (it.j < NJOBS) { const ConvJob Jn = get_job(a, it.j); it.ntiles = ((Jn.K + 63) >> 6) * ((Jn.N + 63) >> 6); int t0 = (gw - it.tbase) % NGW; if (t0 < 0) t0 += NGW; it.t = t0; }
    }
}
__device__ __forceinline__ void rms_row_to_bf16(const float* xrow, bf16_t* orow, int lane) {
    const f32x4* xr = (const f32x4*)xrow + lane; f32x4 v[4]; float s = 0.f;
#pragma unroll
    for (int j = 0; j < 4; ++j) { v[j] = xr[64 * j]; s += (v[j][0] * v[j][0] + v[j][1] * v[j][1]) + (v[j][2] * v[j][2] + v[j][3] * v[j][3]); }
    const float rstd = __builtin_amdgcn_rsqf(wave_sum(s) * (1.0f / D) + NORM_EPS);
    u32x2* o8 = (u32x2*)orow + lane;
#pragma unroll
    for (int j = 0; j < 4; ++j) { u32x2 w; w.x = cvt_pk_bf16(v[j][0] * rstd, v[j][1] * rstd); w.y = cvt_pk_bf16(v[j][2] * rstd, v[j][3] * rstd); o8[64 * j] = w; }
}
__device__ __forceinline__ void prologue_phase(KArgs a, LAS unsigned char* lds, int bid, int nb) {
    const int tid = opaque_tid(), lane = tid & 63, wave = __builtin_amdgcn_readfirstlane(tid >> 6);
    const int gw = bid * 8 + wave, NGW = nb * 8;
    LAS float* scr = (LAS float*)(lds + wave * 16896);
    {   ConvIter it; it.j = 0; it.tbase = 0; { const ConvJob J0 = get_job(a, 0); it.ntiles = ((J0.K + 63) >> 6) * ((J0.N + 63) >> 6); it.t = gw; }
        ConvJob JA, JB, JC; int tA = 0, tB = 0, tC = 0; float vA[64], vB[64], vC[64], gA = 1.f, mA = 0.f, gB = 1.f, mB = 0.f, gC = 1.f, mC = 0.f;
        bool okA = conv_next(a, it, JA, tA, gw, NGW); if (okA) conv_load(JA, tA, vA, gA, mA, lane);
        bool okB = okA && conv_next(a, it, JB, tB, gw, NGW); if (okB) conv_load(JB, tB, vB, gB, mB, lane);
        while (okA) {
            const bool okC = okB && conv_next(a, it, JC, tC, gw, NGW); if (okC) conv_load(JC, tC, vC, gC, mC, lane);
            conv_store(JA, tA, vA, gA, mA, scr, lane);
            okA = okC && conv_next(a, it, JA, tA, gw, NGW); if (okA) conv_load(JA, tA, vA, gA, mA, lane);
            if (!okB) break;
            conv_store(JB, tB, vB, gB, mB, scr, lane);
            okB = okA && conv_next(a, it, JB, tB, gw, NGW); if (okB) conv_load(JB, tB, vB, gB, mB, lane);
            if (!okC) break;
            conv_store(JC, tC, vC, gC, mC, scr, lane);
        }
    }
    { bf16_t* wq = (bf16_t*)(a->ws + WS_WMQ);
      for (int i = bid * 512 + tid; i < 2 * D * D / 4; i += nb * 512) { const int l = i >> 18, k = (i >> 8) & 1023;
          const f32x4 v = *(const f32x4*)(a->in[I_MEMWQ] + (size_t)i * 4) * (a->in[I_NORM_MEM][l * D + k] * (0.0625f * 1.44269504f));
          u32x2 o; o.x = cvt_pk_bf16(v[0], v[1]); o.y = cvt_pk_bf16(v[2], v[3]); *(u32x2*)(wq + (size_t)i * 4) = o; } }
    bf16_t* wr2 = (bf16_t*)(a->ws + WS_RS);
    for (int i = bid * 512 + tid; i < 2 * 256 * 1024; i += nb * 512) { const int l = i >> 18, c = (i >> 10) & 255, k = i & 1023, cc = c & 127;
        float w = 0.f;
        if (cc < 36) w = a->in[I_NORM_FFN][l * D + k] * (cc < 32 ? a->in[I_WRE][((size_t)l * D + k) * 32 + cc] : a->in[I_WRG][((size_t)l * D + k) * 4 + (cc - 32)]);
        const unsigned hi = f2bf(w); const unsigned lo = f2bf(w - __builtin_bit_cast(float, hi << 16));
        wr2[i] = (bf16_t)((c >> 7) ? lo : hi); }
    bf16_t* mn = (bf16_t*)(a->ws + WS_MN);
    for (int r = gw; r < 2048; r += NGW) rms_row_to_bf16(a->in[I_MEM] + (size_t)r * D, mn + (size_t)r * D, lane);
    bf16_t* hp = (bf16_t*)(a->ws + R0);
    { bf16_t* L0 = (bf16_t*)(a->ws + R6); bf16_t* L1 = (bf16_t*)a->out; bf16_t* L2 = (bf16_t*)a->out + (size_t)T * D;
      constexpr int RPW = 32;
      const int e0 = lane * 8, e1 = lane * 8 + 4, e2 = 512 + lane * 8, e3 = 512 + lane * 8 + 4;
      for (int r0 = gw * RPW; r0 < T; r0 += NGW * RPW) {
          f32x4 mu[3][4];
#pragma unroll
          for (int i = 0; i < 3; ++i) { const float* mp = a->in[I_MU] + i * D; mu[i][0] = *(const f32x4*)(mp + e0); mu[i][1] = *(const f32x4*)(mp + e1); mu[i][2] = *(const f32x4*)(mp + e2); mu[i][3] = *(const f32x4*)(mp + e3); }
          f32x4 hprev[4];
          { const int t0 = r0 & (S - 1);
            if (t0 == 0) {
#pragma unroll
                for (int j = 0; j < 4; ++j) hprev[j] = (f32x4){0.f, 0.f, 0.f, 0.f}; }
            else { const float* xr = a->in[I_X] + (size_t)(r0 - 1) * D; float s = 0.f;
                hprev[0] = *(const f32x4*)(xr + e0); hprev[1] = *(const f32x4*)(xr + e1); hprev[2] = *(const f32x4*)(xr + e2); hprev[3] = *(const f32x4*)(xr + e3);
#pragma unroll
                for (int j = 0; j < 4; ++j) s += (hprev[j][0] * hprev[j][0] + hprev[j][1] * hprev[j][1]) + (hprev[j][2] * hprev[j][2] + hprev[j][3] * hprev[j][3]);
                const float rstd = __builtin_amdgcn_rsqf(wave_sum(s) * (1.0f / D) + NORM_EPS);
#pragma unroll
                for (int j = 0; j < 4; ++j) hprev[j] = hprev[j] * rstd; } }
          f32x4 va[4], vb[4];
          { const float* xr = a->in[I_X] + (size_t)r0 * D; va[0] = __builtin_nontemporal_load((const f32x4*)(xr + e0)); va[1] = __builtin_nontemporal_load((const f32x4*)(xr + e1)); va[2] = __builtin_nontemporal_load((const f32x4*)(xr + e2)); va[3] = __builtin_nontemporal_load((const f32x4*)(xr + e3));
            xr += D; vb[0] = __builtin_nontemporal_load((const f32x4*)(xr + e0)); vb[1] = __builtin_nontemporal_load((const f32x4*)(xr + e1)); vb[2] = __builtin_nontemporal_load((const f32x4*)(xr + e2)); vb[3] = __builtin_nontemporal_load((const f32x4*)(xr + e3)); }
#define PRO_ROW(V_, rr_) { const int r = r0 + (rr_), b = r >> 13, t = r & (S - 1); \
              f32x4 v[4]; float s = 0.f; \
              _Pragma("unroll") for (int j = 0; j < 4; ++j) { v[j] = V_[j]; s += (v[j][0] * v[j][0] + v[j][1] * v[j][1]) + (v[j][2] * v[j][2] + v[j][3] * v[j][3]); } \
              { const int rn = ((rr_) + 2 < RPW) ? r + 2 : r; const float* xr = a->in[I_X] + (size_t)rn * D; \
                V_[0] = __builtin_nontemporal_load((const f32x4*)(xr + e0)); V_[1] = __builtin_nontemporal_load((const f32x4*)(xr + e1)); V_[2] = __builtin_nontemporal_load((const f32x4*)(xr + e2)); V_[3] = __builtin_nontemporal_load((const f32x4*)(xr + e3)); } \
              const float rstd = __builtin_amdgcn_rsqf(wave_sum(s) * (1.0f / D) + NORM_EPS); \
              bf16_t* oh = hp + ((size_t)b * (S + 1) + 1 + t) * D + e0; bf16_t* o0 = L0 + (size_t)r * D + e0; bf16_t* o1 = L1 + (size_t)r * D + e0; bf16_t* o2 = L2 + (size_t)r * D + e0; \
              _Pragma("unroll") for (int jh = 0; jh < 2; ++jh) { const f32x4 ha = v[2 * jh] * rstd, hb = v[2 * jh + 1] * rstd, da = hprev[2 * jh] - ha, db = hprev[2 * jh + 1] - hb; \
                  *(u32x4*)(oh + 512 * jh) = pack8(ha, hb); \
                  *(u32x4*)(o0 + 512 * jh) = pack8(ha + da * mu[0][2 * jh], hb + db * mu[0][2 * jh + 1]); \
                  *(u32x4*)(o1 + 512 * jh) = pack8(ha + da * mu[1][2 * jh], hb + db * mu[1][2 * jh + 1]); \
                  *(u32x4*)(o2 + 512 * jh) = pack8(ha + da * mu[2][2 * jh], hb + db * mu[2][2 * jh + 1]); \
                  hprev[2 * jh] = ha; hprev[2 * jh + 1] = hb; } }
#pragma unroll 1
          for (int rr = 0; rr < RPW; rr += 2) { PRO_ROW(va, rr) PRO_ROW(vb, rr + 1) }
#undef PRO_ROW
      } }
    if (gw < NB) { u32x4* z = (u32x4*)(hp + (size_t)gw * (S + 1) * D); z[lane] = (u32x4){0u, 0u, 0u, 0u}; z[64 + lane] = (u32x4){0u, 0u, 0u, 0u}; }
}

namespace rw {
constexpr int RB = 144, SLOT = 64 * RB;
enum { S_AT = 0, S_BT, S_KT, S_RT, S_ATT, S_VT, S_BHT, S_KHT, S_TM, S_APT0, S_APT1, S_AAK, S_XT0, S_TRI, NSLOTS };
constexpr int S_AP0 = S_BT, S_AP1 = S_KT, S_XT1 = S_RT, S_ARB = S_BHT, S_ARK = S_KHT;
constexpr int MISC = NSLOTS * SLOT;
__device__ __forceinline__ int rowmap(int q, int h) { return (q & 3) + 8 * (q >> 2) + 4 * h; }
__device__ __forceinline__ f32x16 zero16() { f32x16 z;
#pragma unroll
    for (int i = 0; i < 16; ++i) z[i] = 0.f;
    return z; }
__device__ __forceinline__ bf16x8 tr_frag(const LAS unsigned char* T, int row0, int ks, int r, int h) {
    const int q = (r & 15) >> 2, p = r & 3, blk = (r >> 4) & 1, sw = (q >> 1) & 1;
    const LAS unsigned char* a0 = T + (16 * ks + 8 * h + q) * 128 + ((((row0 >> 5) ^ sw) * 4 + 2 * blk + (p >> 1)) << 4) + 8 * (p & 1);
    return __builtin_shufflevector(__builtin_amdgcn_ds_read_tr16_b64_v4i16((LAS s16x4*)a0), __builtin_amdgcn_ds_read_tr16_b64_v4i16((LAS s16x4*)(a0 + 4 * 128)), 0, 1, 2, 3, 4, 5, 6, 7); }
template <bool SX = false, bool SY = false>
__device__ __forceinline__ f32x16 mm(f32x16 acc, const LAS unsigned char* X, int xrow0, const LAS unsigned char* Yt, int yrow0, int r, int h, int nks) {
#pragma unroll
    for (int ks = 0; ks < 4; ++ks) if (ks < nks) {
        const bf16x8 a = SX ? tr_frag(X, xrow0, ks, r, h) : *(const LAS bf16x8*)(X + (xrow0 + r) * RB + (16 * ks + 8 * h) * 2);
        const bf16x8 b = SY ? tr_frag(Yt, yrow0, ks, r, h) : *(const LAS bf16x8*)(Yt + (yrow0 + r) * RB + (16 * ks + 8 * h) * 2);
        acc = __builtin_amdgcn_mfma_f32_32x32x16_bf16(a, b, acc, 0, 0, 0); }
    return acc; }
__device__ __forceinline__ void write_T(LAS unsigned char* buf, int col0, int row0, const f32x16& acc, int r, int h) {
#pragma unroll
    for (int m = 0; m < 4; ++m) { u32x2 w; w.x = cvt_pk_c(acc[4 * m], acc[4 * m + 1]); w.y = cvt_pk_c(acc[4 * m + 2], acc[4 * m + 3]);
        *(LAS u32x2*)(buf + (col0 + r) * RB + (row0 + 8 * m + 4 * h) * 2) = w; } }
__device__ __forceinline__ void write_R(LAS unsigned char* buf, int row0, int col0, const f32x16& acc, int r, int h) {
#pragma unroll
    for (int q = 0; q < 16; q += 2) { const unsigned p = cvt_pk_c(acc[q], acc[q + 1]);
        *(LAS unsigned short*)(buf + (row0 + rowmap(q, h)) * RB + (col0 + r) * 2) = (unsigned short)p; *(LAS unsigned short*)(buf + (row0 + rowmap(q + 1, h)) * RB + (col0 + r) * 2) = (unsigned short)(p >> 16); } }
__device__ __forceinline__ void zero_tile(LAS unsigned char* buf, int row0, int col0, int lane) {
#pragma unroll
    for (int i = 0; i < 4; ++i) { const int idx = i * 64 + lane, row = idx >> 3, ch = idx & 7; *(LAS u32x2*)(buf + (row0 + row) * RB + col0 * 2 + ch * 8) = (u32x2){0u, 0u}; } }

#define RW_P8(v_, s_) pack8c(v_[8 * (s_)], v_[8 * (s_) + 1], v_[8 * (s_) + 2], v_[8 * (s_) + 3], v_[8 * (s_) + 4], v_[8 * (s_) + 5], v_[8 * (s_) + 6], v_[8 * (s_) + 7])
__device__ __forceinline__ void inv32(const f32x16 A, const f32x16 AT, f32x16& Tt, f32x16& TtT, int r, int h) {
    f32x16 X = A, Y = AT; Tt = A; TtT = AT;
#pragma unroll
    for (int q = 0; q < 16; ++q) if (rowmap(q, h) == r) { Tt[q] += 1.0f; TtT[q] += 1.0f; }
#pragma unroll
    for (int k = 0; k < 4; ++k) {
        const bf16x8 x0 = RW_P8(X, 0), x1 = RW_P8(X, 1), y0 = RW_P8(Y, 0), y1 = RW_P8(Y, 1);
        f32x16 Sx = zero16(), Sy = zero16();
        Sx = __builtin_amdgcn_mfma_f32_32x32x16_bf16(y0, x0, Sx, 0, 0, 0); if (k < 3) Sy = __builtin_amdgcn_mfma_f32_32x32x16_bf16(x0, y0, Sy, 0, 0, 0);
        Sx = __builtin_amdgcn_mfma_f32_32x32x16_bf16(y1, x1, Sx, 0, 0, 0); if (k < 3) Sy = __builtin_amdgcn_mfma_f32_32x32x16_bf16(x1, y1, Sy, 0, 0, 0);
        const bf16x8 s0 = RW_P8(Sx, 0), s1 = RW_P8(Sx, 1), t0 = RW_P8(TtT, 0), t1 = RW_P8(TtT, 1);
        Tt = __builtin_amdgcn_mfma_f32_32x32x16_bf16(t0, s0, Tt, 0, 0, 0); TtT = __builtin_amdgcn_mfma_f32_32x32x16_bf16(s0, t0, TtT, 0, 0, 0);
        Tt = __builtin_amdgcn_mfma_f32_32x32x16_bf16(t1, s1, Tt, 0, 0, 0); TtT = __builtin_amdgcn_mfma_f32_32x32x16_bf16(s1, t1, TtT, 0, 0, 0);
        X = Sx; Y = Sy;
    }
}
__device__ __forceinline__ void tri_init(LAS unsigned char* lds, int tid) {
    const int row = tid >> 3, kb = (tid & 7) * 8; u32x4 v; unsigned ww[4];
#pragma unroll
    for (int q = 0; q < 4; ++q) ww[q] = ((kb + 2 * q <= row) ? 0x3F80u : 0u) | ((kb + 2 * q + 1 <= row) ? 0x3F800000u : 0u);
    v.x = ww[0]; v.y = ww[1]; v.z = ww[2]; v.w = ww[3]; *(LAS u32x4*)(lds + S_TRI * SLOT + row * RB + kb * 2) = v; }
struct Raw { u32x4 r, k, v, e, a; };
template <bool NEED_R>
__device__ __forceinline__ void raw_load(KArgs a, Raw& R, int item, int tid) {
    const int lane = tid & 63, w = __builtin_amdgcn_readfirstlane(tid >> 6); const int bh = item >> 7, c = item & 127, b = bh >> 4, hd = bh & 15;
    const size_t g0 = ((size_t)b * S + c * 64 + 8 * w) * D + hd * 64;
    const unsigned o = (unsigned)((lane >> 3) * D + (lane & 7) * 8);
    if (NEED_R) R.r = *(const u32x4*)((const bf16_t*)(a->ws + R1) + g0 + o);
    R.k = *(const u32x4*)((const bf16_t*)(a->ws + R2) + g0 + o); R.v = *(const u32x4*)((const bf16_t*)(a->ws + R3) + g0 + o);
    R.e = *(const u32x4*)((const bf16_t*)(a->ws + R4) + g0 + o); R.a = *(const u32x4*)((const bf16_t*)a->out + g0 + o); }
__device__ __forceinline__ void unpack8(const u32x4 w, float (&f)[8]) { f[0] = bf_lo(w.x); f[1] = bf_hi(w.x); f[2] = bf_lo(w.y); f[3] = bf_hi(w.y); f[4] = bf_lo(w.z); f[5] = bf_hi(w.z); f[6] = bf_lo(w.w); f[7] = bf_hi(w.w); }
__device__ __forceinline__ void store_tm(LAS unsigned char* p, const float (&f)[8]) {
    u32x2 lo, hi; lo.x = cvt_pk_c(f[0], f[1]); lo.y = cvt_pk_c(f[2], f[3]); hi.x = cvt_pk_c(f[4], f[5]); hi.y = cvt_pk_c(f[6], f[7]);
    *(LAS u32x2*)p = lo; *(LAS u32x2*)(p + 16) = hi; }
template <bool STAGE_C>
__device__ __forceinline__ void chunk_front(KArgs a, LAS unsigned char* lds, int b, int hd, int c, int tid, Raw& RW, int next_item, u32x4& vraw) {
    const int lane = tid & 63, w = __builtin_amdgcn_readfirstlane(tid >> 6), r = lane & 31, h = lane >> 5;
    LAS float* WLf = (LAS float*)(lds + MISC); LAS float* bon = WLf + 64;
    LAS float* CL = (LAS float*)(lds + S_APT0 * SLOT); constexpr int CS = 68;
    LAS unsigned char* LWT = lds + S_XT0 * SLOT;
    {
        const int tq = lane >> 3, cg = lane & 7, tk = 8 * w + tq, ch = hd * 64 + cg * 8;
        const f32x4 kc0 = *(const f32x4*)(a->in[I_KK] + ch), kc1 = *(const f32x4*)(a->in[I_KK] + ch + 4), ac0 = *(const f32x4*)(a->in[I_KA] + ch), ac1 = *(const f32x4*)(a->in[I_KA] + ch + 4);
        f32x4 rc0 = {0.f, 0.f, 0.f, 0.f}, rc1 = rc0; if (STAGE_C) { rc0 = *(const f32x4*)(a->in[I_RK] + ch); rc1 = *(const f32x4*)(a->in[I_RK] + ch + 4); }
        u32x4 rr, kr4, vr, er, ar;
        if (STAGE_C) { rr.x = pin_u32(RW.r.x); rr.y = pin_u32(RW.r.y); rr.z = pin_u32(RW.r.z); rr.w = pin_u32(RW.r.w); } else rr = (u32x4){0u, 0u, 0u, 0u};
        kr4.x = pin_u32(RW.k.x); kr4.y = pin_u32(RW.k.y); kr4.z = pin_u32(RW.k.z); kr4.w = pin_u32(RW.k.w);
        vr.x = pin_u32(RW.v.x); vr.y = pin_u32(RW.v.y); vr.z = pin_u32(RW.v.z); vr.w = pin_u32(RW.v.w); er.x = pin_u32(RW.e.x); er.y = pin_u32(RW.e.y); er.z = pin_u32(RW.e.z); er.w = pin_u32(RW.e.w);
        ar.x = pin_u32(RW.a.x); ar.y = pin_u32(RW.a.y); ar.z = pin_u32(RW.a.z); ar.w = pin_u32(RW.a.w);
        vraw = vr;
        raw_load<STAGE_C>(a, RW, next_item >= 0 ? next_item : ((b << 4) + hd) * 128 + c, tid);
        const int cmo = tk * 128 + ((cg ^ (((tq >> 1) & 1) << 2)) << 4);
        *(LAS u32x4*)(LWT + cmo) = er;
        *(LAS u32x4*)(lds + S_VT * SLOT + cmo) = vr;
        lds_barrier();
        if (w < 4) { const int ti = w >> 1, cj = w & 1; f32x16 acc = zero16(); acc = mm<false, true>(acc, lds + S_TRI * SLOT, 32 * ti, LWT, 32 * cj, r, h, ti ? 4 : 2);
#pragma unroll
            for (int q = 0; q < 16; ++q) CL[(32 * ti + rowmap(q, h)) * CS + 32 * cj + r] = acc[q]; }
        float rv[8], kv[8], lw[8], lr[8], kk[8], kp[8];
        unpack8(rr, rv); unpack8(kr4, kv); unpack8(er, lw); unpack8(ar, lr);
        { const float kkc[8] = {kc0[0], kc0[1], kc0[2], kc0[3], kc1[0], kc1[1], kc1[2], kc1[3]}, kac[8] = {ac0[0], ac0[1], ac0[2], ac0[3], ac1[0], ac1[1], ac1[2], ac1[3]};
          float ss = 0.f;
#pragma unroll
          for (int j = 0; j < 8; ++j) { kk[j] = kv[j] * kkc[j]; ss += kk[j] * kk[j]; kp[j] = kv[j] * (1.0f + (lr[j] - 1.0f) * kac[j]); }
          const float rn = __builtin_amdgcn_rsqf(fmaxf(sum8(ss), 1e-24f));
#pragma unroll
          for (int j = 0; j < 8; ++j) kk[j] *= rn;
          if (STAGE_C) { const float rkc[8] = {rc0[0], rc0[1], rc0[2], rc0[3], rc1[0], rc1[1], rc1[2], rc1[3]};
              float bs = 0.f;
#pragma unroll
              for (int j = 0; j < 8; ++j) bs += rv[j] * kp[j] * rkc[j];
              bs = sum8(bs); if (cg == 0) bon[tk] = bs; } }
        lds_barrier();
        const f32x4 c10 = *(const LAS f32x4*)(CL + tk * CS + cg * 8), c11 = *(const LAS f32x4*)(CL + tk * CS + cg * 8 + 4), ct0 = *(const LAS f32x4*)(CL + 63 * CS + cg * 8), ct1 = *(const LAS f32x4*)(CL + 63 * CS + cg * 8 + 4);
        const float c1[8] = {c10[0], c10[1], c10[2], c10[3], c11[0], c11[1], c11[2], c11[3]}, ct[8] = {ct0[0], ct0[1], ct0[2], ct0[3], ct1[0], ct1[1], ct1[2], ct1[3]};
        if (!STAGE_C && tk == 63) {
            f32x4 w0, w1;
#pragma unroll
            for (int j = 0; j < 4; ++j) { w0[j] = __builtin_amdgcn_exp2f(1.44269504f * ct[j]); w1[j] = __builtin_amdgcn_exp2f(1.44269504f * ct[4 + j]); }
            *(LAS f32x4*)(WLf + cg * 8) = w0; *(LAS f32x4*)(WLf + cg * 8 + 4) = w1; }
        float at[8], bt[8], kt[8], rt[8], bh[8], kh[8];
#pragma unroll
        for (int j = 0; j < 8; ++j) { const float c0 = c1[j] - lw[j]; const float ep = __builtin_amdgcn_exp2f(1.44269504f * c1[j]), em = __builtin_amdgcn_rcpf(ep);
            at[j] = -kk[j] * __builtin_amdgcn_exp2f(1.44269504f * c0); const float kl = kk[j] * lr[j]; bt[j] = kl * em; kt[j] = kp[j] * em; rt[j] = rv[j] * ep;
            if (!STAGE_C) { const float ew = __builtin_amdgcn_exp2f(1.44269504f * (ct[j] - c1[j])); bh[j] = kl * ew; kh[j] = kp[j] * ew; } }
        { const int tmo = tk * RB + (32 * (cg >> 1) + 8 * (cg & 1));
          store_tm(lds + S_AT * SLOT + tmo, at); store_tm(lds + S_BT * SLOT + tmo, bt); store_tm(lds + S_KT * SLOT + tmo, kt); if (STAGE_C) store_tm(lds + S_RT * SLOT + tmo, rt); }
        if (!STAGE_C) { *(LAS u32x4*)(lds + S_ATT * SLOT + cmo) = __builtin_bit_cast(u32x4, pack8c(at[0], at[1], at[2], at[3], at[4], at[5], at[6], at[7]));
            *(LAS u32x4*)(lds + S_BHT * SLOT + cmo) = __builtin_bit_cast(u32x4, pack8c(bh[0], bh[1], bh[2], bh[3], bh[4], bh[5], bh[6], bh[7]));
            *(LAS u32x4*)(lds + S_KHT * SLOT + cmo) = __builtin_bit_cast(u32x4, pack8c(kh[0], kh[1], kh[2], kh[3], kh[4], kh[5], kh[6], kh[7])); }
    }
    lds_barrier();
    if (w < 2) { f32x16 A = zero16(), AT = zero16(); A = mm(A, lds + S_AT * SLOT, 32 * w, lds + S_BT * SLOT, 32 * w, r, h, 4); AT = mm(AT, lds + S_BT * SLOT, 32 * w, lds + S_AT * SLOT, 32 * w, r, h, 4);
#pragma unroll
        for (int q = 0; q < 16; ++q) { A[q] = (rowmap(q, h) > r) ? A[q] : 0.f; AT[q] = (rowmap(q, h) < r) ? AT[q] : 0.f; }
        f32x16 Ti, TiT; inv32(A, AT, Ti, TiT, r, h);
        write_T(lds + S_TM * SLOT, 32 * w, 32 * w, TiT, r, h);
        if (w == 0) write_T(lds + S_APT1 * SLOT + 32 * RB, 0, 0, Ti, r, h); }
    else if (w == 2) { f32x16 A = zero16(); A = mm(A, lds + S_AT * SLOT, 32, lds + S_BT * SLOT, 0, r, h, 4); write_R(lds + S_APT1 * SLOT, 0, 0, A, r, h); }
    else if (w < 6) { const int ti = (w == 3) ? 0 : 1, tj = (w == 5) ? 1 : 0; f32x16 x = zero16(); x = mm(x, lds + S_AT * SLOT, 32 * ti, lds + S_KT * SLOT, 32 * tj, r, h, 4);
#pragma unroll
        for (int q = 0; q < 16; ++q) { const bool keep = (ti != tj) || (rowmap(q, h) > r); x[q] = keep ? x[q] : 0.f; }
        write_R(lds + S_AAK * SLOT, 32 * ti, 32 * tj, x, r, h); }
    else if (w == 6) { zero_tile(lds + S_AAK * SLOT, 0, 32, lane); zero_tile(lds + S_TM * SLOT, 0, 32, lane); }
    if (STAGE_C && w >= 2) {
        const int t6 = w - 2, t3 = t6 % 3, ti = t3 == 0 ? 0 : 1, tj = t3 == 2 ? 1 : 0; const bool isk = t6 >= 3;
        f32x16 x = zero16(); x = mm(x, lds + S_RT * SLOT, 32 * ti, lds + (isk ? S_KT : S_BT) * SLOT, 32 * tj, r, h, 4);
#pragma unroll
        for (int q = 0; q < 16; ++q) { const bool keep = (ti != tj) || (rowmap(q, h) >= r); x[q] = keep ? x[q] : 0.f; }
        write_R(lds + (isk ? S_ARK : S_ARB) * SLOT, 32 * ti, 32 * tj, x, r, h);
        if (w == 7) { zero_tile(lds + S_ARB * SLOT, 0, 32, lane); zero_tile(lds + S_ARK * SLOT, 0, 32, lane); } }
    lds_barrier();
}
__device__ __forceinline__ void t10_step(LAS unsigned char* lds, int r, int h) {
    f32x16 X = zero16(); X = mm(X, lds + S_APT1 * SLOT, 0, lds + S_APT1 * SLOT + 32 * RB, 0, r, h, 2);
    f32x16 T10 = zero16();
#pragma unroll
    for (int s2 = 0; s2 < 2; ++s2) { const LAS unsigned char* p = lds + S_TM * SLOT + (32 + r) * RB + (32 + 16 * s2 + 4 * h) * 2; const u32x2 lo = *(const LAS u32x2*)p, hi = *(const LAS u32x2*)(p + 16);
        u32x4 aw; aw.x = lo.x; aw.y = lo.y; aw.z = hi.x; aw.w = hi.y;
        const bf16x8 bfr = s2 == 0 ? pack8c(X[0], X[1], X[2], X[3], X[4], X[5], X[6], X[7]) : pack8c(X[8], X[9], X[10], X[11], X[12], X[13], X[14], X[15]);
        T10 = __builtin_amdgcn_mfma_f32_32x32x16_bf16(__builtin_bit_cast(bf16x8, aw), bfr, T10, 0, 0, 0); }
    write_R(lds + S_TM * SLOT, 32, 0, T10, r, h);
}

__device__ __forceinline__ void stage_a(KArgs a, LAS unsigned char* lds, int bid, int nb) {
    const int tid = opaque_tid(), lane = tid & 63, w = __builtin_amdgcn_readfirstlane(tid >> 6), r = lane & 31, h = lane >> 5;
    unsigned char* MF = a->ws + R6; unsigned char* GF = a->ws + R0;
    const LAS float* WLf = (const LAS float*)(lds + MISC);
    const int per = (NB * 16 * 128 + nb - 1) / nb, item0 = bid * per, item1 = (item0 + per < NB * 16 * 128) ? item0 + per : NB * 16 * 128;
    Raw RW; if (item0 < item1) raw_load<false>(a, RW, item0, tid);
    tri_init(lds, tid);
    for (int item = item0; item < item1; ++item) {
        const int bh = item >> 7, c = item & 127, b = bh >> 4, hd = bh & 15;
        lds_barrier();
        u32x4 vdummy; chunk_front<false>(a, lds, b, hd, c, tid, RW, (item + 1 < item1) ? item + 1 : -1, vdummy);
        const int ti = (w >> 1) & 1, tj = w & 1;
        if (w == 2) t10_step(lds, r, h);
        else if (w >= 4) { f32x16 x = zero16(); x = mm<false, true>(x, lds + S_AAK * SLOT, 32 * ti, lds + S_VT * SLOT, 32 * tj, r, h, 4); write_T(lds + S_XT1 * SLOT, 32 * tj, 32 * ti, x, r, h); }
        lds_barrier();
        if (w < 4) { f32x16 p = zero16(); p = mm<false, true>(p, lds + S_TM * SLOT, 32 * ti, lds + S_ATT * SLOT, 32 * tj, r, h, 4); write_T(lds + S_XT0 * SLOT, 32 * tj, 32 * ti, p, r, h); }
        else { f32x16 q2 = zero16(); q2 = mm(q2, lds + S_TM * SLOT, 32 * ti, lds + S_XT1 * SLOT, 32 * tj, r, h, 4); write_T(lds + S_APT0 * SLOT, 32 * tj, 32 * ti, q2, r, h); }
        lds_barrier();
        f32x16 res = zero16();
        if (w < 4) { res = mm<false, true>(res, lds + S_XT0 * SLOT, 32 * ti, lds + S_BHT * SLOT, 32 * tj, r, h, 4);
            if (ti == tj) {
#pragma unroll
                for (int q = 0; q < 16; ++q) if (rowmap(q, h) == r) res[q] += WLf[32 * ti + r]; } }
        else { res = mm<true, false>(res, lds + S_BHT * SLOT, 32 * ti, lds + S_APT0 * SLOT, 32 * tj, r, h, 4); res = mm<true, true>(res, lds + S_KHT * SLOT, 32 * ti, lds + S_VT * SLOT, 32 * tj, r, h, 4); }
        { unsigned char* d0 = (w < 4) ? MF + (size_t)item * 8192 + (tj * 4 + 2 * ti) * 1024 + lane * 16 : GF + (size_t)item * 8192 + (tj * 2 + ti) * 2048 + lane * 16;
          unsigned char* d1 = d0 + 1024;
          { *(u32x4*)d0 = __builtin_bit_cast(u32x4, pack8c(res[0], res[1], res[2], res[3], res[4], res[5], res[6], res[7]));
                         *(u32x4*)d1 = __builtin_bit_cast(u32x4, pack8c(res[8], res[9], res[10], res[11], res[12], res[13], res[14], res[15])); } }
    }
    __syncthreads();
}

__device__ __forceinline__ void stage_b(KArgs a, LAS unsigned char* lds, int bh) {
    const int tid = opaque_tid(), lane = tid & 63, w = __builtin_amdgcn_readfirstlane(tid >> 6);
    constexpr int DD = 7, NS = 9, NSTEP = 128;
    const unsigned char* MF = a->ws + R6 + (size_t)bh * NSTEP * 8192; unsigned char* GF = a->ws + R0 + (size_t)bh * NSTEP * 8192;
    f32x16 H0 = zero16(), H1 = zero16();
#define RW_ISSUE(step_) do { const int step__ = (step_); const int st = step__ < NSTEP ? step__ : NSTEP - 1; LAS unsigned char* slot = lds + (step__ % NS) * 16384; \
        _Pragma("unroll") for (int p = 0; p < 4; ++p) { const int pc = (w - 4) * 4 + p; const unsigned char* src = (pc < 8 ? MF + (size_t)st * 8192 + pc * 1024 : GF + (size_t)st * 8192 + (pc - 8) * 1024) + lane * 16; \
            __builtin_amdgcn_global_load_lds((const unsigned*)src, (LAS unsigned*)(slot + pc * 1024), 16, 0, 0); } } while (0)
    if (w >= 4) {
#pragma unroll 1
        for (int s0 = 0; s0 < DD; ++s0) RW_ISSUE(s0); }
#pragma unroll 1
    for (int c = 0; c < NSTEP; ++c) {
        if (w >= 4) { RW_ISSUE(c + DD); asm volatile("s_waitcnt vmcnt(28)" ::: "memory"); }
        __builtin_amdgcn_s_barrier(); asm volatile("" ::: "memory");
        if (w < 2) {
            const LAS unsigned char* slot = lds + (c % NS) * 16384;
            bf16x8 f[4];
            f[0] = pack8c(H0[0], H0[1], H0[2], H0[3], H0[4], H0[5], H0[6], H0[7]); f[1] = pack8c(H0[8], H0[9], H0[10], H0[11], H0[12], H0[13], H0[14], H0[15]);
            f[2] = pack8c(H1[0], H1[1], H1[2], H1[3], H1[4], H1[5], H1[6], H1[7]); f[3] = pack8c(H1[8], H1[9], H1[10], H1[11], H1[12], H1[13], H1[14], H1[15]);
            const u32x4 g00 = *(const LAS u32x4*)(slot + 8192 + (w * 2 + 0) * 2048 + lane * 16), g01 = *(const LAS u32x4*)(slot + 8192 + (w * 2 + 0) * 2048 + 1024 + lane * 16);
            const u32x4 g10 = *(const LAS u32x4*)(slot + 8192 + (w * 2 + 1) * 2048 + lane * 16), g11 = *(const LAS u32x4*)(slot + 8192 + (w * 2 + 1) * 2048 + 1024 + lane * 16);
            f32x16 n0, n1;
            { const unsigned ww[8] = {g00.x, g00.y, g00.z, g00.w, g01.x, g01.y, g01.z, g01.w};
#pragma unroll
              for (int q = 0; q < 8; ++q) { n0[2 * q] = bf_lo(ww[q]); n0[2 * q + 1] = bf_hi(ww[q]); } }
            { const unsigned ww[8] = {g10.x, g10.y, g10.z, g10.w, g11.x, g11.y, g11.z, g11.w};
#pragma unroll
              for (int q = 0; q < 8; ++q) { n1[2 * q] = bf_lo(ww[q]); n1[2 * q + 1] = bf_hi(ww[q]); } }
#pragma unroll
            for (int ks = 0; ks < 4; ++ks) { n0 = __builtin_amdgcn_mfma_f32_32x32x16_bf16(*(const LAS bf16x8*)(slot + (0 * 4 + ks) * 1024 + lane * 16), f[ks], n0, 0, 0, 0);
                                             n1 = __builtin_amdgcn_mfma_f32_32x32x16_bf16(*(const LAS bf16x8*)(slot + (1 * 4 + ks) * 1024 + lane * 16), f[ks], n1, 0, 0, 0); }
            unsigned char* hdst = GF + (size_t)c * 8192;
#pragma unroll
            for (int ks = 0; ks < 4; ++ks) *(u32x4*)(hdst + ((w * 4 + ks) * 64 + lane) * 16) = __builtin_bit_cast(u32x4, f[ks]);
            H0 = n0; H1 = n1;
        }
    }
    asm volatile("s_waitcnt vmcnt(0)" ::: "memory");
    lds_barrier();
}

__device__ __forceinline__ void stage_c(KArgs a, LAS unsigned char* lds, int bid, int nb) {
    const int tid = opaque_tid(), lane = tid & 63, w = __builtin_amdgcn_readfirstlane(tid >> 6), r = lane & 31, h = lane >> 5;
    const unsigned char* HF = a->ws + R0; bf16_t* Yg = (bf16_t*)(a->ws + R6);
    const bf16_t* Vg = (const bf16_t*)(a->ws + R3); const bf16_t* Gg = (const bf16_t*)a->out + (size_t)T * D;
    const LAS float* bon = (const LAS float*)(lds + MISC) + 64;
    LAS float* yb = (LAS float*)(lds + S_AP0 * SLOT); constexpr int YS = 68;
    const int per = (NB * 16 * 128 + nb - 1) / nb, item0 = bid * per, item1 = (item0 + per < NB * 16 * 128) ? item0 + per : NB * 16 * 128;
    Raw RW; if (item0 < item1) raw_load<true>(a, RW, item0, tid);
    tri_init(lds, tid);
    for (int item = item0; item < item1; ++item) {
        const int bh = item >> 7, c = item & 127, b = bh >> 4, hd = bh & 15;
        lds_barrier();
        const int ptk = 8 * w + (lane >> 3), pcg = lane & 7;
        const size_t po = ((size_t)b * S + c * 64 + ptk) * D + hd * 64 + pcg * 8;
        const u32x4 pgv = *(const u32x4*)(Gg + po);
        const int ytile = w - 4, rtile = (w == 0) ? 0 : (w == 1) ? 1 : (w == 3) ? 2 : (w == 5) ? 3 : -1;
        const int tjw = (w >= 4) ? (w & 1) : (w == 1 ? 1 : 0);
        bf16x8 hf[4];
        { const unsigned char* hsrc = HF + (size_t)item * 8192;
#pragma unroll
          for (int ks = 0; ks < 4; ++ks) hf[ks] = *(const bf16x8*)(hsrc + ((tjw * 4 + ks) * 64 + lane) * 16); }
        const int pch = hd * 64 + pcg * 8;
        const f32x4 g0 = *(const f32x4*)(a->in[I_LNG] + pch), g1 = *(const f32x4*)(a->in[I_LNG] + pch + 4), b0 = *(const f32x4*)(a->in[I_LNB] + pch), b1 = *(const f32x4*)(a->in[I_LNB] + pch + 4);
        u32x4 pvv; chunk_front<true>(a, lds, b, hd, c, tid, RW, (item + 1 < item1) ? item + 1 : -1, pvv);
        f32x16 y = zero16();
        if (w == 2) t10_step(lds, r, h);
        if (w >= 4) { const int ti = (ytile >> 1) & 1;
#pragma unroll
            for (int ks = 0; ks < 4; ++ks) y = __builtin_amdgcn_mfma_f32_32x32x16_bf16(*(const LAS bf16x8*)(lds + S_RT * SLOT + (32 * ti + r) * RB + (16 * ks + 8 * h) * 2), hf[ks], y, 0, 0, 0);
            y = mm<false, true>(y, lds + S_ARK * SLOT, 32 * ti, lds + S_VT * SLOT, 32 * tjw, r, h, 4); }
        if (rtile >= 0) { const int ti = (rtile >> 1) & 1; f32x16 x = zero16();
#pragma unroll
            for (int ks = 0; ks < 4; ++ks) x = __builtin_amdgcn_mfma_f32_32x32x16_bf16(*(const LAS bf16x8*)(lds + S_AT * SLOT + (32 * ti + r) * RB + (16 * ks + 8 * h) * 2), hf[ks], x, 0, 0, 0);
            x = mm<false, true>(x, lds + S_AAK * SLOT, 32 * ti, lds + S_VT * SLOT, 32 * tjw, r, h, 4);
            write_T(lds + S_XT0 * SLOT, 32 * tjw, 32 * ti, x, r, h); }
        lds_barrier();
        if (w < 4) { const int ti = (w >> 1) & 1, tj = w & 1; f32x16 u = zero16(); u = mm(u, lds + S_TM * SLOT, 32 * ti, lds + S_XT0 * SLOT, 32 * tj, r, h, 4); write_T(lds + S_APT0 * SLOT, 32 * tj, 32 * ti, u, r, h); }
        lds_barrier();
        if (w >= 4) { const int ti = (ytile >> 1) & 1; y = mm(y, lds + S_ARB * SLOT, 32 * ti, lds + S_APT0 * SLOT, 32 * tjw, r, h, 4);
#pragma unroll
            for (int q = 0; q < 16; ++q) yb[(32 * ti + rowmap(q, h)) * YS + 32 * tjw + r] = y[q]; }
        lds_barrier();
        {
            const f32x4 y0 = *(const LAS f32x4*)(yb + ptk * YS + pcg * 8), y1 = *(const LAS f32x4*)(yb + ptk * YS + pcg * 8 + 4);
            const float mean = sum8(((y0[0] + y0[1]) + (y0[2] + y0[3])) + ((y1[0] + y1[1]) + (y1[2] + y1[3]))) * (1.0f / 64.0f);
            const f32x4 d0 = y0 - mean, d1 = y1 - mean;
            const float var = sum8(((d0[0] * d0[0] + d0[1] * d0[1]) + (d0[2] * d0[2] + d0[3] * d0[3])) + ((d1[0] * d1[0] + d1[1] * d1[1]) + (d1[2] * d1[2] + d1[3] * d1[3]))) * (1.0f / 64.0f);
            const float rs = __builtin_amdgcn_rsqf(var + 64e-5f), bn = bon[ptk];
            const f32x4 v0 = (f32x4){bf_lo(pvv.x), bf_hi(pvv.x), bf_lo(pvv.y), bf_hi(pvv.y)}, v1 = (f32x4){bf_lo(pvv.z), bf_hi(pvv.z), bf_lo(pvv.w), bf_hi(pvv.w)};
            const f32x4 q0 = (f32x4){bf_lo(pgv.x), bf_hi(pgv.x), bf_lo(pgv.y), bf_hi(pgv.y)}, q1 = (f32x4){bf_lo(pgv.z), bf_hi(pgv.z), bf_lo(pgv.w), bf_hi(pgv.w)};
            const f32x4 o0 = ((d0 * rs) * g0 + b0 + v0 * bn) * q0, o1 = ((d1 * rs) * g1 + b1 + v1 * bn) * q1;
            *(u32x4*)(Yg + po) = pack8(o0, o1);
        }
    }
    __syncthreads();
}
}

template <bool DIAG>
__device__ __forceinline__ void sb_block(const f32x16& s, const bf16x8 (&tri)[2], float R, int r, int hh, bf16x8& pb0, bf16x8& pb1, float& tsum) {
    f32x2 X2[8], zr2[8], ts2 = {0.f, 0.f};
#pragma unroll
    for (int qp = 0; qp < 8; ++qp) { const int q0 = 2 * qp, q1 = q0 + 1; const f32x2 z2 = {s[q0], s[q1]};
        const f32x2 e2 = {__builtin_amdgcn_exp2f(-fabsf(z2.x)), __builtin_amdgcn_exp2f(-fabsf(z2.y))};
        const f32x2 u2 = e2 + 1.0f;
        const f32x2 l2 = {__builtin_amdgcn_logf(u2.x), __builtin_amdgcn_logf(u2.y)}, m2 = {fmaxf(z2.x, 0.f), fmaxf(z2.y, 0.f)};
        const f32x2 sp2 = m2 + l2;
        f32x2 x2 = -sp2;
        if (DIAG) { const int k0 = (q0 & 3) + 8 * (q0 >> 2) + 4 * hh, k1 = (q1 & 3) + 8 * (q1 >> 2) + 4 * hh; x2.x = (k0 < r) ? x2.x : 0.f; x2.y = (k1 < r) ? x2.y : 0.f; }
        X2[qp] = x2; ts2 += x2; zr2[qp] = (z2 - sp2) + R; }
    tsum = ts2.x + ts2.y;
    const bf16x8 xb0 = pack8c(X2[0].x, X2[0].y, X2[1].x, X2[1].y, X2[2].x, X2[2].y, X2[3].x, X2[3].y), xb1 = pack8c(X2[4].x, X2[4].y, X2[5].x, X2[5].y, X2[6].x, X2[6].y, X2[7].x, X2[7].y);
    f32x16 c = rw::zero16();
    c = __builtin_amdgcn_mfma_f32_32x32x16_bf16(tri[0], xb0, c, 0, 0, 0); c = __builtin_amdgcn_mfma_f32_32x32x16_bf16(tri[1], xb1, c, 0, 0, 0);
    float P[16];
#pragma unroll
    for (int qp = 0; qp < 8; ++qp) { const int q0 = 2 * qp, q1 = q0 + 1; const f32x2 a2 = zr2[qp] + (f32x2){c[q0], c[q1]};
        float p0 = __builtin_amdgcn_exp2f(a2.x), p1 = __builtin_amdgcn_exp2f(a2.y);
        if (DIAG) { const int k0 = (q0 & 3) + 8 * (q0 >> 2) + 4 * hh, k1 = (q1 & 3) + 8 * (q1 >> 2) + 4 * hh; p0 = (k0 < r) ? p0 : 0.f; p1 = (k1 < r) ? p1 : 0.f; }
        P[q0] = p0; P[q1] = p1; }
    pb0 = pack8c(P[0], P[1], P[2], P[3], P[4], P[5], P[6], P[7]); pb1 = pack8c(P[8], P[9], P[10], P[11], P[12], P[13], P[14], P[15]);
}
__device__ __forceinline__ void sbattn_phase(KArgs a, LAS unsigned char* lds, int bid, int nb) {
    const int tid = opaque_tid(), lane = tid & 63, w = __builtin_amdgcn_readfirstlane(tid >> 6), r = lane & 31, hh = lane >> 5;
    constexpr int NR = 10, KROWB = 144, KBLK = 32 * KROWB, VROWB = 192, VBLK = 32 * VROWB;
    LAS unsigned char* Kr = lds; LAS unsigned char* Vr = lds + NR * KBLK; LAS unsigned char* Ost = Vr + NR * VBLK; volatile LAS int* flag = (volatile LAS int*)(Ost + 8 * 4608);
    const bf16_t* Kg = (const bf16_t*)(a->ws + R2); const bf16_t* Vg = (const bf16_t*)(a->ws + R3); const bf16_t* Qg = (const bf16_t*)(a->ws + R4); bf16_t* Og = (bf16_t*)(a->ws + R0);
    bf16x8 tri[2];
#pragma unroll
    for (int ks = 0; ks < 2; ++ks) {
#pragma unroll
        for (int jj = 0; jj < 8; ++jj) { const int key = 16 * ks + 8 * (jj >> 2) + 4 * hh + (jj & 3); tri[ks][jj] = (key > r) ? (short)0x3F80 : (short)0; } }
    const int skey = (tid & 255) >> 3, sch = tid & 7; const bool isv = tid >= 256;
    u32x4 pre[8];
#define SB_REQUEST(unit_) do { const int u_ = (unit_); const int b_ = u_ >> 9, h_ = (u_ >> 5) & 15, qt_ = u_ & 31; const size_t hb_ = (size_t)b_ * S * D + h_ * 64; \
        _Pragma("unroll") for (int m = 0; m < 8; ++m) { const size_t go = hb_ + (size_t)((qt_ * 8 + m) * 32 + skey) * D + sch * 8; pre[m] = isv ? *(const u32x4*)(Vg + go) : *(const u32x4*)(Kg + go); } } while (0)
    if (bid < NB * 16 * 32) SB_REQUEST(bid);
    for (int unit = bid; unit < NB * 16 * 32; unit += nb) {
        const int b = unit >> 9, h = (unit >> 5) & 15, qt = unit & 31, q0 = qt * 256, kb0 = qt * 8;
        const size_t hbase = (size_t)b * S * D + h * 64;
        lds_barrier();
        if (tid < 3) flag[tid] = 0;
        bf16x8 Qf[4];
        { const bf16_t* qp = Qg + hbase + (size_t)(q0 + 32 * w + r) * D + 8 * hh;
#pragma unroll
          for (int ks = 0; ks < 4; ++ks) Qf[ks] = *(const bf16x8*)(qp + 16 * ks); }
        {
#pragma unroll
            for (int m = 0; m < 8; ++m) { const int slot = (kb0 + m) % NR; const u32x4 v = pre[m];
                if (!isv) *(LAS u32x4*)(Kr + slot * KBLK + skey * KROWB + sch * 16) = v;
                else *(LAS u32x4*)(Vr + slot * VBLK + skey * VROWB + sch * 16) = v; }
        }
        f32x16 o0, o1;
#pragma unroll
        for (int i = 0; i < 16; ++i) { o0[i] = 0.f; o1[i] = 0.f; }
        float R = 0.f; bool wdone = false;
        u32x4 sg0 = (u32x4){0u, 0u, 0u, 0u}, sg1 = sg0, sg2 = sg0;
        { const int n0 = kb0 - 1, n1 = kb0 - 2, n2 = kb0 - 3;
          if (n0 >= 0) { const size_t go = hbase + (size_t)(n0 * 32 + skey) * D + sch * 8; sg0 = isv ? *(const u32x4*)(Vg + go) : *(const u32x4*)(Kg + go); }
          if (n1 >= 0) { const size_t go = hbase + (size_t)(n1 * 32 + skey) * D + sch * 8; sg1 = isv ? *(const u32x4*)(Vg + go) : *(const u32x4*)(Kg + go); }
          if (n2 >= 0) { const size_t go = hbase + (size_t)(n2 * 32 + skey) * D + sch * 8; sg2 = isv ? *(const u32x4*)(Vg + go) : *(const u32x4*)(Kg + go); } }
        if (unit + nb < NB * 16 * 32) SB_REQUEST(unit + nb);
        for (int i = 0;; ++i) {
            lds_barrier();
            if (i > 0 && flag[(i - 1) % 3] == 0) break;
            if (tid == 0) flag[(i + 1) % 3] = 0;
            const int nblk = kb0 - i - 1;
            const u32x4 stg = sg0; sg0 = sg1; sg1 = sg2;
            { const int nf = kb0 - i - 4; sg2 = (u32x4){0u, 0u, 0u, 0u};
              if (nf >= 0) { const size_t go = hbase + (size_t)(nf * 32 + skey) * D + sch * 8; sg2 = isv ? *(const u32x4*)(Vg + go) : *(const u32x4*)(Kg + go); } }
            const int kb = kb0 + w - i;
            if (!wdone && kb >= 0) {
                const int slot = kb % NR;
                f32x16 s;
#pragma unroll
                for (int q = 0; q < 16; ++q) s[q] = 0.f;
#pragma unroll
                for (int ks = 0; ks < 4; ++ks) { const bf16x8 kf = *(const LAS bf16x8*)(Kr + slot * KBLK + r * KROWB + (16 * ks + 8 * hh) * 2); s = __builtin_amdgcn_mfma_f32_32x32x16_bf16(kf, Qf[ks], s, 0, 0, 0); }
                bf16x8 pb0, pb1; float tsum;
                if (i == 0) sb_block<true>(s, tri, R, r, hh, pb0, pb1, tsum); else sb_block<false>(s, tri, R, r, hh, pb0, pb1, tsum);
                const LAS unsigned char* vbase = Vr + slot * VBLK + (4 * hh + ((lane & 15) >> 2)) * VROWB + (16 * ((lane >> 4) & 1) + 4 * (lane & 3)) * 2;
#define SB_VT(s_, c_) __builtin_shufflevector(__builtin_amdgcn_ds_read_tr16_b64_v4i16((LAS s16x4*)(vbase + (16 * (s_)) * VROWB + 64 * (c_))), __builtin_amdgcn_ds_read_tr16_b64_v4i16((LAS s16x4*)(vbase + (16 * (s_) + 8) * VROWB + 64 * (c_))), 0, 1, 2, 3, 4, 5, 6, 7)
                { const bf16x8 v00 = SB_VT(0, 0), v10 = SB_VT(1, 0);
                  o0 = __builtin_amdgcn_mfma_f32_32x32x16_bf16(v00, pb0, o0, 0, 0, 0);
                  o0 = __builtin_amdgcn_mfma_f32_32x32x16_bf16(v10, pb1, o0, 0, 0, 0); }
                __builtin_amdgcn_sched_barrier(0);
                { const bf16x8 v01 = SB_VT(0, 1), v11 = SB_VT(1, 1);
                  o1 = __builtin_amdgcn_mfma_f32_32x32x16_bf16(v01, pb0, o1, 0, 0, 0);
                  o1 = __builtin_amdgcn_mfma_f32_32x32x16_bf16(v11, pb1, o1, 0, 0, 0); }
#undef SB_VT
                tsum += __shfl_xor(tsum, 32); R += tsum;
                wdone = (kb == 0) || (__builtin_amdgcn_ballot_w64(R >= -160.0f) == 0ull);
                if (!wdone && lane == 0) flag[i % 3] = 1;
            }
            if (nblk >= 0) { const int slot = nblk % NR;
                if (!isv) *(LAS u32x4*)(Kr + slot * KBLK + skey * KROWB + sch * 16) = stg;
                else *(LAS u32x4*)(Vr + slot * VBLK + skey * VROWB + sch * 16) = stg; }
        }
        { LAS bf16_t* ow = (LAS bf16_t*)(Ost + w * 4608);
#pragma unroll
          for (int m = 0; m < 4; ++m) { u32x2 wa, wb; wa.x = cvt_pk_c(o0[4 * m], o0[4 * m + 1]); wa.y = cvt_pk_c(o0[4 * m + 2], o0[4 * m + 3]); wb.x = cvt_pk_c(o1[4 * m], o1[4 * m + 1]); wb.y = cvt_pk_c(o1[4 * m + 2], o1[4 * m + 3]);
              *(LAS u32x2*)(ow + r * 72 + 8 * m + 4 * hh) = wa; *(LAS u32x2*)(ow + r * 72 + 32 + 8 * m + 4 * hh) = wb; }
          asm volatile("s_waitcnt lgkmcnt(0)" ::: "memory");
#pragma unroll
          for (int c4 = 0; c4 < 4; ++c4) { const int idx = c4 * 64 + lane, row = idx >> 3, ch = idx & 7; const u32x4 v = *(const LAS u32x4*)(ow + row * 72 + ch * 8);
              *(u32x4*)(Og + hbase + (size_t)(q0 + 32 * w + row) * D + ch * 8) = v; }
          asm volatile("s_waitcnt lgkmcnt(0)" ::: "memory"); }
    }
#undef SB_REQUEST
    __syncthreads();
}

__device__ __forceinline__ void assign_phase(KArgs a, int l, LAS unsigned char* lds, int bid, int nb) {
    const int tid = opaque_tid(), lane = tid & 63, wave = tid >> 6;
    LAS int* pst = (LAS int*)lds; LAS int* lc = pst + 64; LAS int* lbase = lc + 32; LAS int* a_tok = lbase + 32; LAS int* a_slot = a_tok + 512;
    unsigned* ctl = (unsigned*)a->ws;
    if (tid == 0) { int accv = 0; for (int e = 0; e < 32; ++e) { pst[e] = accv; accv += (int)((__hip_atomic_load(ctl + CW_CNT + 64 * l + e, __ATOMIC_RELAXED, __HIP_MEMORY_SCOPE_AGENT) + 255u) / 256u * 256u); } pst[32] = accv; }
    if (tid < 32) lc[tid] = 0;
    __syncthreads();
    int* tile_expert = (int*)(a->ws + WS_TILEEXP);
    if (bid == 0) { const int ntl = pst[32] >> 8; if (tid == 0) ctl[CW_NT + 64 * l] = (unsigned)ntl;
        for (int ti = tid; ti < ntl; ti += 512) { int e = 0; for (int q = 1; q < 32; ++q) if (pst[q] <= ti * 256) e = q; tile_expert[ti] = e; } }
    const u32x4* tok = (const u32x4*)(a->ws + WS_TOK); int* slot_of = (int*)(a->ws + WS_SLOTOF); float* slot_info = (float*)(a->ws + WS_SLOTINFO);
    int* slot_tok = (int*)(a->ws + WS_SLOTTOK);
    for (int chunk = bid; chunk < T / 256; chunk += nb) {
        const int t = chunk * 256 + (tid >> 1), kk = tid & 1;
        const u32x4 info = tok[t]; const int e = kk ? (int)((info.x >> 8) & 0xff) : (int)(info.x & 0xff);
        const unsigned gbits = kk ? info.z : info.y, rbits = info.w;
        const float gate = __uint_as_float(gbits), rstd = __uint_as_float(rbits);
        const int rank = atomicAdd((int*)&lc[e], 1);
        __syncthreads();
        if (tid < 32) lbase[tid] = (int)__hip_atomic_fetch_add(ctl + CW_FILL + 64 * l + tid, (unsigned)lc[tid], __ATOMIC_RELAXED, __HIP_MEMORY_SCOPE_AGENT);
        __syncthreads();
        const int slot = pst[e] + lbase[e] + rank;
        slot_of[t * 2 + kk] = slot; slot_info[(size_t)slot * 2] = gate; slot_info[(size_t)slot * 2 + 1] = rstd; slot_tok[slot] = t;
        __syncthreads();
        if (tid < 32) lc[tid] = 0;
        __syncthreads();
    }
}

__device__ __forceinline__ void combine_phase(KArgs a, bool fin, int bid, int nb, float msc = 1.f) {
    const int tid = opaque_tid(), lane = tid & 63, wave = tid >> 6;
    float* x = a->out; const bf16_t* ys = (const bf16_t*)(a->ws + R2); const int* slot_of = (const int*)(a->ws + WS_SLOTOF);
    bf16_t* xb = (bf16_t*)(a->ws + R1); float* ssq = (float*)(a->ws + WS_SSQ); const float* nf = a->in[I_NORM_FINAL];
    u32x4 px[2], py1[2], py2[2];
    { const int row0 = bid * 8 + wave; const int s1 = slot_of[row0 * 2], s2 = slot_of[row0 * 2 + 1];
#pragma unroll
      for (int k = 0; k < 2; ++k) { px[k] = *(const u32x4*)(xb + (size_t)row0 * D + k * 512 + lane * 8); py1[k] = *(const u32x4*)(ys + (size_t)s1 * D + k * 512 + lane * 8); py2[k] = *(const u32x4*)(ys + (size_t)s2 * D + k * 512 + lane * 8); } }
    for (int row = bid * 8 + wave; row < T; row += nb * 8) {
        f32x4 xv[4]; float ss = 0.f;
        const int nrow = (row + nb * 8 < T) ? row + nb * 8 : row; const int ns1 = slot_of[nrow * 2], ns2 = slot_of[nrow * 2 + 1];
#pragma unroll
        for (int k = 0; k < 2; ++k) { u32x4 xw, y1, y2;
            xw.x = pin_u32(px[k].x); xw.y = pin_u32(px[k].y); xw.z = pin_u32(px[k].z); xw.w = pin_u32(px[k].w); y1.x = pin_u32(py1[k].x); y1.y = pin_u32(py1[k].y); y1.z = pin_u32(py1[k].z); y1.w = pin_u32(py1[k].w);
            y2.x = pin_u32(py2[k].x); y2.y = pin_u32(py2[k].y); y2.z = pin_u32(py2[k].z); y2.w = pin_u32(py2[k].w);
            const float ms = msc;
            xv[2 * k] = (f32x4){bf_lo(xw.x) + ms * (bf_lo(y1.x) + bf_lo(y2.x)), bf_hi(xw.x) + ms * (bf_hi(y1.x) + bf_hi(y2.x)), bf_lo(xw.y) + ms * (bf_lo(y1.y) + bf_lo(y2.y)), bf_hi(xw.y) + ms * (bf_hi(y1.y) + bf_hi(y2.y))};
            xv[2 * k + 1] = (f32x4){bf_lo(xw.z) + ms * (bf_lo(y1.z) + bf_lo(y2.z)), bf_hi(xw.z) + ms * (bf_hi(y1.z) + bf_hi(y2.z)), bf_lo(xw.w) + ms * (bf_lo(y1.w) + bf_lo(y2.w)), bf_hi(xw.w) + ms * (bf_hi(y1.w) + bf_hi(y2.w))};
            ss += ((xv[2 * k][0] * xv[2 * k][0] + xv[2 * k][1] * xv[2 * k][1]) + (xv[2 * k][2] * xv[2 * k][2] + xv[2 * k][3] * xv[2 * k][3])) + ((xv[2 * k + 1][0] * xv[2 * k + 1][0] + xv[2 * k + 1][1] * xv[2 * k + 1][1]) + (xv[2 * k + 1][2] * xv[2 * k + 1][2] + xv[2 * k + 1][3] * xv[2 * k + 1][3])); }
        if (nrow != row) {
#pragma unroll
            for (int k = 0; k < 2; ++k) { px[k] = *(const u32x4*)(xb + (size_t)nrow * D + k * 512 + lane * 8); py1[k] = *(const u32x4*)(ys + (size_t)ns1 * D + k * 512 + lane * 8); py2[k] = *(const u32x4*)(ys + (size_t)ns2 * D + k * 512 + lane * 8); } }
        ss = wave_sum(ss);
        if (fin) { const float rstd = __builtin_amdgcn_rsqf(ss * (1.0f / D) + NORM_EPS);
#pragma unroll
            for (int k = 0; k < 2; ++k) { const f32x4 ga = *(const f32x4*)(nf + k * 512 + lane * 8), gb = *(const f32x4*)(nf + k * 512 + lane * 8 + 4);
                *(f32x4*)(x + (size_t)row * D + k * 512 + lane * 8) = xv[2 * k] * rstd * ga; *(f32x4*)(x + (size_t)row * D + k * 512 + lane * 8 + 4) = xv[2 * k + 1] * rstd * gb; } }
        else {
#pragma unroll
            for (int k = 0; k < 2; ++k) *(u32x4*)(xb + (size_t)row * D + k * 512 + lane * 8) = pack8v4(xv[2 * k], xv[2 * k + 1]);
            if (lane < 16) ssq[(size_t)row * 16 + lane] = lane == 0 ? ss : 0.f; }
    }
}

#define GRID_BAR() do { XcdBarrier b_; b_.bar = (unsigned*)a->ws + CW_BAR; b_.x = xb_xcc_id(); b_.st = (volatile LAS unsigned*)(lds + LDS_MISC) + 8; xcd_barrier(b_); } while (0)
#define IN(k) true
#define SEAM(k) do { if (IN(k) && IN((k) + 1)) GRID_BAR(); } while (0)
template <int l> __device__ __forceinline__ void layer_body(KArgs a, LAS unsigned char* lds, const int lo, const int hi) {
    const int bid = blockIdx.x, nb = gridDim.x; unsigned char* ws = a->ws;

        const int pb = 1 + 13 * l;
        if constexpr (l == 0) {
            if (IN(pb + 0)) {
                { pg8::Gemm g{(const bf16_t*)ws, (const bf16_t*)(ws + WS_WCAT), D, D, D};
                  SchedRKV Sd; Sd.init(T / 256, 12, nb, bid); Sd.aoff0 = (long long)R6; Sd.aoff1 = (long long)((const unsigned char*)a->out - ws);
                  EpiCat E{(bf16_t*)(ws + R1), (bf16_t*)(ws + R5), (long long)(R2 - R1) / 2, 0};
                  pg8::gemm_phase(lds, g, Sd, E); }
                { pg8::Gemm g{(const bf16_t*)(ws + R0), (const bf16_t*)(ws + WS_WCAT) + (size_t)3072 * 2 * D, D, 2 * D, 2 * D};
                  SchedHP Sd; Sd.init(T / 256, 2, nb, bid);
                  EpiCat E{(bf16_t*)(ws + R1), (bf16_t*)(ws + R5), (long long)(R2 - R1) / 2, 12};
                  pg8::gemm_phase(lds, g, Sd, E); }
            }
            SEAM(pb + 0);
            if (IN(pb + 1)) {
                { pg8::Gemm g{(const bf16_t*)(ws + R5), (const bf16_t*)(ws + WS_WWA2), 512, 256, 256};
                  SchedPlain Sd; Sd.init(T / 256, 8, nb, bid); Sd.astr = (long long)256 * 512 * 2; Sd.bstr = (long long)256 * 256 * 2;
                  const float* b0 = a->in[I_W0]; const float* b1 = a->in[I_A0]; bf16_t* o0 = (bf16_t*)(ws + R4); bf16_t* o1 = (bf16_t*)a->out;
                  EpiAct E{o0, (long long)(o1 - o0), b0, (long long)(b1 - b0), -0.60653066f, 1.60653066f};
                  pg8::gemm_phase(lds, g, Sd, E); }
            }
            SEAM(pb + 1);
            if (IN(pb + 2)) {
                rw::stage_a(a, lds, bid, nb);
                GRID_BAR();
                if (bid < 128) rw::stage_b(a, lds, bid);
                else {
                    pg8::Gemm g{(const bf16_t*)(ws + WS_MN), (const bf16_t*)(ws + WS_WMKV), D, D, D};
                    SchedMemKV Sd; Sd.init(16, 8, nb - 128, bid - 128);
                    EpiMemKV E{(bf16_t*)(ws + WS_KMEM), (bf16_t*)(ws + WS_VT)};
                    pg8::gemm_phase(lds, g, Sd, E); }
                {
                    constexpr int NU = (T / 256) * 4, NSCAN = NU * 2 / 8;
                    pg8::Gemm g{(const bf16_t*)(ws + R5) + 256, (const bf16_t*)(ws + WS_WG2), 512, 256, 256};
                    SchedRange Sd; Sd.init(T / 256, 4, bid < 128 ? 128 : nb - 128, bid < 128 ? bid : bid - 128); Sd.astr = (long long)256 * 512 * 2; Sd.bstr = (long long)256 * 256 * 2;
                    Sd.base = bid < 128 ? 0 : NSCAN; Sd.count = bid < 128 ? NSCAN : NU - NSCAN;
                    EpiAct E{(bf16_t*)a->out + (size_t)T * D, 0, nullptr, 0, 1.f, 0.f};
                    pg8::gemm_phase(lds, g, Sd, E); }
                GRID_BAR();
                rw::stage_c(a, lds, bid, nb);
            }
            SEAM(pb + 2);
        } else {
            if (IN(pb + 0)) {
                pg8::Gemm g{(const bf16_t*)(ws + R1), (const bf16_t*)(ws + WS_WKVQ), D, D, D};
                SchedPlain Sd; Sd.init(T / 256, 12, nb, bid); Sd.astr = (long long)256 * D * 2; Sd.bstr = (long long)256 * D * 2;
                EpiRstd E{(bf16_t*)(ws + R2), (long long)(R3 - R2) / 2, (const float*)(ws + WS_SSQ)};
                pg8::gemm_phase(lds, g, Sd, E);
            }
            SEAM(pb + 0);
            if (IN(pb + 1)) { sbattn_phase(a, lds, bid, nb);
            }
            if (IN(pb + 1) && IN(pb + 3)) GRID_BAR();
        }
        if (IN(pb + 3)) {
            pg8::Gemm g{(const bf16_t*)(ws + (l ? R0 : R6)), (const bf16_t*)(ws + (l ? WS_WOSB : WS_WO0)), D, D, D};
            SchedPlain Sd; Sd.init(T / 256, 4, nb, bid); Sd.astr = (long long)256 * D * 2; Sd.bstr = (long long)256 * D * 2;
            EpiResid E{l ? (const float*)nullptr : a->in[I_X], (bf16_t*)(ws + R1), (float*)(ws + WS_SSQ), 1.f};
            pg8::gemm_phase(lds, g, Sd, E);
            if constexpr (l == 0) {
                { pg8::Gemm g2{(const bf16_t*)(ws + WS_KMEM), (const bf16_t*)(ws + WS_WMQ), D, D, 256};
                  SchedMemPre S2; S2.init(64, 4, nb, bid); S2.mode = 0; EpiMemPre E2{(bf16_t*)a->out};
                  pg8::gemm_phase(lds, g2, S2, E2); }
                { pg8::Gemm g2{(const bf16_t*)(ws + WS_WMO), (const bf16_t*)(ws + WS_VT), D, D, 256};
                  SchedMemPre S2; S2.init(64, 4, nb, bid); S2.mode = 1; EpiMemPre E2{(bf16_t*)a->out + (size_t)16 * D * D};
                  pg8::gemm_phase(lds, g2, S2, E2); } }
        }
        SEAM(pb + 3);
        if (IN(pb + 4)) {
            pg8::Gemm g{(const bf16_t*)(ws + R1), (const bf16_t*)a->out + (size_t)l * 8 * D * D, D, D, D};
            SchedBatchB Sd; Sd.init(T / 256, 4, nb, bid);
            EpiSoftmax E{(bf16_t*)(ws + R2), (const float*)(ws + WS_SSQ)};
            pg8::gemm_phase(lds, g, Sd, E);
        }
        SEAM(pb + 4);
        if (IN(pb + 7)) {
            pg8::Gemm g{(const bf16_t*)(ws + R2), (const bf16_t*)a->out + (size_t)(16 + l * 8) * D * D, D, D, D};
            SchedBatchB Sd; Sd.init(T / 256, 4, nb, bid);
            EpiResid E{(const float*)nullptr, (bf16_t*)(ws + R1), (float*)(ws + WS_SSQ), 1.f};
            pg8::gemm_phase(lds, g, Sd, E);
        }
        SEAM(pb + 7);
        if (IN(pb + 8)) {
            LAS int* lc = (LAS int*)(lds + LDS_EPI + 4096);
            if (threadIdx.x < 32) lc[threadIdx.x] = 0;
            __syncthreads();
            { pg8::Gemm g{(const bf16_t*)(ws + R1), (const bf16_t*)(ws + WS_RS) + (size_t)l * 256 * D, D, D, D};
              SchedPlain Sd; Sd.init(T / 256, 1, nb, bid); Sd.astr = (long long)256 * D * 2; Sd.bstr = 0;
              EpiRouter E{(const float*)(ws + WS_SSQ), a->in[I_BRG] + l * 4, a->in[I_BRE] + l * 32, (u32x4*)(ws + WS_TOK)};
              pg8::gemm_phase(lds, g, Sd, E); }
            __syncthreads();
            if (threadIdx.x < 32) atomicAdd((unsigned*)ws + CW_CNT + 64 * l + threadIdx.x, (unsigned)lc[threadIdx.x]);
        }
        SEAM(pb + 8);
        if (IN(pb + 9)) { assign_phase(a, l, lds, bid, nb);
        }
        SEAM(pb + 9);
        if (IN(pb + 10)) {
            const int ntl = (int)__hip_atomic_load((unsigned*)ws + CW_NT + 64 * l, __ATOMIC_RELAXED, __HIP_MEMORY_SCOPE_AGENT);
            pg8::Gemm g{(const bf16_t*)(ws + R1), (const bf16_t*)(ws + WS_WGU) + (size_t)l * 32 * 512 * D, D, D, D};
            SchedMoE Sd; Sd.init(ntl, 2, nb, bid); Sd.tile_expert = (const int*)(ws + WS_TILEEXP); Sd.mode = 0;
            EpiSwiGLU E{(bf16_t*)(ws + R0), (const float*)(ws + WS_SLOTINFO)};
            pg8::gemm_phase_gather(lds, g, Sd, E, (const int*)(ws + WS_SLOTTOK));
        }
        SEAM(pb + 10);
        if (IN(pb + 11)) {
            const int ntl = (int)__hip_atomic_load((unsigned*)ws + CW_NT + 64 * l, __ATOMIC_RELAXED, __HIP_MEMORY_SCOPE_AGENT);
            pg8::Gemm g{(const bf16_t*)(ws + R0), (const bf16_t*)(ws + WS_WDN) + (size_t)l * 32 * D * 256, 256, 256, 256};
            SchedMoE Sd; Sd.init(ntl, 4, nb, bid); Sd.tile_expert = (const int*)(ws + WS_TILEEXP); Sd.mode = 1;
            EpiGate E{(bf16_t*)(ws + R2), (const float*)(ws + WS_SLOTINFO)};
            pg8::gemm_phase(lds, g, Sd, E);
        }
        SEAM(pb + 11);
        combine_phase(a, l == 1, bid, nb);
        if (l == 0) SEAM(pb + 12);
    }
constexpr int NPHASE = 27;
__global__ void __launch_bounds__(512, 2) fwd_kernel(Args a_unused) {
    extern __shared__ __attribute__((aligned(16))) unsigned char lds_raw[];
    LAS unsigned char* lds = (LAS unsigned char*)lds_raw;
    const int tid = threadIdx.x, bid = blockIdx.x, nb = gridDim.x;
    KArgs a = kargs();
    unsigned char* ws = a->ws;
    volatile LAS unsigned* MISC = (volatile LAS unsigned*)(lds + LDS_MISC);
    if (tid < 64) MISC[tid] = 0u;
    __syncthreads();
    (void)xcd_barrier_post((unsigned*)ws + CW_BAR, MISC + 8);
    const int lo = a->ph_lo, hi = a->ph_hi;
    prologue_phase(a, lds, bid, nb);
    SEAM(0);
    layer_body<0>(a, lds, lo, hi);
    layer_body<1>(a, lds, lo, hi);
#undef IN
#undef SEAM
}

extern "C" void kernel_launch(void* const* d_in, const int* in_sizes, int n_in, void* d_out, int out_size, void* d_ws, size_t ws_size, hipStream_t stream) {
    static int grid = 0;
    if (grid == 0) {
        if (n_in != 37 || in_sizes[0] != T * D || out_size != T * D || ws_size < WS_END) { fprintf(stderr, "kernel_launch: unexpected shapes (n_in %d, ws %zu < %zu)\n", n_in, ws_size, (size_t)WS_END); grid = -1; return; }
        int dev = 0, cus = 0, per_cu = 0;
        if (hipGetDevice(&dev) != hipSuccess || hipDeviceGetAttribute(&cus, hipDeviceAttributeMultiprocessorCount, dev) != hipSuccess) { grid = -1; return; }
        if (hipFuncSetAttribute((const void*)fwd_kernel, hipFuncAttributeMaxDynamicSharedMemorySize, LDS_BYTES) != hipSuccess) { fprintf(stderr, "kernel_launch: hipFuncSetAttribute failed\n"); grid = -1; return; }
        if (hipOccupancyMaxActiveBlocksPerMultiprocessor(&per_cu, (const void*)fwd_kernel, 512, LDS_BYTES) != hipSuccess || per_cu < 1) fprintf(stderr, "kernel_launch: occupancy query reports %d\n", per_cu);
        (void)hipGetLastError();
        grid = cus;
    }
    if (grid < 0) return;
    hipMemsetAsync((char*)d_ws + WS_CTL, 0, CTL_BYTES, stream);
    hipMemsetAsync((char*)d_ws + WS_WCAT + (size_t)3072 * 2048 * 2, 0, (size_t)512 * 2048 * 2, stream);
    hipMemsetAsync((char*)d_ws + WS_WWA2, 0, (size_t)3072 * 256 * 2, stream);
    hipMemsetAsync((char*)d_ws + WS_SLOTTOK, 0, (size_t)NSLOT_MAX * 4, stream);
    Args ha{};
    for (int i = 0; i < 37; ++i) ha.in[i] = (const float*)d_in[i];
    ha.out = (float*)d_out; ha.ws = (unsigned char*)d_ws;
    ha.ph_lo = 0; ha.ph_hi = NPHASE;
    hipLaunchKernelGGL(fwd_kernel, dim3(grid), dim3(512), LDS_BYTES, stream, ha);
}
```

```cpp
#include <hip/hip_runtime.h>
#include <cstdio>
#include <cstdint>

#define LAS __attribute__((address_space(3)))
typedef unsigned short bf16_t;
typedef short bf16x8 __attribute__((ext_vector_type(8)));
typedef float f32x4 __attribute__((ext_vector_type(4)));
typedef float f32x2 __attribute__((ext_vector_type(2)));
typedef short s16x4 __attribute__((ext_vector_type(4)));
typedef unsigned u32x4 __attribute__((ext_vector_type(4)));
typedef unsigned u32x2 __attribute__((ext_vector_type(2)));

constexpr int NB = 8, S = 8192, D = 1024, T = NB * S;
constexpr int HP_ROWS = NB * (S + 1);
constexpr int NSLOT_MAX = 2 * T + 32 * 256;
constexpr int NTILE_MAX = NSLOT_MAX / 256;
constexpr float NORM_EPS = 1e-6f;

constexpr size_t MiB = 1u << 20;
constexpr size_t WS_CTL = 0, CTL_BYTES = 1 * MiB;
constexpr size_t WS_WCAT = 1 * MiB;
constexpr size_t WS_WWA2 = WS_WCAT + (size_t)3584 * 2048 * 2;
constexpr size_t WS_WG2 = WS_WWA2 + (size_t)2048 * 256 * 2;
constexpr size_t WS_WO0 = WS_WG2 + (size_t)1024 * 256 * 2;
constexpr size_t WS_WKVQ = WS_WO0 + (size_t)1024 * 1024 * 2;
constexpr size_t WS_WOSB = WS_WKVQ + (size_t)3072 * 1024 * 2;
constexpr size_t WS_WMQ = WS_WOSB + (size_t)1024 * 1024 * 2;
constexpr size_t WS_WMKV = WS_WMQ + (size_t)2 * 1024 * 1024 * 2;
constexpr size_t WS_WMO = WS_WMKV + (size_t)2 * 2048 * 1024 * 2;
constexpr size_t WS_WGU = WS_WMO + (size_t)2 * 1024 * 1024 * 2;
constexpr size_t WS_WDN = WS_WGU + (size_t)2 * 32 * 512 * 1024 * 2;
constexpr size_t WS_WR = WS_WDN + (size_t)2 * 32 * 1024 * 256 * 2;
constexpr size_t WS_WEND = WS_WR + (size_t)2 * 36 * 1024 * 4;
constexpr size_t WS_MN = (WS_WEND + 4095) / 4096 * 4096;
constexpr size_t WS_KMEM = WS_MN + (size_t)2048 * 1024 * 2;
constexpr size_t WS_VT = WS_KMEM + (size_t)2 * 2048 * 1024 * 2;
constexpr size_t WS_SSQ = WS_VT + (size_t)2 * 2048 * 1024 * 2;
constexpr size_t WS_RS = WS_SSQ + (size_t)T * 16 * 4;
constexpr size_t WS_TOK = WS_RS + (size_t)T * 16 * 4;
constexpr size_t WS_SLOTOF = WS_TOK + (size_t)T * 16;
constexpr size_t WS_SLOTINFO = WS_SLOTOF + (size_t)T * 8;
constexpr size_t WS_TILEEXP = WS_SLOTINFO + (size_t)NSLOT_MAX * 8;
constexpr size_t WS_SLOTTOK = WS_TILEEXP + 4096;
constexpr size_t WS_ARENA = (WS_SLOTTOK + (size_t)NSLOT_MAX * 4 + MiB - 1) / MiB * MiB;
constexpr size_t R0 = WS_ARENA;
constexpr size_t R1 = R0 + 129 * MiB;
constexpr size_t R2 = R1 + 128 * MiB;
constexpr size_t R3 = R2 + 128 * MiB;
constexpr size_t R4 = R3 + 128 * MiB;
constexpr size_t R5 = R4 + 128 * MiB;
constexpr size_t R6 = R5 + 64 * MiB;
constexpr size_t WS_END = R6 + 128 * MiB;
static_assert((size_t)HP_ROWS * D * 2 <= 129 * MiB, "hp");
static_assert((size_t)NSLOT_MAX * D * 2 <= 3 * 128 * MiB, "xs/ys");
static_assert(WS_END <= (size_t)1024 * MiB, "workspace over 1 GiB");

constexpr int CW_BAR = 4096;
constexpr int CW_CNT = 16384;
constexpr int CW_FILL = 16384 + 256;
constexpr int CW_NT = 16384 + 512;

constexpr int LDS_BYTES = 161792;
constexpr int LDS_EPI = 131072;
constexpr int LDS_MISC = LDS_BYTES - 256;

__device__ __forceinline__ unsigned f2bf(float f) { unsigned u = __builtin_bit_cast(unsigned, f); return (u + 0x7fffu + ((u >> 16) & 1u)) >> 16; }
typedef __bf16 bf16v2_t __attribute__((ext_vector_type(2)));
__device__ __forceinline__ unsigned cvt_pk_c(float lo, float hi) { const f32x2 v = {lo, hi}; const bf16v2_t b = __builtin_convertvector(v, bf16v2_t); return __builtin_bit_cast(unsigned, b); }
__device__ __forceinline__ unsigned cvt_pk_bf16(float lo, float hi) { return cvt_pk_c(lo, hi); }
typedef float f32x16 __attribute__((ext_vector_type(16)));
__device__ __forceinline__ bf16x8 pack8c(float a0, float a1, float a2, float a3, float a4, float a5, float a6, float a7) {
    u32x4 w; w.x = cvt_pk_c(a0, a1); w.y = cvt_pk_c(a2, a3); w.z = cvt_pk_c(a4, a5); w.w = cvt_pk_c(a6, a7); return __builtin_bit_cast(bf16x8, w); }
__device__ __forceinline__ bf16x8 pack8v(float a0, float a1, float a2, float a3, float a4, float a5, float a6, float a7) {
    u32x4 w; w.x = cvt_pk_bf16(a0, a1); w.y = cvt_pk_bf16(a2, a3); w.z = cvt_pk_bf16(a4, a5); w.w = cvt_pk_bf16(a6, a7); return __builtin_bit_cast(bf16x8, w); }
__device__ __forceinline__ float bf_lo(unsigned w) { return __builtin_bit_cast(float, w << 16); }
__device__ __forceinline__ float bf_hi(unsigned w) { return __builtin_bit_cast(float, w & 0xffff0000u); }
__device__ __forceinline__ float wave_sum_shfl(float v) {
#pragma unroll
    for (int o = 1; o < 64; o <<= 1) v += __shfl_xor(v, o);
    return v;
}
__device__ __forceinline__ float dpp_f(float v, const int ctrl_sel) {
    int x = __builtin_bit_cast(int, v), r;
    if (ctrl_sel == 0) r = __builtin_amdgcn_update_dpp(0, x, 0xB1, 0xF, 0xF, true);
    else if (ctrl_sel == 1) r = __builtin_amdgcn_update_dpp(0, x, 0x4E, 0xF, 0xF, true);
    else if (ctrl_sel == 2) r = __builtin_amdgcn_update_dpp(0, x, 0x141, 0xF, 0xF, true);
    else r = __builtin_amdgcn_update_dpp(0, x, 0x140, 0xF, 0xF, true);
    return __builtin_bit_cast(float, r);
}
__device__ __forceinline__ float sum8(float v) { v += dpp_f(v, 0); v += dpp_f(v, 1); v += dpp_f(v, 2); return v; }
__device__ __forceinline__ float sum16(float v) { v = sum8(v); v += dpp_f(v, 3); return v; }
__device__ __forceinline__ float wave_sum(float v) { v = sum16(v);
    v += __builtin_bit_cast(float, __builtin_amdgcn_update_dpp(0, __builtin_bit_cast(int, v), 0x142, 0xF, 0xF, true));
    v += __builtin_bit_cast(float, __builtin_amdgcn_update_dpp(0, __builtin_bit_cast(int, v), 0x143, 0xF, 0xF, true));
    return __builtin_bit_cast(float, __builtin_amdgcn_readlane(__builtin_bit_cast(int, v), 63)); }
__device__ __forceinline__ float fast_sigmoid(float x) { return __builtin_amdgcn_rcpf(1.0f + __builtin_amdgcn_exp2f(-1.44269504f * x)); }
__device__ __forceinline__ float fast_tanh(float x) { return 1.0f - 2.0f * __builtin_amdgcn_rcpf(1.0f + __builtin_amdgcn_exp2f(2.88539008f * x)); }

__device__ __forceinline__ unsigned pin_u32(unsigned x) { asm volatile("" : "+v"(x)); return x; }
__device__ __forceinline__ int opaque_tid() { int t = threadIdx.x; asm volatile("" : "+v"(t)); return t; }
template <class P> __device__ __forceinline__ P* opaque_ptr(P* p) { asm volatile("" : "+s"(p)); return p; }
__device__ __forceinline__ void lds_barrier() { asm volatile("s_waitcnt lgkmcnt(0)" ::: "memory"); __builtin_amdgcn_s_barrier(); asm volatile("" ::: "memory"); }
#define XB_TMO      128
#define XB_XCNT(j)  (256  + 64 * (j))
#define XB_XSUB(j)  (1280 + 64 * (j))
#define XB_XGEN(j)  (2304 + 64 * (j))
#define XB_TOP      3328
#define XB_TOPGEN   3392
#define XCD_BAR_WORDS 3456
#define XB_SPIN_CAP (1u << 22)
__device__ __forceinline__ unsigned xb_ld(unsigned* p)              { return __hip_atomic_load(p, __ATOMIC_RELAXED, __HIP_MEMORY_SCOPE_AGENT); }
__device__ __forceinline__ unsigned xb_add(unsigned* p, unsigned v) { return __hip_atomic_fetch_add(p, v, __ATOMIC_RELAXED, __HIP_MEMORY_SCOPE_AGENT); }
__device__ __forceinline__ unsigned xb_xcc_id() { return (unsigned)__builtin_amdgcn_s_getreg((3 << 11) | 20) & 0xFu; }
#define XB_SPIN(cond, bar) do { unsigned _sp = 0; while (cond) { __builtin_amdgcn_s_sleep(1); \
    if ((++_sp & 255u) == 0u) { if (xb_ld(&(bar)[XB_TMO])) break; if (_sp > XB_SPIN_CAP) { atomicAdd(&(bar)[XB_TMO], 1u); break; } } } } while (0)
struct XcdBarrier { unsigned* bar; unsigned x; volatile LAS unsigned* st; };
__device__ __forceinline__ XcdBarrier xcd_barrier_post(unsigned* bar, volatile LAS unsigned* st) {
    XcdBarrier b; b.bar = bar; b.x = xb_xcc_id(); b.st = st;
    if (threadIdx.x == 0) (void)xb_add(&bar[XB_XCNT(b.x)], 1u);
    return b;
}
__device__ __forceinline__ void xcd_barrier_complete(unsigned* bar, unsigned x, unsigned& nloc, unsigned& nx) {
    const unsigned G = gridDim.x * gridDim.y * gridDim.z;
    unsigned sum, cnt, mine, sp = 0u;
    for (;;) {
        sum = 0u; cnt = 0u; mine = 0u;
#pragma unroll
        for (unsigned j = 0; j < 16; ++j) { const unsigned c = xb_ld(&bar[XB_XCNT(j)]); sum += c; cnt += (c > 0u) ? 1u : 0u; mine = (j == x) ? c : mine; }
        if (sum == G) break;
        __builtin_amdgcn_s_sleep(1);
        if ((++sp & 255u) == 0u) { if (xb_ld(&bar[XB_TMO])) break; if (sp > XB_SPIN_CAP) { atomicAdd(&bar[XB_TMO], 1u); break; } }
    }
    nloc = mine > 0u ? mine : 1u; nx = cnt > 0u ? cnt : 1u;
}
__device__ __forceinline__ void xcd_barrier(const XcdBarrier& b) {
    asm volatile("s_waitcnt vmcnt(0)" ::: "memory");
    __syncthreads();
    if (threadIdx.x == 0) {
        unsigned* bar = b.bar;
        __builtin_amdgcn_s_waitcnt(0);
        unsigned nloc = b.st[0], nx = b.st[1];
        if (nloc == 0u) { xcd_barrier_complete(bar, b.x, nloc, nx); b.st[0] = nloc; b.st[1] = nx; }
        const unsigned old = xb_add(&bar[XB_XSUB(b.x)], 1u);
        const unsigned gen = old / nloc;
        if (old + 1u == (gen + 1u) * nloc) {
            __builtin_amdgcn_fence(__ATOMIC_RELEASE, "agent");
            asm volatile("s_waitcnt vmcnt(0)" ::: "memory");
            const unsigned og = xb_add(&bar[XB_TOP], 1u);
            const unsigned tg = og / nx;
            if (og + 1u == (tg + 1u) * nx) xb_add(&bar[XB_TOPGEN], 1u);
            else XB_SPIN(xb_ld(&bar[XB_TOPGEN]) == tg, bar);
            __builtin_amdgcn_fence(__ATOMIC_ACQUIRE, "agent");
            xb_add(&bar[XB_XGEN(b.x)], 1u);
            asm volatile("s_waitcnt vmcnt(0)" ::: "memory");
        } else {
            XB_SPIN(xb_ld(&bar[XB_XGEN(b.x)]) == gen, bar);
            __builtin_amdgcn_fence(__ATOMIC_ACQUIRE, "agent");
            asm volatile("s_waitcnt vmcnt(0)" ::: "memory");
        }
    }
    __syncthreads();
}

namespace pg8 {
constexpr int BM = 256, BK = 64, HALF = 128, HTB = HALF * BK * 2, STAGE_BYTES = 8 * HTB, NXCD = 8, WGM = 8;
__host__ __device__ __forceinline__ int lds_byte(int r, int c) { const int st = (r >> 4) * 2 + (c >> 5), rr = r & 15, cc = c & 31, ob = rr * 64 + cc * 2; return st * 1024 + (ob ^ (((ob >> 9) & 1) << 5)); }
__host__ __device__ __forceinline__ void stage_rc(int b, int& R, int& C) { const int st = b / 1024, sb = b % 1024, swz = sb ^ (((sb >> 9) & 1) << 5); R = (st >> 1) * 16 + swz / 64; C = (st & 1) * 32 + (swz % 64) / 2; }
__host__ __device__ __forceinline__ int perm32(int rho) { const int n = rho >> 4, i = rho & 15; return 8 * (i >> 2) + 4 * n + (i & 3); }

struct Unit { int pm, pn; };
struct Gemm { const bf16_t* A; const bf16_t* Bt; int lda, ldb, K; };

struct OrderCore {
    int nM, nN, nwg, G, c;
    __device__ __forceinline__ void init(int nM_, int nN_, int G_, int c_) { nM = nM_; nN = nN_; nwg = nM * nN; G = G_; c = c_; }
    __device__ __forceinline__ bool map(int i, int& pm, int& pn) const { const long L = (long)i * G + c; if (c < 0 || L >= nwg) return false; return map_lin(L, pm, pn); }
    __device__ __forceinline__ bool map_lin(long L, int& pm, int& pn) const {
        int wgid = (int)L; { const int q = nwg / NXCD, r = nwg % NXCD, xcd = wgid % NXCD, off = wgid / NXCD; wgid = (xcd < r ? xcd * (q + 1) : r * (q + 1) + (xcd - r) * q) + off; }
        const int nig = WGM * nN, gid = wgid / nig, fm = gid * WGM, gsz = (nM - fm) < WGM ? (nM - fm) : WGM;
        pm = fm + ((wgid % nig) % gsz); pn = (wgid % nig) / gsz; return true;
    }
    __device__ __forceinline__ void a_ready(const Unit&) const {}
    __device__ __forceinline__ void done(const Unit&) const {}
};

template <class Epi, class Sched, bool ALIGN_EPI = true, bool SP2 = true>
__device__ __forceinline__ void gemm_phase(LAS unsigned char* lds, const Gemm g, const Sched& S, const Epi& E) {
    const int tid = opaque_tid(), wid = __builtin_amdgcn_readfirstlane(tid >> 6), lane = tid & 63, wr = wid >> 2, wc = wid & 3, fr = lane & 15, fq = lane >> 4;
    const int K = g.K, nt = K / BK;
    unsigned voffA[2], voffB[2];
#pragma unroll
    for (int i = 0; i < 2; ++i) { int R, C; stage_rc(tid * 16 + i * 8192, R, C); const int Rb = Epi::PERM ? ((R & ~31) + perm32(R & 31)) : R;
        voffA[i] = (unsigned)(R * g.lda + C) * 2u; voffB[i] = (unsigned)(Rb * g.ldb + C) * 2u; }
    const size_t kstep = (size_t)(BK * 2);
    const size_t hstepA = (size_t)HALF * g.lda * 2, hstepB = (size_t)HALF * g.ldb * 2;
    const unsigned ldsw = (unsigned)wid * 1024u;
    const int aoff = lds_byte(wr * 64 + fr, fq * 8), boff = lds_byte(wc * 32 + fr, fq * 8);
#define PG8_SA(b, h) (((b) * 2 + (h)) * HTB)
#define PG8_SB(b, h) ((4 + (b) * 2 + (h)) * HTB)
#define PG8_STAGE(bufoff, gbase, voff) do { _Pragma("unroll") for (int _i = 0; _i < 2; ++_i) \
        __builtin_amdgcn_global_load_lds((const unsigned*)((const char*)(gbase) + (voff)[_i]), (LAS unsigned*)(lds + (bufoff) + ldsw + _i * 8192), 16, 0, 0); } while (0)
#define PG8_LDA(dst, b, h) do { _Pragma("unroll") for (int m = 0; m < 4; ++m) _Pragma("unroll") for (int k = 0; k < 2; ++k) dst[m][k] = *(const LAS bf16x8*)(lds + PG8_SA(b, h) + aoff + m * 2048 + k * 1024); } while (0)
#define PG8_LDB(dst, b, h) do { _Pragma("unroll") for (int n = 0; n < 2; ++n) _Pragma("unroll") for (int k = 0; k < 2; ++k) dst[n][k] = *(const LAS bf16x8*)(lds + PG8_SB(b, h) + boff + n * 2048 + k * 1024); } while (0)
#define PG8_MMA(ai, bj, At, Bt) do { __builtin_amdgcn_s_setprio(1); _Pragma("unroll") for (int m = 0; m < 4; ++m) _Pragma("unroll") for (int n = 0; n < 2; ++n) _Pragma("unroll") for (int k = 0; k < 2; ++k) \
        acc[ai][bj][m][n] = __builtin_amdgcn_mfma_f32_16x16x32_bf16(Bt[n][k], At[m][k], acc[ai][bj][m][n], 0, 0, 0); __builtin_amdgcn_s_setprio(0); } while (0)
#define PG8_WAIT_V(n) asm volatile("s_waitcnt vmcnt(" #n ")" ::: "memory")
#define PG8_WAIT_L(n) asm volatile("s_waitcnt lgkmcnt(" #n ")" ::: "memory")
#define PG8_BAR __builtin_amdgcn_s_barrier()
#define PG8_SCHED __builtin_amdgcn_sched_barrier(0)
    __builtin_amdgcn_sched_barrier(0);
    Unit cur, nxt; int ui = 0;
    if (!S.next(0, cur)) return;
    f32x4 acc[2][2][4][2];
#pragma unroll
    for (int a = 0; a < 2; ++a)
#pragma unroll
        for (int b = 0; b < 2; ++b)
#pragma unroll
            for (int m = 0; m < 4; ++m)
#pragma unroll
                for (int n = 0; n < 2; ++n) acc[a][b][m][n] = (f32x4){0.f, 0.f, 0.f, 0.f};
    bf16x8 At[4][2], B0[2][2], B1[2][2];
    const char* cA; const char* cB; { long long ao, bo; S.offs(cur, ao, bo); cA = (const char*)g.A + ao; cB = (const char*)g.Bt + bo; }
    S.a_ready(cur);
    if constexpr (SP2) {
        PG8_STAGE(PG8_SB(0, 0), cB, voffB); PG8_STAGE(PG8_SB(0, 1), cB + hstepB, voffB); PG8_STAGE(PG8_SA(0, 0), cA, voffA); PG8_STAGE(PG8_SA(0, 1), cA + hstepA, voffA);
        if (wr == 1) PG8_BAR;
        PG8_WAIT_V(2); PG8_BAR;
        PG8_STAGE(PG8_SB(1, 0), cB + kstep, voffB); PG8_STAGE(PG8_SA(1, 0), cA + kstep, voffA); PG8_STAGE(PG8_SB(1, 1), cB + hstepB + kstep, voffB);
        PG8_WAIT_V(6); PG8_BAR;
    } else {
        PG8_STAGE(PG8_SB(0, 0), cB, voffB); PG8_STAGE(PG8_SA(0, 0), cA, voffA); PG8_STAGE(PG8_SB(0, 1), cB + hstepB, voffB); PG8_STAGE(PG8_SA(0, 1), cA + hstepA, voffA);
        if (wr == 1) PG8_BAR;
        PG8_WAIT_V(4); PG8_BAR;
        PG8_STAGE(PG8_SB(1, 0), cB + kstep, voffB); PG8_STAGE(PG8_SA(1, 0), cA + kstep, voffA); PG8_STAGE(PG8_SB(1, 1), cB + hstepB + kstep, voffB);
        PG8_WAIT_V(6); PG8_BAR;
    }
    for (;;) {
        const bool has_next = S.next(ui + 1, nxt);
        const char* nA = cA; const char* nB = cB; if (has_next) { long long ao, bo; S.offs(nxt, ao, bo); nA = (const char*)g.A + ao; nB = (const char*)g.Bt + bo; }
#pragma nounroll
        for (int t = 0; t < nt; t += 2) {
            const bool last = (t == nt - 2);
            const char* a1 = cA + (size_t)(t + 1) * kstep;
            const char* a2 = last ? nA : cA + (size_t)(t + 2) * kstep; const char* b2 = last ? nB : cB + (size_t)(t + 2) * kstep;
            const char* a3 = a2 + kstep; const char* b3 = b2 + kstep;
            if (last && has_next) S.a_ready(nxt);
            if constexpr (SP2) {
            PG8_LDB(B0, 0, 0); PG8_LDB(B1, 0, 1); PG8_SCHED; PG8_LDA(At, 0, 0); PG8_STAGE(PG8_SA(1, 1), a1 + hstepA, voffA);
            PG8_WAIT_V(8); PG8_WAIT_L(0); PG8_BAR; PG8_MMA(0, 0, At, B0); PG8_MMA(0, 1, At, B1); PG8_BAR; PG8_SCHED;
            PG8_LDA(At, 0, 1); PG8_STAGE(PG8_SB(0, 0), b2, voffB); PG8_STAGE(PG8_SB(0, 1), b2 + hstepB, voffB); PG8_STAGE(PG8_SA(0, 0), a2, voffA);
            PG8_WAIT_V(8); PG8_WAIT_L(0); PG8_BAR; PG8_MMA(1, 0, At, B0); PG8_MMA(1, 1, At, B1); PG8_BAR; PG8_SCHED;
            PG8_LDB(B0, 1, 0); PG8_LDB(B1, 1, 1); PG8_SCHED; PG8_LDA(At, 1, 0); PG8_STAGE(PG8_SA(0, 1), a2 + hstepA, voffA);
            PG8_WAIT_V(8); PG8_WAIT_L(0); PG8_BAR; PG8_MMA(0, 0, At, B0); PG8_MMA(0, 1, At, B1); PG8_BAR; PG8_SCHED;
            PG8_LDA(At, 1, 1); PG8_STAGE(PG8_SB(1, 0), b3, voffB); PG8_STAGE(PG8_SB(1, 1), b3 + hstepB, voffB); PG8_STAGE(PG8_SA(1, 0), a3, voffA);
            PG8_WAIT_V(8); PG8_WAIT_L(0); PG8_BAR; PG8_MMA(1, 0, At, B0); PG8_MMA(1, 1, At, B1); PG8_BAR; PG8_SCHED;
            } else {
            PG8_LDB(B0, 0, 0); PG8_SCHED; PG8_LDA(At, 0, 0); PG8_STAGE(PG8_SA(1, 1), a1 + hstepA, voffA);
            PG8_WAIT_L(8); PG8_BAR; PG8_WAIT_L(0); PG8_MMA(0, 0, At, B0); PG8_BAR; PG8_SCHED;
            PG8_LDB(B1, 0, 1); PG8_STAGE(PG8_SB(0, 0), b2, voffB);
            PG8_BAR; PG8_WAIT_L(0); PG8_MMA(0, 1, At, B1); PG8_BAR;
            PG8_LDA(At, 0, 1); PG8_STAGE(PG8_SA(0, 0), a2, voffA);
            PG8_BAR; PG8_WAIT_L(0); PG8_MMA(1, 0, At, B0); PG8_BAR; PG8_SCHED;
            PG8_STAGE(PG8_SB(0, 1), b2 + hstepB, voffB);
            PG8_WAIT_V(6); PG8_BAR; PG8_MMA(1, 1, At, B1); PG8_BAR;
            PG8_LDB(B0, 1, 0); PG8_SCHED; PG8_LDA(At, 1, 0); PG8_STAGE(PG8_SA(0, 1), a2 + hstepA, voffA);
            PG8_WAIT_L(8); PG8_BAR; PG8_WAIT_L(0); PG8_MMA(0, 0, At, B0); PG8_BAR; PG8_SCHED;
            PG8_LDB(B1, 1, 1); PG8_STAGE(PG8_SB(1, 0), b3, voffB);
            PG8_BAR; PG8_WAIT_L(0); PG8_MMA(0, 1, At, B1); PG8_BAR;
            PG8_LDA(At, 1, 1); PG8_STAGE(PG8_SA(1, 0), a3, voffA);
            PG8_BAR; PG8_WAIT_L(0); PG8_MMA(1, 0, At, B0); PG8_BAR; PG8_SCHED;
            PG8_STAGE(PG8_SB(1, 1), b3 + hstepB, voffB);
            PG8_WAIT_V(6); PG8_BAR; PG8_MMA(1, 1, At, B1); PG8_BAR;
            }
        }
        if constexpr (ALIGN_EPI) { if (wr == 0) PG8_BAR; }
        E(acc, cur, wr, wc, fr, fq, lds);
        if (!has_next) break;
#pragma unroll
        for (int a = 0; a < 2; ++a)
#pragma unroll
            for (int b = 0; b < 2; ++b)
#pragma unroll
                for (int m = 0; m < 4; ++m)
#pragma unroll
                    for (int n = 0; n < 2; ++n) acc[a][b][m][n] = (f32x4){0.f, 0.f, 0.f, 0.f};
        cur = nxt; cA = nA; cB = nB; ++ui;
        if constexpr (ALIGN_EPI) { if (wr == 1) PG8_BAR; }
    }
    PG8_WAIT_V(0);
    if constexpr (!ALIGN_EPI) { if (wr == 0) PG8_BAR; }
    PG8_BAR;
    PG8_SCHED;
#undef PG8_SA
#undef PG8_SB
#undef PG8_STAGE
#undef PG8_LDA
#undef PG8_LDB
#undef PG8_MMA
#undef PG8_WAIT_V
#undef PG8_WAIT_L
#undef PG8_BAR
#undef PG8_SCHED
}

template <class Epi, class Sched>
__device__ __forceinline__ void gemm_phase_gather(LAS unsigned char* lds, const Gemm g, const Sched& S, const Epi& E, const int* tok) {
    const int tid = opaque_tid(), wid = __builtin_amdgcn_readfirstlane(tid >> 6), lane = tid & 63, wr = wid >> 2, wc = wid & 3, fr = lane & 15, fq = lane >> 4;
    const int K = g.K, nt = K / BK;
    unsigned voffB[2]; int rA[2], cA2[2];
#pragma unroll
    for (int i = 0; i < 2; ++i) { int R, C; stage_rc(tid * 16 + i * 8192, R, C); const int Rb = Epi::PERM ? ((R & ~31) + perm32(R & 31)) : R; rA[i] = R; cA2[i] = C * 2; voffB[i] = (unsigned)(Rb * g.ldb + C) * 2u; }
    const size_t kstep = (size_t)(BK * 2); const size_t hstepB = (size_t)HALF * g.ldb * 2;
    const unsigned ldsw = (unsigned)wid * 1024u;
    const int aoff = lds_byte(wr * 64 + fr, fq * 8), boff = lds_byte(wc * 32 + fr, fq * 8);
#define PG8_SA(b, h) (((b) * 2 + (h)) * HTB)
#define PG8_SB(b, h) ((4 + (b) * 2 + (h)) * HTB)
#define PG8_STAGE(bufoff, gbase, voff) do { _Pragma("unroll") for (int _i = 0; _i < 2; ++_i) \
        __builtin_amdgcn_global_load_lds((const unsigned*)((const char*)(gbase) + (voff)[_i]), (LAS unsigned*)(lds + (bufoff) + ldsw + _i * 8192), 16, 0, 0); } while (0)
#define PG8_STAGEA(bufoff, go_, kb_) do { _Pragma("unroll") for (int _i = 0; _i < 2; ++_i) \
        __builtin_amdgcn_global_load_lds((const unsigned*)((const char*)g.A + (go_)[_i] + (kb_)), (LAS unsigned*)(lds + (bufoff) + ldsw + _i * 8192), 16, 0, 0); } while (0)
#define PG8_LDA(dst, b, h) do { _Pragma("unroll") for (int m = 0; m < 4; ++m) _Pragma("unroll") for (int k = 0; k < 2; ++k) dst[m][k] = *(const LAS bf16x8*)(lds + PG8_SA(b, h) + aoff + m * 2048 + k * 1024); } while (0)
#define PG8_LDB(dst, b, h) do { _Pragma("unroll") for (int n = 0; n < 2; ++n) _Pragma("unroll") for (int k = 0; k < 2; ++k) dst[n][k] = *(const LAS bf16x8*)(lds + PG8_SB(b, h) + boff + n * 2048 + k * 1024); } while (0)
#define PG8_MMA(ai, bj, At, Bt) do { __builtin_amdgcn_s_setprio(1); _Pragma("unroll") for (int m = 0; m < 4; ++m) _Pragma("unroll") for (int n = 0; n < 2; ++n) _Pragma("unroll") for (int k = 0; k < 2; ++k) \
        acc[ai][bj][m][n] = __builtin_amdgcn_mfma_f32_16x16x32_bf16(Bt[n][k], At[m][k], acc[ai][bj][m][n], 0, 0, 0); __builtin_amdgcn_s_setprio(0); } while (0)
#define PG8_WAIT_V(n) asm volatile("s_waitcnt vmcnt(" #n ")" ::: "memory")
#define PG8_WAIT_L(n) asm volatile("s_waitcnt lgkmcnt(" #n ")" ::: "memory")
#define PG8_BAR __builtin_amdgcn_s_barrier()
#define PG8_SCHED __builtin_amdgcn_sched_barrier(0)
#define PG8_GOFF(dst, u_) do { _Pragma("unroll") for (int _h = 0; _h < 2; ++_h) _Pragma("unroll") for (int _i = 0; _i < 2; ++_i) \
        dst[_h][_i] = (unsigned)tok[(u_).pm * 256 + _h * 128 + rA[_i]] * (unsigned)(g.lda * 2) + (unsigned)cA2[_i]; } while (0)
    __builtin_amdgcn_sched_barrier(0);
    Unit cur, nxt; int ui = 0;
    if (!S.next(0, cur)) return;
    f32x4 acc[2][2][4][2];
#pragma unroll
    for (int a = 0; a < 2; ++a)
#pragma unroll
        for (int b = 0; b < 2; ++b)
#pragma unroll
            for (int m = 0; m < 4; ++m)
#pragma unroll
                for (int n = 0; n < 2; ++n) acc[a][b][m][n] = (f32x4){0.f, 0.f, 0.f, 0.f};
    bf16x8 At[4][2], B0[2][2], B1[2][2];
    unsigned goC[2][2], goN[2][2];
    PG8_GOFF(goC, cur);
    const char* cB; { long long ao, bo; S.offs(cur, ao, bo); cB = (const char*)g.Bt + bo; }
    PG8_STAGE(PG8_SB(0, 0), cB, voffB); PG8_STAGE(PG8_SB(0, 1), cB + hstepB, voffB); PG8_STAGEA(PG8_SA(0, 0), goC[0], 0); PG8_STAGEA(PG8_SA(0, 1), goC[1], 0);
    if (wr == 1) PG8_BAR;
    PG8_WAIT_V(2); PG8_BAR;
    PG8_STAGE(PG8_SB(1, 0), cB + kstep, voffB); PG8_STAGEA(PG8_SA(1, 0), goC[0], kstep); PG8_STAGE(PG8_SB(1, 1), cB + hstepB + kstep, voffB);
    PG8_WAIT_V(6); PG8_BAR;
    for (;;) {
        const bool has_next = S.next(ui + 1, nxt);
        const char* nB = cB; if (has_next) { long long ao, bo; S.offs(nxt, ao, bo); nB = (const char*)g.Bt + bo; PG8_GOFF(goN, nxt); }
        else {
#pragma unroll
            for (int _h = 0; _h < 2; ++_h)
#pragma unroll
                for (int _i = 0; _i < 2; ++_i) goN[_h][_i] = goC[_h][_i]; }
#pragma nounroll
        for (int t = 0; t < nt; t += 2) {
            const bool last = (t == nt - 2);
            const size_t k1 = (size_t)(t + 1) * kstep, k2 = last ? 0 : (size_t)(t + 2) * kstep, k3 = k2 + kstep;
            const char* b2 = last ? nB : cB + (size_t)(t + 2) * kstep; const char* b3 = b2 + kstep;
            unsigned g2[2][2];
#pragma unroll
            for (int _h = 0; _h < 2; ++_h)
#pragma unroll
                for (int _i = 0; _i < 2; ++_i) g2[_h][_i] = last ? goN[_h][_i] : goC[_h][_i];
            PG8_LDB(B0, 0, 0); PG8_LDB(B1, 0, 1); PG8_SCHED; PG8_LDA(At, 0, 0); PG8_STAGEA(PG8_SA(1, 1), goC[1], k1);
            PG8_WAIT_V(8); PG8_WAIT_L(0); PG8_BAR; PG8_MMA(0, 0, At, B0); PG8_MMA(0, 1, At, B1); PG8_BAR; PG8_SCHED;
            PG8_LDA(At, 0, 1); PG8_STAGE(PG8_SB(0, 0), b2, voffB); PG8_STAGE(PG8_SB(0, 1), b2 + hstepB, voffB); PG8_STAGEA(PG8_SA(0, 0), g2[0], k2);
            PG8_WAIT_V(8); PG8_WAIT_L(0); PG8_BAR; PG8_MMA(1, 0, At, B0); PG8_MMA(1, 1, At, B1); PG8_BAR; PG8_SCHED;
            PG8_LDB(B0, 1, 0); PG8_LDB(B1, 1, 1); PG8_SCHED; PG8_LDA(At, 1, 0); PG8_STAGEA(PG8_SA(0, 1), g2[1], k2);
            PG8_WAIT_V(8); PG8_WAIT_L(0); PG8_BAR; PG8_MMA(0, 0, At, B0); PG8_MMA(0, 1, At, B1); PG8_BAR; PG8_SCHED;
            PG8_LDA(At, 1, 1); PG8_STAGE(PG8_SB(1, 0), b3, voffB); PG8_STAGE(PG8_SB(1, 1), b3 + hstepB, voffB); PG8_STAGEA(PG8_SA(1, 0), g2[0], k3);
            PG8_WAIT_V(8); PG8_WAIT_L(0); PG8_BAR; PG8_MMA(1, 0, At, B0); PG8_MMA(1, 1, At, B1); PG8_BAR; PG8_SCHED;
        }
        if (wr == 0) PG8_BAR;
        E(acc, cur, wr, wc, fr, fq, lds);
        if (!has_next) break;
#pragma unroll
        for (int a = 0; a < 2; ++a)
#pragma unroll
            for (int b = 0; b < 2; ++b)
#pragma unroll
                for (int m = 0; m < 4; ++m)
#pragma unroll
                    for (int n = 0; n < 2; ++n) acc[a][b][m][n] = (f32x4){0.f, 0.f, 0.f, 0.f};
        cur = nxt; cB = nB; ++ui;
#pragma unroll
        for (int _h = 0; _h < 2; ++_h)
#pragma unroll
            for (int _i = 0; _i < 2; ++_i) goC[_h][_i] = goN[_h][_i];
        if (wr == 1) PG8_BAR;
    }
    PG8_WAIT_V(0);
    PG8_BAR;
    PG8_SCHED;
#undef PG8_SA
#undef PG8_SB
#undef PG8_STAGE
#undef PG8_STAGEA
#undef PG8_LDA
#undef PG8_LDB
#undef PG8_MMA
#undef PG8_WAIT_V
#undef PG8_WAIT_L
#undef PG8_BAR
#undef PG8_SCHED
#undef PG8_GOFF
}
}
using pg8::Unit;
typedef const f32x4 (&AccRef)[2][2][4][2];

struct SchedPlain : pg8::OrderCore {
    long long astr, bstr;
    __device__ __forceinline__ bool next(int i, Unit& u) const { return map(i, u.pm, u.pn); }
    __device__ __forceinline__ void offs(const Unit& u, long long& ao, long long& bo) const { ao = (long long)u.pm * astr; bo = (long long)u.pn * bstr; }
};
struct SchedRange : pg8::OrderCore {
    long long astr, bstr; int base, count;
    __device__ __forceinline__ bool next(int i, Unit& u) const { const long L = (long)i * G + c; if (c < 0 || L >= count) return false; return map_lin(base + L, u.pm, u.pn); }
    __device__ __forceinline__ void offs(const Unit& u, long long& ao, long long& bo) const { ao = (long long)u.pm * astr; bo = (long long)u.pn * bstr; }
};
struct SchedHP : pg8::OrderCore {
    __device__ __forceinline__ bool next(int i, Unit& u) const { return map(i, u.pm, u.pn); }
    __device__ __forceinline__ void offs(const Unit& u, long long& ao, long long& bo) const {
        ao = ((long long)(u.pm >> 5) * (S + 1) + (long long)(u.pm & 31) * 256) * (D * 2); bo = (long long)u.pn * 256 * (2 * D) * 2; }
};
struct SchedRKV : pg8::OrderCore {
    long long aoff0, aoff1;
    __device__ __forceinline__ bool next(int i, Unit& u) const { return map(i, u.pm, u.pn); }
    __device__ __forceinline__ void offs(const Unit& u, long long& ao, long long& bo) const {
        const int t = u.pn >> 2; long long base = aoff1 + (long long)(t - 1) * ((long long)T * D * 2); if (t == 0) base = aoff0; ao = base + (long long)u.pm * 256 * D * 2; bo = (long long)u.pn * 256 * D * 2; }
};
struct SchedMoE : pg8::OrderCore {
    const int* tile_expert; int mode;
    __device__ __forceinline__ bool next(int i, Unit& u) const { return map(i, u.pm, u.pn); }
    __device__ __forceinline__ void offs(const Unit& u, long long& ao, long long& bo) const {
        const int e = tile_expert[u.pm];
        if (mode == 0) { ao = (long long)u.pm * 256 * D * 2; bo = ((long long)e * 512 + u.pn * 256) * D * 2; }
        else { ao = (long long)u.pm * 256 * 256 * 2; bo = ((long long)e * 1024 + u.pn * 256) * 256 * 2; } }
};

__device__ __forceinline__ u32x4 pack8v4(const f32x4 v0, const f32x4 v1) { u32x4 w; w.x = cvt_pk_c(v0[0], v0[1]); w.y = cvt_pk_c(v0[2], v0[3]); w.z = cvt_pk_c(v1[0], v1[1]); w.w = cvt_pk_c(v1[2], v1[3]); return w; }
__device__ __forceinline__ u32x4 pack8(const f32x4 v0, const f32x4 v1) { u32x4 w; w.x = cvt_pk_c(v0[0], v0[1]); w.y = cvt_pk_c(v0[2], v0[3]); w.z = cvt_pk_c(v1[0], v1[1]); w.w = cvt_pk_c(v1[2], v1[3]); return w; }

struct EpiCat {
    static constexpr bool PERM = true;
    bf16_t *R, *L; long long tstride; int pn_off;
    __device__ __forceinline__ void operator()(AccRef acc, const Unit& u, int wr, int wc, int fr, int fq, LAS unsigned char*) const {
        const int row0 = u.pm * 256 + wr * 64 + fr; const int pn = u.pn + pn_off;
        if (pn < 12) {
            const int t = pn >> 2; bf16_t* base = R + (long long)t * tstride; const int col0 = (pn & 3) * 256 + wc * 32 + 8 * fq;
#pragma unroll
            for (int ai = 0; ai < 2; ++ai)
#pragma unroll
                for (int m = 0; m < 4; ++m) { bf16_t* rowp = base + (size_t)(row0 + ai * 128 + m * 16) * D + col0;
#pragma unroll
                    for (int bj = 0; bj < 2; ++bj) *(u32x4*)(rowp + bj * 128) = pack8(acc[ai][bj][m][0], acc[ai][bj][m][1]); }
        } else {
            const int ct = wc * 32 + 8 * fq, lcol0 = (pn - 12) * 256 + ct;
#pragma unroll
            for (int ai = 0; ai < 2; ++ai)
#pragma unroll
                for (int m = 0; m < 4; ++m) { bf16_t* rowp = L + (size_t)(row0 + ai * 128 + m * 16) * 512 + lcol0;
#pragma unroll
                    for (int bj = 0; bj < 2; ++bj) { f32x4 v0 = acc[ai][bj][m][0], v1 = acc[ai][bj][m][1];
                        const int mode = (pn == 13) ? 2 : ((ct + bj * 128) < 64 ? 1 : 0);
                        if (mode == 1) {
#pragma unroll
                            for (int j = 0; j < 4; ++j) { v0[j] = fast_tanh(v0[j]); v1[j] = fast_tanh(v1[j]); } }
                        else if (mode == 2) {
#pragma unroll
                            for (int j = 0; j < 4; ++j) { v0[j] = fast_sigmoid(v0[j]); v1[j] = fast_sigmoid(v1[j]); } }
                        *(u32x4*)(rowp + bj * 128) = pack8(v0, v1); } }
        }
    }
};
struct EpiAct {
    static constexpr bool PERM = true;
    bf16_t* O0; long long ostride; const float* bias0; long long bstride; float sc0, dsc;
    __device__ __forceinline__ void operator()(AccRef acc, const Unit& u, int wr, int wc, int fr, int fq, LAS unsigned char*) const {
        const int t = u.pn >> 2; const int row0 = u.pm * 256 + wr * 64 + fr, col0 = (u.pn & 3) * 256 + wc * 32 + 8 * fq;
        bf16_t* base = O0 + (long long)t * ostride; const float* bs = bias0 + (long long)t * bstride;
        f32x4 bv[2][2];
#pragma unroll
        for (int bj = 0; bj < 2; ++bj)
#pragma unroll
            for (int n = 0; n < 2; ++n) bv[bj][n] = bias0 ? *(const f32x4*)(bs + col0 + bj * 128 + 4 * n) : (f32x4){0.f, 0.f, 0.f, 0.f};
#pragma unroll
        for (int ai = 0; ai < 2; ++ai)
#pragma unroll
            for (int m = 0; m < 4; ++m) { bf16_t* rowp = base + (size_t)(row0 + ai * 128 + m * 16) * D + col0;
#pragma unroll
                for (int bj = 0; bj < 2; ++bj) { f32x4 v0 = acc[ai][bj][m][0] + bv[bj][0], v1 = acc[ai][bj][m][1] + bv[bj][1];
                    if (bias0) { const float sc = sc0 + (float)t * dsc;
#pragma unroll
                        for (int j = 0; j < 4; ++j) { v0[j] = sc * fast_sigmoid(v0[j]); v1[j] = sc * fast_sigmoid(v1[j]); } }
                    *(u32x4*)(rowp + bj * 128) = pack8(v0, v1); } }
    }
};
struct EpiResid {
    static constexpr bool PERM = true;
    const float* resid_f32; bf16_t* xb; float* ssq; float bscale;
    __device__ __forceinline__ void operator()(AccRef acc, const Unit& u, int wr, int wc, int fr, int fq, LAS unsigned char*) const {
        const int row0 = u.pm * 256 + wr * 64 + fr, col0 = u.pn * 256 + wc * 32 + 8 * fq;
        if (resid_f32) {
#pragma unroll
            for (int bt = 0; bt < 4; ++bt) { f32x4 rr[2][2][2];
#pragma unroll
                for (int mm = 0; mm < 2; ++mm)
#pragma unroll
                    for (int bj = 0; bj < 2; ++bj) { const size_t off = (size_t)(row0 + (bt >> 1) * 128 + ((bt & 1) * 2 + mm) * 16) * D + col0 + bj * 128;
                        rr[mm][bj][0] = *(const f32x4*)(resid_f32 + off); rr[mm][bj][1] = *(const f32x4*)(resid_f32 + off + 4); }
                float s[2];
#pragma unroll
                for (int mm = 0; mm < 2; ++mm) { const int ai = bt >> 1, m = (bt & 1) * 2 + mm; const size_t off = (size_t)(row0 + ai * 128 + m * 16) * D + col0; s[mm] = 0.f;
#pragma unroll
                    for (int bj = 0; bj < 2; ++bj) { const f32x4 o0 = rr[mm][bj][0] + acc[ai][bj][m][0] * bscale, o1 = rr[mm][bj][1] + acc[ai][bj][m][1] * bscale;
                        *(u32x4*)(xb + off + bj * 128) = pack8(o0, o1);
                        s[mm] += ((o0[0] * o0[0] + o0[1] * o0[1]) + (o0[2] * o0[2] + o0[3] * o0[3])) + ((o1[0] * o1[0] + o1[1] * o1[1]) + (o1[2] * o1[2] + o1[3] * o1[3])); } }
#pragma unroll
                for (int mm = 0; mm < 2; ++mm) { s[mm] += __shfl_xor(s[mm], 16); s[mm] += __shfl_xor(s[mm], 32);
                    if (fq == 0) ssq[(size_t)(row0 + (bt >> 1) * 128 + ((bt & 1) * 2 + mm) * 16) * 16 + u.pn * 4 + wc] = s[mm]; }
                asm volatile("" ::: "memory"); }
        } else {
#define ER_LOAD(R_, q_) do { _Pragma("unroll") for (int mm = 0; mm < 2; ++mm) _Pragma("unroll") for (int bj = 0; bj < 2; ++bj) \
            R_[mm][bj] = *(const u32x4*)(xb + (size_t)(row0 + ((q_) >> 1) * 128 + (((q_) & 1) * 2 + mm) * 16) * D + col0 + bj * 128); } while (0)
#define ER_PROC(R_, q_) do { float s[2]; \
            _Pragma("unroll") for (int mm = 0; mm < 2; ++mm) { const int ai = (q_) >> 1, m = ((q_) & 1) * 2 + mm; const size_t off = (size_t)(row0 + ai * 128 + m * 16) * D + col0; s[mm] = 0.f; \
                _Pragma("unroll") for (int bj = 0; bj < 2; ++bj) { const u32x4 w = R_[mm][bj]; \
                    const f32x4 r0 = (f32x4){bf_lo(w.x), bf_hi(w.x), bf_lo(w.y), bf_hi(w.y)}, r1 = (f32x4){bf_lo(w.z), bf_hi(w.z), bf_lo(w.w), bf_hi(w.w)}; \
                    const f32x4 o0 = r0 + acc[ai][bj][m][0] * bscale, o1 = r1 + acc[ai][bj][m][1] * bscale; \
                    *(u32x4*)(xb + off + bj * 128) = pack8(o0, o1); \
                    s[mm] += ((o0[0] * o0[0] + o0[1] * o0[1]) + (o0[2] * o0[2] + o0[3] * o0[3])) + ((o1[0] * o1[0] + o1[1] * o1[1]) + (o1[2] * o1[2] + o1[3] * o1[3])); } } \
            _Pragma("unroll") for (int mm = 0; mm < 2; ++mm) { s[mm] += __shfl_xor(s[mm], 16); s[mm] += __shfl_xor(s[mm], 32); \
                if (fq == 0) ssq[(size_t)(row0 + ((q_) >> 1) * 128 + (((q_) & 1) * 2 + mm) * 16) * 16 + u.pn * 4 + wc] = s[mm]; } \
            asm volatile("" ::: "memory"); } while (0)
            u32x4 rA[2][2], rB[2][2];
            ER_LOAD(rA, 0); ER_LOAD(rB, 1); asm volatile("" ::: "memory");
            ER_PROC(rA, 0); ER_LOAD(rA, 2); asm volatile("" ::: "memory");
            ER_PROC(rB, 1); ER_LOAD(rB, 3); asm volatile("" ::: "memory");
            ER_PROC(rA, 2); ER_PROC(rB, 3);
#undef ER_LOAD
#undef ER_PROC
        }
    }
};
__device__ __forceinline__ void rows_rstd(const float* ssq, int row0, int fq, float (&rs)[2][4]) {
    f32x4 part[2][4];
#pragma unroll
    for (int ai = 0; ai < 2; ++ai)
#pragma unroll
        for (int m = 0; m < 4; ++m) part[ai][m] = *(const f32x4*)(ssq + (size_t)(row0 + ai * 128 + m * 16) * 16 + fq * 4);
#pragma unroll
    for (int ai = 0; ai < 2; ++ai)
#pragma unroll
        for (int m = 0; m < 4; ++m) { float sm = (part[ai][m][0] + part[ai][m][1]) + (part[ai][m][2] + part[ai][m][3]); sm += __shfl_xor(sm, 16); sm += __shfl_xor(sm, 32);
            rs[ai][m] = __builtin_amdgcn_rsqf(sm * (1.0f / D) + NORM_EPS); }
}
struct EpiRstd {
    static constexpr bool PERM = true;
    bf16_t* O0; long long tstride; const float* ssq;
    __device__ __forceinline__ void operator()(AccRef acc, const Unit& u, int wr, int wc, int fr, int fq, LAS unsigned char*) const {
        const int t = u.pn >> 2; bf16_t* base = O0 + (long long)t * tstride;
        const int row0 = u.pm * 256 + wr * 64 + fr, col0 = (u.pn & 3) * 256 + wc * 32 + 8 * fq;
        float rs[2][4]; rows_rstd(ssq, row0, fq, rs);
#pragma unroll
        for (int ai = 0; ai < 2; ++ai)
#pragma unroll
            for (int m = 0; m < 4; ++m) { const int row = row0 + ai * 128 + m * 16; const float rstd = rs[ai][m];
                bf16_t* rowp = base + (size_t)row * D + col0;
#pragma unroll
                for (int bj = 0; bj < 2; ++bj) *(u32x4*)(rowp + bj * 128) = pack8(acc[ai][bj][m][0] * rstd, acc[ai][bj][m][1] * rstd); }
    }
};
struct EpiSwiGLU {
    static constexpr bool PERM = true;
    bf16_t* H; const float* slot_info;
    __device__ __forceinline__ void operator()(AccRef acc, const Unit& u, int wr, int wc, int fr, int fq, LAS unsigned char*) const {
        const int row0 = u.pm * 256 + wr * 64 + fr, col0 = u.pn * 128 + wc * 32 + 8 * fq;
        float rs[2][4];
#pragma unroll
        for (int ai = 0; ai < 2; ++ai)
#pragma unroll
            for (int m = 0; m < 4; ++m) rs[ai][m] = slot_info[(size_t)(row0 + ai * 128 + m * 16) * 2 + 1];
#pragma unroll
        for (int ai = 0; ai < 2; ++ai)
#pragma unroll
            for (int m = 0; m < 4; ++m) { const int row = row0 + ai * 128 + m * 16; const float rstd = rs[ai][m];
                f32x4 h0, h1;
#pragma unroll
                for (int j = 0; j < 4; ++j) { const float g0 = acc[ai][0][m][0][j] * rstd, g1 = acc[ai][0][m][1][j] * rstd;
                    h0[j] = g0 * fast_sigmoid(g0) * (acc[ai][1][m][0][j] * rstd); h1[j] = g1 * fast_sigmoid(g1) * (acc[ai][1][m][1][j] * rstd); }
                *(u32x4*)(H + (size_t)row * 256 + col0) = pack8(h0, h1); }
    }
};
struct EpiGate {
    static constexpr bool PERM = true;
    bf16_t* Y; const float* slot_info;
    __device__ __forceinline__ void operator()(AccRef acc, const Unit& u, int wr, int wc, int fr, int fq, LAS unsigned char*) const {
        const int row0 = u.pm * 256 + wr * 64 + fr, col0 = u.pn * 256 + wc * 32 + 8 * fq;
        float gts[2][4];
#pragma unroll
        for (int ai = 0; ai < 2; ++ai)
#pragma unroll
            for (int m = 0; m < 4; ++m) gts[ai][m] = slot_info[(size_t)(row0 + ai * 128 + m * 16) * 2];
#pragma unroll
        for (int ai = 0; ai < 2; ++ai)
#pragma unroll
            for (int m = 0; m < 4; ++m) { const int row = row0 + ai * 128 + m * 16; const float gt = gts[ai][m];
                bf16_t* rowp = Y + (size_t)row * D + col0;
#pragma unroll
                for (int bj = 0; bj < 2; ++bj) *(u32x4*)(rowp + bj * 128) = pack8(acc[ai][bj][m][0] * gt, acc[ai][bj][m][1] * gt); }
    }
};
struct EpiMemKV {
    static constexpr bool PERM = true;
    bf16_t* KM; bf16_t* VM;
    __device__ __forceinline__ void operator()(AccRef acc, const Unit& u, int wr, int wc, int fr, int fq, LAS unsigned char*) const {
        const int l = u.pm >> 3, prow0 = (u.pm & 7) * 256 + wr * 64 + fr, ct0 = u.pn * 256 + wc * 32 + 8 * fq;
#pragma unroll
        for (int ai = 0; ai < 2; ++ai)
#pragma unroll
            for (int m = 0; m < 4; ++m) { const int row = prow0 + ai * 128 + m * 16;
#pragma unroll
                for (int bj = 0; bj < 2; ++bj) { const int col = ct0 + bj * 128; bf16_t* dst = (col < 1024 ? KM : VM - 1024) + ((size_t)l * 2048 + row) * D + col;
                    *(u32x4*)dst = pack8(acc[ai][bj][m][0], acc[ai][bj][m][1]); } }
    }
};
struct SchedMemKV : pg8::OrderCore {
    __device__ __forceinline__ bool next(int i, Unit& u) const { return map(i, u.pm, u.pn); }
    __device__ __forceinline__ void offs(const Unit& u, long long& ao, long long& bo) const { ao = (long long)(u.pm & 7) * 256 * D * 2; bo = ((long long)(u.pm >> 3) * 2048 + u.pn * 256) * D * 2; }
};

struct SchedMemPre : pg8::OrderCore {
    int mode;
    __device__ __forceinline__ bool next(int i, Unit& u) const { return map(i, u.pm, u.pn); }
    __device__ __forceinline__ void offs(const Unit& u, long long& ao, long long& bo) const {
        const int lb = u.pm >> 2, q = u.pm & 3, l = lb >> 3;
        if (mode == 0) { ao = ((long long)lb * 256 * D + q * 256) * 2; bo = ((long long)l * D * D + (long long)u.pn * 256 * D + q * 256) * 2; }
        else { ao = ((long long)l * D * D + (long long)q * 256 * D + u.pn * 256) * 2; bo = ((long long)lb * 256 * D + u.pn * 256) * 2; } }
};
struct EpiMemPre {
    static constexpr bool PERM = true;
    bf16_t* O;
    __device__ __forceinline__ void operator()(AccRef acc, const Unit& u, int wr, int wc, int fr, int fq, LAS unsigned char*) const {
        const int row0 = (u.pm >> 2) * 1024 + (u.pm & 3) * 256 + wr * 64 + fr, col0 = u.pn * 256 + wc * 32 + 8 * fq;
#pragma unroll
        for (int ai = 0; ai < 2; ++ai)
#pragma unroll
            for (int m = 0; m < 4; ++m) { bf16_t* rowp = O + (size_t)(row0 + ai * 128 + m * 16) * D + col0;
#pragma unroll
                for (int bj = 0; bj < 2; ++bj) *(u32x4*)(rowp + bj * 128) = pack8(acc[ai][bj][m][0], acc[ai][bj][m][1]); }
    }
};
struct SchedBatchB : pg8::OrderCore {
    __device__ __forceinline__ bool next(int i, Unit& u) const { return map(i, u.pm, u.pn); }
    __device__ __forceinline__ void offs(const Unit& u, long long& ao, long long& bo) const { ao = (long long)u.pm * 256 * D * 2; bo = ((long long)(u.pm >> 5) * 1024 + u.pn * 256) * D * 2; }
};
struct EpiSoftmax {
    static constexpr bool PERM = true;
    bf16_t* P; const float* ssq;
    __device__ __forceinline__ void operator()(AccRef acc_c, const Unit& u, int wr, int wc, int fr, int fq, LAS unsigned char* lds) const {
        f32x4 (&acc)[2][2][4][2] = const_cast<f32x4 (&)[2][2][4][2]>(acc_c);
        LAS f32x2* ex = (LAS f32x2*)(lds + LDS_EPI);
        float rs[2][4]; rows_rstd(ssq, u.pm * 256 + wr * 64 + fr, fq, rs);
#pragma unroll
        for (int ai = 0; ai < 2; ++ai)
#pragma unroll
            for (int m = 0; m < 4; ++m) { const int rl = ai * 128 + wr * 64 + m * 16 + fr; const float rstd = rs[ai][m];
                float mx = -3.0e38f;
#pragma unroll
                for (int bj = 0; bj < 2; ++bj)
#pragma unroll
                    for (int n = 0; n < 2; ++n) { acc[ai][bj][m][n] = acc[ai][bj][m][n] * rstd; mx = fmaxf(mx, fmaxf(fmaxf(acc[ai][bj][m][n][0], acc[ai][bj][m][n][1]), fmaxf(acc[ai][bj][m][n][2], acc[ai][bj][m][n][3]))); }
                mx = fmaxf(mx, __shfl_xor(mx, 16)); mx = fmaxf(mx, __shfl_xor(mx, 32));
                float sm = 0.f;
#pragma unroll
                for (int bj = 0; bj < 2; ++bj)
#pragma unroll
                    for (int n = 0; n < 2; ++n) {
#pragma unroll
                        for (int j = 0; j < 4; ++j) { const float pj = __builtin_amdgcn_exp2f(acc[ai][bj][m][n][j] - mx); acc[ai][bj][m][n][j] = pj; sm += pj; } }
                sm += __shfl_xor(sm, 16); sm += __shfl_xor(sm, 32);
                if (fq == 0) ex[rl * 4 + wc] = (f32x2){mx, sm}; }
        lds_barrier();
#pragma unroll
        for (int ai = 0; ai < 2; ++ai)
#pragma unroll
            for (int m = 0; m < 4; ++m) { const int rl = ai * 128 + wr * 64 + m * 16 + fr;
                const f32x4 e01 = *(const LAS f32x4*)(ex + rl * 4), e23 = *(const LAS f32x4*)(ex + rl * 4 + 2);
                const float gm = fmaxf(fmaxf(e01[0], e01[2]), fmaxf(e23[0], e23[2]));
                const float tot = (e01[1] * __builtin_amdgcn_exp2f(e01[0] - gm) + e01[3] * __builtin_amdgcn_exp2f(e01[2] - gm)) + (e23[1] * __builtin_amdgcn_exp2f(e23[0] - gm) + e23[3] * __builtin_amdgcn_exp2f(e23[2] - gm));
                const float own = wc == 0 ? e01[0] : wc == 1 ? e01[2] : wc == 2 ? e23[0] : e23[2];
                const float f = __builtin_amdgcn_exp2f(own - gm) * __builtin_amdgcn_rcpf(tot);
                bf16_t* rowp = P + (size_t)(u.pm * 256 + rl) * D + u.pn * 256 + wc * 32 + 8 * fq;
#pragma unroll
                for (int bj = 0; bj < 2; ++bj) *(u32x4*)(rowp + bj * 128) = pack8(acc[ai][bj][m][0] * f, acc[ai][bj][m][1] * f); }
    }
};
struct EpiRouter {
    static constexpr bool PERM = true;
    const float* ssq; const float* brg; const float* bre; u32x4* tok;
    __device__ __forceinline__ void operator()(AccRef acc, const Unit& u, int wr, int wc, int fr, int fq, LAS unsigned char* lds) const {
        LAS f32x4* gl = (LAS f32x4*)(lds + LDS_EPI); LAS int* lc = (LAS int*)(lds + LDS_EPI + 4096);
        auto row_rstd = [&](int row) { const f32x4* sp = (const f32x4*)(ssq + (size_t)row * 16); const f32x4 s4 = (sp[0] + sp[1]) + (sp[2] + sp[3]);
            return __builtin_amdgcn_rsqf(((s4[0] + s4[1]) + (s4[2] + s4[3])) * (1.0f / D) + NORM_EPS); };
        if (wc == 1 && fq == 0) { const f32x4 bg = *(const f32x4*)brg;
#pragma unroll
            for (int ai = 0; ai < 2; ++ai)
#pragma unroll
                for (int m = 0; m < 4; ++m) { const int rl = ai * 128 + wr * 64 + m * 16 + fr; gl[rl] = (acc[ai][0][m][0] + acc[ai][1][m][0]) * row_rstd(u.pm * 256 + rl) + bg; } }
        lds_barrier();
        if (wc == 0) {
#pragma unroll
            for (int ai = 0; ai < 2; ++ai)
#pragma unroll
                for (int m = 0; m < 4; ++m) { const int rl = ai * 128 + wr * 64 + m * 16 + fr; const f32x4 g = gl[rl];
                    int grp = 0; float gm = g[0];
#pragma unroll
                    for (int c = 1; c < 4; ++c) if (g[c] > gm) { gm = g[c]; grp = c; }
                    if (fq == grp) {
                        float gden = 0.f;
#pragma unroll
                        for (int c = 0; c < 4; ++c) gden += __expf(g[c] - gm);
                        const float gw = 1.0f / gden;
                        const f32x4 b0 = *(const f32x4*)(bre + grp * 8), b1 = *(const f32x4*)(bre + grp * 8 + 4);
                        const float rs = row_rstd(u.pm * 256 + rl);
                        const f32x4 e0 = (acc[ai][0][m][0] + acc[ai][1][m][0]) * rs + b0, e1v = (acc[ai][0][m][1] + acc[ai][1][m][1]) * rs + b1;
                        const float el[8] = {e0[0], e0[1], e0[2], e0[3], e1v[0], e1v[1], e1v[2], e1v[3]};
                        int i1 = 0; float m1 = el[0];
#pragma unroll
                        for (int c = 1; c < 8; ++c) if (el[c] > m1) { m1 = el[c]; i1 = c; }
                        int i2 = -1; float m2 = -3.0e38f;
#pragma unroll
                        for (int c = 0; c < 8; ++c) if (c != i1 && el[c] > m2) { m2 = el[c]; i2 = c; }
                        if (i2 < 0) i2 = i1 ? 0 : 1;
                        const float ex = __expf(m2 - m1); const float w1 = 1.0f / (1.0f + ex), w2 = ex * w1;
                        const int x1 = grp * 8 + i1, x2 = grp * 8 + i2;
                        u32x4 o; o.x = (unsigned)x1 | ((unsigned)x2 << 8); o.y = __builtin_bit_cast(unsigned, gw * w1); o.z = __builtin_bit_cast(unsigned, gw * w2); o.w = __builtin_bit_cast(unsigned, rs);
                        tok[u.pm * 256 + rl] = o; atomicAdd((int*)&lc[x1], 1); atomicAdd((int*)&lc[x2], 1); } } }
    }
};

struct Args { const float* in[37]; float* out; unsigned char* ws; int ph_lo, ph_hi; };
typedef const __attribute__((address_space(4))) Args* KArgs;
__device__ __forceinline__ KArgs kargs() { KArgs p = (KArgs)__builtin_amdgcn_kernarg_segment_ptr(); asm volatile("" : "+s"(p)); return p; }
enum { I_X = 0, I_MEM, I_NORM_MIX, I_NORM_MEM, I_NORM_FFN, I_NORM_FINAL, I_MU, I_WRKV, I_W0, I_W1, I_W2, I_A0, I_A1, I_A2, I_G1, I_G2, I_KK, I_KA, I_RK, I_LNG, I_LNB, I_WO,
       I_KVNORM, I_WKVS, I_SBWQ, I_SBWO, I_MEMNORMKV, I_MEMWQ, I_MEMWKV, I_MEMWO, I_WRG, I_BRG, I_WRE, I_BRE, I_WGATE, I_WUP, I_WDOWN };

struct ConvJob { const float* src; bf16_t* dst; const float* g; const float* mu; int K, N, lds, ldd, mumode; float cst; };
constexpr int NJOBS = 25 + 320;
__device__ __forceinline__ ConvJob get_job(KArgs a, int j) {
    ConvJob J; J.g = nullptr; J.mu = nullptr; J.mumode = 0; J.cst = 1.f;
    unsigned char* ws = a->ws;
    if (j < 12) { const int i = j >> 1, part = j & 1; J.K = D; J.g = a->in[I_NORM_MIX];
        if (i < 3) {
            J.src = a->in[I_WRKV] + (size_t)i * D * D; J.N = part ? 0 : D; J.lds = D; J.ldd = D; J.dst = (bf16_t*)(ws + WS_WCAT) + (size_t)(i * 1024) * D; return J; }
        J.ldd = 2 * D; J.mu = a->in[I_MU] + i * D; J.mumode = part ? 2 : 1;
        bf16_t* base = (bf16_t*)(ws + WS_WCAT) + part * D;
        if (i == 3) { J.src = a->in[I_W1]; J.N = 64; J.lds = 64; J.dst = base + (size_t)3072 * 2 * D; }
        else if (i == 4) { J.src = a->in[I_A1]; J.N = 64; J.lds = 64; J.dst = base + (size_t)(3072 + 64) * 2 * D; }
        else { J.src = a->in[I_G1]; J.N = 160; J.lds = 160; J.dst = base + (size_t)3328 * 2 * D; }
        return J; }
    if (j == 12) { J.src = a->in[I_W2]; J.K = 64; J.N = D; J.lds = D; J.dst = (bf16_t*)(ws + WS_WWA2); J.ldd = 256; return J; }
    if (j == 13) { J.src = a->in[I_A2]; J.K = 64; J.N = D; J.lds = D; J.dst = (bf16_t*)(ws + WS_WWA2) + (size_t)1024 * 256 + 64; J.ldd = 256; return J; }
    if (j == 14) { J.src = a->in[I_G2]; J.K = 160; J.N = D; J.lds = D; J.dst = (bf16_t*)(ws + WS_WG2); J.ldd = 256; return J; }
    if (j == 15) { J.src = a->in[I_WO]; J.K = D; J.N = D; J.lds = D; J.dst = (bf16_t*)(ws + WS_WO0); J.ldd = D; return J; }
    if (j == 16) { J.src = a->in[I_WKVS]; J.K = D; J.N = 2 * D; J.lds = 2 * D; J.dst = (bf16_t*)(ws + WS_WKVQ); J.ldd = D; J.g = a->in[I_KVNORM]; return J; }
    if (j == 17) { J.src = a->in[I_SBWQ]; J.K = D; J.N = D; J.lds = D; J.dst = (bf16_t*)(ws + WS_WKVQ) + (size_t)2048 * D; J.ldd = D; J.g = a->in[I_NORM_MIX] + D; J.cst = 0.125f * 1.44269504f; return J; }
    if (j == 18) { J.src = a->in[I_SBWO]; J.K = D; J.N = D; J.lds = D; J.dst = (bf16_t*)(ws + WS_WOSB); J.ldd = D; return J; }
    if (j < 25) { const int l = (j - 19) / 3, w = (j - 19) % 3; J.K = D; J.ldd = D;
        if (w == 0) { J.src = a->in[I_MEMWQ]; J.N = 0; J.lds = D; J.dst = (bf16_t*)(ws + WS_WMQ); }
        else if (w == 1) { J.src = a->in[I_MEMWKV] + (size_t)l * D * 2 * D; J.N = 2 * D; J.lds = 2 * D; J.dst = (bf16_t*)(ws + WS_WMKV) + (size_t)l * 2 * D * D; J.g = a->in[I_MEMNORMKV] + l * D; }
        else { J.src = a->in[I_MEMWO] + (size_t)l * D * D; J.N = D; J.lds = D; J.dst = (bf16_t*)(ws + WS_WMO) + (size_t)l * D * D; }
        return J; }
    const int mI = j - 25, l = mI / 160, e = (mI % 160) / 5, part = mI % 5;
    if (part < 4) { const int up = part >> 1, hh = part & 1; J.src = a->in[up ? I_WUP : I_WGATE] + ((size_t)l * 32 + e) * D * 256 + hh * 128; J.K = D; J.N = 128; J.lds = 256;
        J.dst = (bf16_t*)(ws + WS_WGU) + (((size_t)l * 32 + e) * 512 + hh * 256 + up * 128) * D; J.ldd = D; J.g = a->in[I_NORM_FFN] + l * D; }
    else { J.src = a->in[I_WDOWN] + ((size_t)l * 32 + e) * 256 * D; J.K = 256; J.N = D; J.lds = D; J.dst = (bf16_t*)(ws + WS_WDN) + ((size_t)l * 32 + e) * D * 256; J.ldd = 256; }
    return J;
}
__device__ __forceinline__ void conv_load(const ConvJob& J, int tile, float (&v)[64], float& gk, float& mk, int lane) {
    const int ntn = (J.N + 63) >> 6, kb = tile / ntn, nb = tile % ntn, k0 = kb * 64, n0 = nb * 64;
    const int nc = (n0 + lane) < J.N ? n0 + lane : J.N - 1;
    { const int kc = (k0 + lane) < J.K ? k0 + lane : J.K - 1; gk = J.g ? J.g[kc] : 1.0f; mk = J.mu ? J.mu[kc] : 0.0f; }
    const float* sp = J.src + nc;
#pragma unroll
    for (int u = 0; u < 64; ++u) { const int kr = (k0 + u) < J.K ? k0 + u : J.K - 1; v[u] = __builtin_nontemporal_load(sp + (size_t)kr * J.lds); }
}
__device__ __forceinline__ void conv_store(const ConvJob& J, int tile, const float (&v)[64], float gk, float mk, LAS float* scr, int lane) {
    const int ntn = (J.N + 63) >> 6, kb = tile / ntn, nb = tile % ntn, k0 = kb * 64, n0 = nb * 64;
    float sk = 0.f;
    if (k0 + lane < J.K) { sk = J.cst * gk; if (J.mumode == 1) sk *= mk; else if (J.mumode == 2) sk *= (1.0f - mk); }
#pragma unroll
    for (int u = 0; u < 64; ++u) { const float s = __builtin_bit_cast(float, __builtin_amdgcn_readlane(__builtin_bit_cast(int, sk), u)); scr[u * 65 + lane] = v[u] * s; }
    asm volatile("s_waitcnt lgkmcnt(0)" ::: "memory");
    const int c = lane & 7;
#pragma unroll
    for (int it = 0; it < 8; ++it) { const int n = (lane >> 3) + 8 * it; const LAS float* s = scr + (8 * c) * 65 + n;
        if (n0 + n < J.N && k0 + 8 * c < J.K) { u32x4 o; o.x = cvt_pk_bf16(s[0], s[65]); o.y = cvt_pk_bf16(s[130], s[195]); o.z = cvt_pk_bf16(s[260], s[325]); o.w = cvt_pk_bf16(s[390], s[455]);
            *(u32x4*)(J.dst + (size_t)(n0 + n) * J.ldd + k0 + 8 * c) = o; } }
    asm volatile("s_waitcnt lgkmcnt(0)" ::: "memory");
}
struct ConvIter { int j, t, ntiles, tbase; };
__device__ __forceinline__ bool conv_next(KArgs a, ConvIter& it, ConvJob& J, int& tile, int gw, int NGW) {
    for (;;) {
        if (it.j >= NJOBS) return false;
        if (it.t < it.ntiles) { J = get_job(a, it.j); tile = it.t; it.t += NGW; return true; }
        it.tbase = (it.tbase + it.ntiles) % NGW; ++it.j;
        if (it.j < NJOBS) { const ConvJob Jn = get_job(a, it.j); it.ntiles = ((Jn.K + 63) >> 6) * ((Jn.N + 63) >> 6); int t0 = (gw - it.tbase) % NGW; if (t0 < 0) t0 += NGW; it.t = t0; }
    }
}
__device__ __forceinline__ void rms_row_to_bf16(const float* xrow, bf16_t* orow, int lane) {
    const f32x4* xr = (const f32x4*)xrow + lane; f32x4 v[4]; float s = 0.f;
#pragma unroll
    for (int j = 0; j < 4; ++j) { v[j] = xr[64 * j]; s += (v[j][0] * v[j][0] + v[j][1] * v[j][1]) + (v[j][2] * v[j][2] + v[j][3] * v[j][3]); }
    const float rstd = __builtin_amdgcn_rsqf(wave_sum(s) * (1.0f / D) + NORM_EPS);
    u32x2* o8 = (u32x2*)orow + lane;
#pragma unroll
    for (int j = 0; j < 4; ++j) { u32x2 w; w.x = cvt_pk_bf16(v[j][0] * rstd, v[j][1] * rstd); w.y = cvt_pk_bf16(v[j][2] * rstd, v[j][3] * rstd); o8[64 * j] = w; }
}
__device__ __forceinline__ void prologue_phase(KArgs a, LAS unsigned char* lds, int bid, int nb) {
    const int tid = opaque_tid(), lane = tid & 63, wave = __builtin_amdgcn_readfirstlane(tid >> 6);
    const int gw = bid * 8 + wave, NGW = nb * 8;
    LAS float* scr = (LAS float*)(lds + wave * 16896);
    {   ConvIter it; it.j = 0; it.tbase = 0; { const ConvJob J0 = get_job(a, 0); it.ntiles = ((J0.K + 63) >> 6) * ((J0.N + 63) >> 6); it.t = gw; }
        ConvJob JA, JB, JC; int tA = 0, tB = 0, tC = 0; float vA[64], vB[64], vC[64], gA = 1.f, mA = 0.f, gB = 1.f, mB = 0.f, gC = 1.f, mC = 0.f;
        bool okA = conv_next(a, it, JA, tA, gw, NGW); if (okA) conv_load(JA, tA, vA, gA, mA, lane);
        bool okB = okA && conv_next(a, it, JB, tB, gw, NGW); if (okB) conv_load(JB, tB, vB, gB, mB, lane);
        while (okA) {
            const bool okC = okB && conv_next(a, it, JC, tC, gw, NGW); if (okC) conv_load(JC, tC, vC, gC, mC, lane);
            conv_store(JA, tA, vA, gA, mA, scr, lane);
            okA = okC && conv_next(a, it, JA, tA, gw, NGW); if (okA) conv_load(JA, tA, vA, gA, mA, lane);
            if (!okB) break;
            conv_store(JB, tB, vB, gB, mB, scr, lane);
            okB = okA && conv_next(a, it, JB, tB, gw, NGW); if (okB) conv_load(JB, tB, vB, gB, mB, lane);
            if (!okC) break;
            conv_store(JC, tC, vC, gC, mC, scr, lane);
        }
    }
    { bf16_t* wq = (bf16_t*)(a->ws + WS_WMQ);
      for (int i = bid * 512 + tid; i < 2 * D * D / 4; i += nb * 512) { const int l = i >> 18, k = (i >> 8) & 1023;
          const f32x4 v = *(const f32x4*)(a->in[I_MEMWQ] + (size_t)i * 4) * (a->in[I_NORM_MEM][l * D + k] * (0.0625f * 1.44269504f));
          u32x2 o; o.x = cvt_pk_bf16(v[0], v[1]); o.y = cvt_pk_bf16(v[2], v[3]); *(u32x2*)(wq + (size_t)i * 4) = o; } }
    bf16_t* wr2 = (bf16_t*)(a->ws + WS_RS);
    for (int i = bid * 512 + tid; i < 2 * 256 * 1024; i += nb * 512) { const int l = i >> 18, c = (i >> 10) & 255, k = i & 1023, cc = c & 127;
        float w = 0.f;
        if (cc < 36) w = a->in[I_NORM_FFN][l * D + k] * (cc < 32 ? a->in[I_WRE][((size_t)l * D + k) * 32 + cc] : a->in[I_WRG][((size_t)l * D + k) * 4 + (cc - 32)]);
        const unsigned hi = f2bf(w); const unsigned lo = f2bf(w - __builtin_bit_cast(float, hi << 16));
        wr2[i] = (bf16_t)((c >> 7) ? lo : hi); }
    bf16_t* mn = (bf16_t*)(a->ws + WS_MN);
    for (int r = gw; r < 2048; r += NGW) rms_row_to_bf16(a->in[I_MEM] + (size_t)r * D, mn + (size_t)r * D, lane);
    bf16_t* hp = (bf16_t*)(a->ws + R0);
    { bf16_t* L0 = (bf16_t*)(a->ws + R6); bf16_t* L1 = (bf16_t*)a->out; bf16_t* L2 = (bf16_t*)a->out + (size_t)T * D;
      constexpr int RPW = 32;
      const int e0 = lane * 8, e1 = lane * 8 + 4, e2 = 512 + lane * 8, e3 = 512 + lane * 8 + 4;
      for (int r0 = gw * RPW; r0 < T; r0 += NGW * RPW) {
          f32x4 mu[3][4];
#pragma unroll
          for (int i = 0; i < 3; ++i) { const float* mp = a->in[I_MU] + i * D; mu[i][0] = *(const f32x4*)(mp + e0); mu[i][1] = *(const f32x4*)(mp + e1); mu[i][2] = *(const f32x4*)(mp + e2); mu[i][3] = *(const f32x4*)(mp + e3); }
          f32x4 hprev[4];
          { const int t0 = r0 & (S - 1);
            if (t0 == 0) {
#pragma unroll
                for (int j = 0; j < 4; ++j) hprev[j] = (f32x4){0.f, 0.f, 0.f, 0.f}; }
            else { const float* xr = a->in[I_X] + (size_t)(r0 - 1) * D; float s = 0.f;
                hprev[0] = *(const f32x4*)(xr + e0); hprev[1] = *(const f32x4*)(xr + e1); hprev[2] = *(const f32x4*)(xr + e2); hprev[3] = *(const f32x4*)(xr + e3);
#pragma unroll
                for (int j = 0; j < 4; ++j) s += (hprev[j][0] * hprev[j][0] + hprev[j][1] * hprev[j][1]) + (hprev[j][2] * hprev[j][2] + hprev[j][3] * hprev[j][3]);
                const float rstd = __builtin_amdgcn_rsqf(wave_sum(s) * (1.0f / D) + NORM_EPS);
#pragma unroll
                for (int j = 0; j < 4; ++j) hprev[j] = hprev[j] * rstd; } }
          f32x4 va[4], vb[4];
          { const float* xr = a->in[I_X] + (size_t)r0 * D; va[0] = __builtin_nontemporal_load((const f32x4*)(xr + e0)); va[1] = __builtin_nontemporal_load((const f32x4*)(xr + e1)); va[2] = __builtin_nontemporal_load((const f32x4*)(xr + e2)); va[3] = __builtin_nontemporal_load((const f32x4*)(xr + e3));
            xr += D; vb[0] = __builtin_nontemporal_load((const f32x4*)(xr + e0)); vb[1] = __builtin_nontemporal_load((const f32x4*)(xr + e1)); vb[2] = __builtin_nontemporal_load((const f32x4*)(xr + e2)); vb[3] = __builtin_nontemporal_load((const f32x4*)(xr + e3)); }
#define PRO_ROW(V_, rr_) { const int r = r0 + (rr_), b = r >> 13, t = r & (S - 1); \
              f32x4 v[4]; float s = 0.f; \
              _Pragma("unroll") for (int j = 0; j < 4; ++j) { v[j] = V_[j]; s += (v[j][0] * v[j][0] + v[j][1] * v[j][1]) + (v[j][2] * v[j][2] + v[j][3] * v[j][3]); } \
              { const int rn = ((rr_) + 2 < RPW) ? r + 2 : r; const float* xr = a->in[I_X] + (size_t)rn * D; \
                V_[0] = __builtin_nontemporal_load((const f32x4*)(xr + e0)); V_[1] = __builtin_nontemporal_load((const f32x4*)(xr + e1)); V_[2] = __builtin_nontemporal_load((const f32x4*)(xr + e2)); V_[3] = __builtin_nontemporal_load((const f32x4*)(xr + e3)); } \
              const float rstd = __builtin_amdgcn_rsqf(wave_sum(s) * (1.0f / D) + NORM_EPS); \
              bf16_t* oh = hp + ((size_t)b * (S + 1) + 1 + t) * D + e0; bf16_t* o0 = L0 + (size_t)r * D + e0; bf16_t* o1 = L1 + (size_t)r * D + e0; bf16_t* o2 = L2 + (size_t)r * D + e0; \
              _Pragma("unroll") for (int jh = 0; jh < 2; ++jh) { const f32x4 ha = v[2 * jh] * rstd, hb = v[2 * jh + 1] * rstd, da = hprev[2 * jh] - ha, db = hprev[2 * jh + 1] - hb; \
                  *(u32x4*)(oh + 512 * jh) = pack8(ha, hb); \
                  *(u32x4*)(o0 + 512 * jh) = pack8(ha + da * mu[0][2 * jh], hb + db * mu[0][2 * jh + 1]); \
                  *(u32x4*)(o1 + 512 * jh) = pack8(ha + da * mu[1][2 * jh], hb + db * mu[1][2 * jh + 1]); \
                  *(u32x4*)(o2 + 512 * jh) = pack8(ha + da * mu[2][2 * jh], hb + db * mu[2][2 * jh + 1]); \
                  hprev[2 * jh] = ha; hprev[2 * jh + 1] = hb; } }
#pragma unroll 1
          for (int rr = 0; rr < RPW; rr += 2) { PRO_ROW(va, rr) PRO_ROW(vb, rr + 1) }
#undef PRO_ROW
      } }
    if (gw < NB) { u32x4* z = (u32x4*)(hp + (size_t)gw * (S + 1) * D); z[lane] = (u32x4){0u, 0u, 0u, 0u}; z[64 + lane] = (u32x4){0u, 0u, 0u, 0u}; }
}

namespace rw {
constexpr int RB = 144, SLOT = 64 * RB;
enum { S_AT = 0, S_BT, S_KT, S_RT, S_ATT, S_VT, S_BHT, S_KHT, S_TM, S_APT0, S_APT1, S_AAK, S_XT0, S_TRI, NSLOTS };
constexpr int S_AP0 = S_BT, S_AP1 = S_KT, S_XT1 = S_RT, S_ARB = S_BHT, S_ARK = S_KHT;
constexpr int MISC = NSLOTS * SLOT;
__device__ __forceinline__ int rowmap(int q, int h) { return (q & 3) + 8 * (q >> 2) + 4 * h; }
__device__ __forceinline__ f32x16 zero16() { f32x16 z;
#pragma unroll
    for (int i = 0; i < 16; ++i) z[i] = 0.f;
    return z; }
__device__ __forceinline__ bf16x8 tr_frag(const LAS unsigned char* T, int row0, int ks, int r, int h) {
    const int q = (r & 15) >> 2, p = r & 3, blk = (r >> 4) & 1, sw = (q >> 1) & 1;
    const LAS unsigned char* a0 = T + (16 * ks + 8 * h + q) * 128 + ((((row0 >> 5) ^ sw) * 4 + 2 * blk + (p >> 1)) << 4) + 8 * (p & 1);
    return __builtin_shufflevector(__builtin_amdgcn_ds_read_tr16_b64_v4i16((LAS s16x4*)a0), __builtin_amdgcn_ds_read_tr16_b64_v4i16((LAS s16x4*)(a0 + 4 * 128)), 0, 1, 2, 3, 4, 5, 6, 7); }
template <bool SX = false, bool SY = false>
__device__ __forceinline__ f32x16 mm(f32x16 acc, const LAS unsigned char* X, int xrow0, const LAS unsigned char* Yt, int yrow0, int r, int h, int nks) {
#pragma unroll
    for (int ks = 0; ks < 4; ++ks) if (ks < nks) {
        const bf16x8 a = SX ? tr_frag(X, xrow0, ks, r, h) : *(const LAS bf16x8*)(X + (xrow0 + r) * RB + (16 * ks + 8 * h) * 2);
        const bf16x8 b = SY ? tr_frag(Yt, yrow0, ks, r, h) : *(const LAS bf16x8*)(Yt + (yrow0 + r) * RB + (16 * ks + 8 * h) * 2);
        acc = __builtin_amdgcn_mfma_f32_32x32x16_bf16(a, b, acc, 0, 0, 0); }
    return acc; }
__device__ __forceinline__ void write_T(LAS unsigned char* buf, int col0, int row0, const f32x16& acc, int r, int h) {
#pragma unroll
    for (int m = 0; m < 4; ++m) { u32x2 w; w.x = cvt_pk_c(acc[4 * m], acc[4 * m + 1]); w.y = cvt_pk_c(acc[4 * m + 2], acc[4 * m + 3]);
        *(LAS u32x2*)(buf + (col0 + r) * RB + (row0 + 8 * m + 4 * h) * 2) = w; } }
__device__ __forceinline__ void write_R(LAS unsigned char* buf, int row0, int col0, const f32x16& acc, int r, int h) {
#pragma unroll
    for (int q = 0; q < 16; q += 2) { const unsigned p = cvt_pk_c(acc[q], acc[q + 1]);
        *(LAS unsigned short*)(buf + (row0 + rowmap(q, h)) * RB + (col0 + r) * 2) = (unsigned short)p; *(LAS unsigned short*)(buf + (row0 + rowmap(q + 1, h)) * RB + (col0 + r) * 2) = (unsigned short)(p >> 16); } }
__device__ __forceinline__ void zero_tile(LAS unsigned char* buf, int row0, int col0, int lane) {
#pragma unroll
    for (int i = 0; i < 4; ++i) { const int idx = i * 64 + lane, row = idx >> 3, ch = idx & 7; *(LAS u32x2*)(buf + (row0 + row) * RB + col0 * 2 + ch * 8) = (u32x2){0u, 0u}; } }

#define RW_P8(v_, s_) pack8c(v_[8 * (s_)], v_[8 * (s_) + 1], v_[8 * (s_) + 2], v_[8 * (s_) + 3], v_[8 * (s_) + 4], v_[8 * (s_) + 5], v_[8 * (s_) + 6], v_[8 * (s_) + 7])
__device__ __forceinline__ void inv32(const f32x16 A, const f32x16 AT, f32x16& Tt, f32x16& TtT, int r, int h) {
    f32x16 X = A, Y = AT; Tt = A; TtT = AT;
#pragma unroll
    for (int q = 0; q < 16; ++q) if (rowmap(q, h) == r) { Tt[q] += 1.0f; TtT[q] += 1.0f; }
#pragma unroll
    for (int k = 0; k < 4; ++k) {
        const bf16x8 x0 = RW_P8(X, 0), x1 = RW_P8(X, 1), y0 = RW_P8(Y, 0), y1 = RW_P8(Y, 1);
        f32x16 Sx = zero16(), Sy = zero16();
        Sx = __builtin_amdgcn_mfma_f32_32x32x16_bf16(y0, x0, Sx, 0, 0, 0); if (k < 3) Sy = __builtin_amdgcn_mfma_f32_32x32x16_bf16(x0, y0, Sy, 0, 0, 0);
        Sx = __builtin_amdgcn_mfma_f32_32x32x16_bf16(y1, x1, Sx, 0, 0, 0); if (k < 3) Sy = __builtin_amdgcn_mfma_f32_32x32x16_bf16(x1, y1, Sy, 0, 0, 0);
        const bf16x8 s0 = RW_P8(Sx, 0), s1 = RW_P8(Sx, 1), t0 = RW_P8(TtT, 0), t1 = RW_P8(TtT, 1);
        Tt = __builtin_amdgcn_mfma_f32_32x32x16_bf16(t0, s0, Tt, 0, 0, 0); TtT = __builtin_amdgcn_mfma_f32_32x32x16_bf16(s0, t0, TtT, 0, 0, 0);
        Tt = __builtin_amdgcn_mfma_f32_32x32x16_bf16(t1, s1, Tt, 0, 0, 0); TtT = __builtin_amdgcn_mfma_f32_32x32x16_bf16(s1, t1, TtT, 0, 0, 0);
        X = Sx; Y = Sy;
    }
}
__device__ __forceinline__ void tri_init(LAS unsigned char* lds, int tid) {
    const int row = tid >> 3, kb = (tid & 7) * 8; u32x4 v; unsigned ww[4];
#pragma unroll
    for (int q = 0; q < 4; ++q) ww[q] = ((kb + 2 * q <= row) ? 0x3F80u : 0u) | ((kb + 2 * q + 1 <= row) ? 0x3F800000u : 0u);
    v.x = ww[0]; v.y = ww[1]; v.z = ww[2]; v.w = ww[3]; *(LAS u32x4*)(lds + S_TRI * SLOT + row * RB + kb * 2) = v; }
struct Raw { u32x4 r, k, v, e, a; };
template <bool NEED_R>
__device__ __forceinline__ void raw_load(KArgs a, Raw& R, int item, int tid) {
    const int lane = tid & 63, w = __builtin_amdgcn_readfirstlane(tid >> 6); const int bh = item >> 7, c = item & 127, b = bh >> 4, hd = bh & 15;
    const size_t g0 = ((size_t)b * S + c * 64 + 8 * w) * D + hd * 64;
    const unsigned o = (unsigned)((lane >> 3) * D + (lane & 7) * 8);
    if (NEED_R) R.r = *(const u32x4*)((const bf16_t*)(a->ws + R1) + g0 + o);
    R.k = *(const u32x4*)((const bf16_t*)(a->ws + R2) + g0 + o); R.v = *(const u32x4*)((const bf16_t*)(a->ws + R3) + g0 + o);
    R.e = *(const u32x4*)((const bf16_t*)(a->ws + R4) + g0 + o); R.a = *(const u32x4*)((const bf16_t*)a->out + g0 + o); }
__device__ __forceinline__ void unpack8(const u32x4 w, float (&f)[8]) { f[0] = bf_lo(w.x); f[1] = bf_hi(w.x); f[2] = bf_lo(w.y); f[3] = bf_hi(w.y); f[4] = bf_lo(w.z); f[5] = bf_hi(w.z); f[6] = bf_lo(w.w); f[7] = bf_hi(w.w); }
__device__ __forceinline__ void store_tm(LAS unsigned char* p, const float (&f)[8]) {
    u32x2 lo, hi; lo.x = cvt_pk_c(f[0], f[1]); lo.y = cvt_pk_c(f[2], f[3]); hi.x = cvt_pk_c(f[4], f[5]); hi.y = cvt_pk_c(f[6], f[7]);
    *(LAS u32x2*)p = lo; *(LAS u32x2*)(p + 16) = hi; }
template <bool STAGE_C>
__device__ __forceinline__ void chunk_front(KArgs a, LAS unsigned char* lds, int b, int hd, int c, int tid, Raw& RW, int next_item, u32x4& vraw) {
    const int lane = tid & 63, w = __builtin_amdgcn_readfirstlane(tid >> 6), r = lane & 31, h = lane >> 5;
    LAS float* WLf = (LAS float*)(lds + MISC); LAS float* bon = WLf + 64;
    LAS float* CL = (LAS float*)(lds + S_APT0 * SLOT); constexpr int CS = 68;
    LAS unsigned char* LWT = lds + S_XT0 * SLOT;
    {
        const int tq = lane >> 3, cg = lane & 7, tk = 8 * w + tq, ch = hd * 64 + cg * 8;
        const f32x4 kc0 = *(const f32x4*)(a->in[I_KK] + ch), kc1 = *(const f32x4*)(a->in[I_KK] + ch + 4), ac0 = *(const f32x4*)(a->in[I_KA] + ch), ac1 = *(const f32x4*)(a->in[I_KA] + ch + 4);
        f32x4 rc0 = {0.f, 0.f, 0.f, 0.f}, rc1 = rc0; if (STAGE_C) { rc0 = *(const f32x4*)(a->in[I_RK] + ch); rc1 = *(const f32x4*)(a->in[I_RK] + ch + 4); }
        u32x4 rr, kr4, vr, er, ar;
        if (STAGE_C) { rr.x = pin_u32(RW.r.x); rr.y = pin_u32(RW.r.y); rr.z = pin_u32(RW.r.z); rr.w = pin_u32(RW.r.w); } else rr = (u32x4){0u, 0u, 0u, 0u};
        kr4.x = pin_u32(RW.k.x); kr4.y = pin_u32(RW.k.y); kr4.z = pin_u32(RW.k.z); kr4.w = pin_u32(RW.k.w);
        vr.x = pin_u32(RW.v.x); vr.y = pin_u32(RW.v.y); vr.z = pin_u32(RW.v.z); vr.w = pin_u32(RW.v.w); er.x = pin_u32(RW.e.x); er.y = pin_u32(RW.e.y); er.z = pin_u32(RW.e.z); er.w = pin_u32(RW.e.w);
        ar.x = pin_u32(RW.a.x); ar.y = pin_u32(RW.a.y); ar.z = pin_u32(RW.a.z); ar.w = pin_u32(RW.a.w);
        vraw = vr;
        raw_load<STAGE_C>(a, RW, next_item >= 0 ? next_item : ((b << 4) + hd) * 128 + c, tid);
        const int cmo = tk * 128 + ((cg ^ (((tq >> 1) & 1) << 2)) << 4);
        *(LAS u32x4*)(LWT + cmo) = er;
        *(LAS u32x4*)(lds + S_VT * SLOT + cmo) = vr;
        lds_barrier();
        if (w < 4) { const int ti = w >> 1, cj = w & 1; f32x16 acc = zero16(); acc = mm<false, true>(acc, lds + S_TRI * SLOT, 32 * ti, LWT, 32 * cj, r, h, ti ? 4 : 2);
#pragma unroll
            for (int q = 0; q < 16; ++q) CL[(32 * ti + rowmap(q, h)) * CS + 32 * cj + r] = acc[q]; }
        float rv[8], kv[8], lw[8], lr[8], kk[8], kp[8];
        unpack8(rr, rv); unpack8(kr4, kv); unpack8(er, lw); unpack8(ar, lr);
        { const float kkc[8] = {kc0[0], kc0[1], kc0[2], kc0[3], kc1[0], kc1[1], kc1[2], kc1[3]}, kac[8] = {ac0[0], ac0[1], ac0[2], ac0[3], ac1[0], ac1[1], ac1[2], ac1[3]};
          float ss = 0.f;
#pragma unroll
          for (int j = 0; j < 8; ++j) { kk[j] = kv[j] * kkc[j]; ss += kk[j] * kk[j]; kp[j] = kv[j] * (1.0f + (lr[j] - 1.0f) * kac[j]); }
          const float rn = __builtin_amdgcn_rsqf(fmaxf(sum8(ss), 1e-24f));
#pragma unroll
          for (int j = 0; j < 8; ++j) kk[j] *= rn;
          if (STAGE_C) { const float rkc[8] = {rc0[0], rc0[1], rc0[2], rc0[3], rc1[0], rc1[1], rc1[2], rc1[3]};
              float bs = 0.f;
#pragma unroll
              for (int j = 0; j < 8; ++j) bs += rv[j] * kp[j] * rkc[j];
              bs = sum8(bs); if (cg == 0) bon[tk] = bs; } }
        lds_barrier();
        const f32x4 c10 = *(const LAS f32x4*)(CL + tk * CS + cg * 8), c11 = *(const LAS f32x4*)(CL + tk * CS + cg * 8 + 4), ct0 = *(const LAS f32x4*)(CL + 63 * CS + cg * 8), ct1 = *(const LAS f32x4*)(CL + 63 * CS + cg * 8 + 4);
        const float c1[8] = {c10[0], c10[1], c10[2], c10[3], c11[0], c11[1], c11[2], c11[3]}, ct[8] = {ct0[0], ct0[1], ct0[2], ct0[3], ct1[0], ct1[1], ct1[2], ct1[3]};
        if (!STAGE_C && tk == 63) {
            f32x4 w0, w1;
#pragma unroll
            for (int j = 0; j < 4; ++j) { w0[j] = __builtin_amdgcn_exp2f(1.44269504f * ct[j]); w1[j] = __builtin_amdgcn_exp2f(1.44269504f * ct[4 + j]); }
            *(LAS f32x4*)(WLf + cg * 8) = w0; *(LAS f32x4*)(WLf + cg * 8 + 4) = w1; }
        float at[8], bt[8], kt[8], rt[8], bh[8], kh[8];
#pragma unroll
        for (int j = 0; j < 8; ++j) { const float c0 = c1[j] - lw[j]; const float ep = __builtin_amdgcn_exp2f(1.44269504f * c1[j]), em = __builtin_amdgcn_rcpf(ep);
            at[j] = -kk[j] * __builtin_amdgcn_exp2f(1.44269504f * c0); const float kl = kk[j] * lr[j]; bt[j] = kl * em; kt[j] = kp[j] * em; rt[j] = rv[j] * ep;
            if (!STAGE_C) { const float ew = __builtin_amdgcn_exp2f(1.44269504f * (ct[j] - c1[j])); bh[j] = kl * ew; kh[j] = kp[j] * ew; } }
        { const int tmo = tk * RB + (32 * (cg >> 1) + 8 * (cg & 1));
          store_tm(lds + S_AT * SLOT + tmo, at); store_tm(lds + S_BT * SLOT + tmo, bt); store_tm(lds + S_KT * SLOT + tmo, kt); if (STAGE_C) store_tm(lds + S_RT * SLOT + tmo, rt); }
        if (!STAGE_C) { *(LAS u32x4*)(lds + S_ATT * SLOT + cmo) = __builtin_bit_cast(u32x4, pack8c(at[0], at[1], at[2], at[3], at[4], at[5], at[6], at[7]));
            *(LAS u32x4*)(lds + S_BHT * SLOT + cmo) = __builtin_bit_cast(u32x4, pack8c(bh[0], bh[1], bh[2], bh[3], bh[4], bh[5], bh[6], bh[7]));
            *(LAS u32x4*)(lds + S_KHT * SLOT + cmo) = __builtin_bit_cast(u32x4, pack8c(kh[0], kh[1], kh[2], kh[3], kh[4], kh[5], kh[6], kh[7])); }
    }
    lds_barrier();
    if (w < 2) { f32x16 A = zero16(), AT = zero16(); A = mm(A, lds + S_AT * SLOT, 32 * w, lds + S_BT * SLOT, 32 * w, r, h, 4); AT = mm(AT, lds + S_BT * SLOT, 32 * w, lds + S_AT * SLOT, 32 * w, r, h, 4);
#pragma unroll
        for (int q = 0; q < 16; ++q) { A[q] = (rowmap(q, h) > r) ? A[q] : 0.f; AT[q] = (rowmap(q, h) < r) ? AT[q] : 0.f; }
        f32x16 Ti, TiT; inv32(A, AT, Ti, TiT, r, h);
        write_T(lds + S_TM * SLOT, 32 * w, 32 * w, TiT, r, h);
        if (w == 0) write_T(lds + S_APT1 * SLOT + 32 * RB, 0, 0, Ti, r, h); }
    else if (w == 2) { f32x16 A = zero16(); A = mm(A, lds + S_AT * SLOT, 32, lds + S_BT * SLOT, 0, r, h, 4); write_R(lds + S_APT1 * SLOT, 0, 0, A, r, h); }
    else if (w < 6) { const int ti = (w == 3) ? 0 : 1, tj = (w == 5) ? 1 : 0; f32x16 x = zero16(); x = mm(x, lds + S_AT * SLOT, 32 * ti, lds + S_KT * SLOT, 32 * tj, r, h, 4);
#pragma unroll
        for (int q = 0; q < 16; ++q) { const bool keep = (ti != tj) || (rowmap(q, h) > r); x[q] = keep ? x[q] : 0.f; }
        write_R(lds + S_AAK * SLOT, 32 * ti, 32 * tj, x, r, h); }
    else if (w == 6) { zero_tile(lds + S_AAK * SLOT, 0, 32, lane); zero_tile(lds + S_TM * SLOT, 0, 32, lane); }
    if (STAGE_C && w >= 2) {
        const int t6 = w - 2, t3 = t6 % 3, ti = t3 == 0 ? 0 : 1, tj = t3 == 2 ? 1 : 0; const bool isk = t6 >= 3;
        f32x16 x = zero16(); x = mm(x, lds + S_RT * SLOT, 32 * ti, lds + (isk ? S_KT : S_BT) * SLOT, 32 * tj, r, h, 4);
#pragma unroll
        for (int q = 0; q < 16; ++q) { const bool keep = (ti != tj) || (rowmap(q, h) >= r); x[q] = keep ? x[q] : 0.f; }
        write_R(lds + (isk ? S_ARK : S_ARB) * SLOT, 32 * ti, 32 * tj, x, r, h);
        if (w == 7) { zero_tile(lds + S_ARB * SLOT, 0, 32, lane); zero_tile(lds + S_ARK * SLOT, 0, 32, lane); } }
    lds_barrier();
}
__device__ __forceinline__ void t10_step(LAS unsigned char* lds, int r, int h) {
    f32x16 X = zero16(); X = mm(X, lds + S_APT1 * SLOT, 0, lds + S_APT1 * SLOT + 32 * RB, 0, r, h, 2);
    f32x16 T10 = zero16();
#pragma unroll
    for (int s2 = 0; s2 < 2; ++s2) { const LAS unsigned char* p = lds + S_TM * SLOT + (32 + r) * RB + (32 + 16 * s2 + 4 * h) * 2; const u32x2 lo = *(const LAS u32x2*)p, hi = *(const LAS u32x2*)(p + 16);
        u32x4 aw; aw.x = lo.x; aw.y = lo.y; aw.z = hi.x; aw.w = hi.y;
        const bf16x8 bfr = s2 == 0 ? pack8c(X[0], X[1], X[2], X[3], X[4], X[5], X[6], X[7]) : pack8c(X[8], X[9], X[10], X[11], X[12], X[13], X[14], X[15]);
        T10 = __builtin_amdgcn_mfma_f32_32x32x16_bf16(__builtin_bit_cast(bf16x8, aw), bfr, T10, 0, 0, 0); }
    write_R(lds + S_TM * SLOT, 32, 0, T10, r, h);
}

__device__ __forceinline__ void stage_a(KArgs a, LAS unsigned char* lds, int bid, int nb) {
    const int tid = opaque_tid(), lane = tid & 63, w = __builtin_amdgcn_readfirstlane(tid >> 6), r = lane & 31, h = lane >> 5;
    unsigned char* MF = a->ws + R6; unsigned char* GF = a->ws + R0;
    const LAS float* WLf = (const LAS float*)(lds + MISC);
    const int per = (NB * 16 * 128 + nb - 1) / nb, item0 = bid * per, item1 = (item0 + per < NB * 16 * 128) ? item0 + per : NB * 16 * 128;
    Raw RW; if (item0 < item1) raw_load<false>(a, RW, item0, tid);
    tri_init(lds, tid);
    for (int item = item0; item < item1; ++item) {
        const int bh = item >> 7, c = item & 127, b = bh >> 4, hd = bh & 15;
        lds_barrier();
        u32x4 vdummy; chunk_front<false>(a, lds, b, hd, c, tid, RW, (item + 1 < item1) ? item + 1 : -1, vdummy);
        const int ti = (w >> 1) & 1, tj = w & 1;
        if (w == 2) t10_step(lds, r, h);
        else if (w >= 4) { f32x16 x = zero16(); x = mm<false, true>(x, lds + S_AAK * SLOT, 32 * ti, lds + S_VT * SLOT, 32 * tj, r, h, 4); write_T(lds + S_XT1 * SLOT, 32 * tj, 32 * ti, x, r, h); }
        lds_barrier();
        if (w < 4) { f32x16 p = zero16(); p = mm<false, true>(p, lds + S_TM * SLOT, 32 * ti, lds + S_ATT * SLOT, 32 * tj, r, h, 4); write_T(lds + S_XT0 * SLOT, 32 * tj, 32 * ti, p, r, h); }
        else { f32x16 q2 = zero16(); q2 = mm(q2, lds + S_TM * SLOT, 32 * ti, lds + S_XT1 * SLOT, 32 * tj, r, h, 4); write_T(lds + S_APT0 * SLOT, 32 * tj, 32 * ti, q2, r, h); }
        lds_barrier();
        f32x16 res = zero16();
        if (w < 4) { res = mm<false, true>(res, lds + S_XT0 * SLOT, 32 * ti, lds + S_BHT * SLOT, 32 * tj, r, h, 4);
            if (ti == tj) {
#pragma unroll
                for (int q = 0; q < 16; ++q) if (rowmap(q, h) == r) res[q] += WLf[32 * ti + r]; } }
        else { res = mm<true, false>(res, lds + S_BHT * SLOT, 32 * ti, lds + S_APT0 * SLOT, 32 * tj, r, h, 4); res = mm<true, true>(res, lds + S_KHT * SLOT, 32 * ti, lds + S_VT * SLOT, 32 * tj, r, h, 4); }
        { unsigned char* d0 = (w < 4) ? MF + (size_t)item * 8192 + (tj * 4 + 2 * ti) * 1024 + lane * 16 : GF + (size_t)item * 8192 + (tj * 2 + ti) * 2048 + lane * 16;
          unsigned char* d1 = d0 + 1024;
          { *(u32x4*)d0 = __builtin_bit_cast(u32x4, pack8c(res[0], res[1], res[2], res[3], res[4], res[5], res[6], res[7]));
                         *(u32x4*)d1 = __builtin_bit_cast(u32x4, pack8c(res[8], res[9], res[10], res[11], res[12], res[13], res[14], res[15])); } }
    }
    __syncthreads();
}

__device__ __forceinline__ void stage_b(KArgs a, LAS unsigned char* lds, int bh) {
    const int tid = opaque_tid(), lane = tid & 63, w = __builtin_amdgcn_readfirstlane(tid >> 6);
    constexpr int DD = 7, NS = 9, NSTEP = 128;
    const unsigned char* MF = a->ws + R6 + (size_t)bh * NSTEP * 8192; unsigned char* GF = a->ws + R0 + (size_t)bh * NSTEP * 8192;
    f32x16 H0 = zero16(), H1 = zero16();
#define RW_ISSUE(step_) do { const int step__ = (step_); const int st = step__ < NSTEP ? step__ : NSTEP - 1; LAS unsigned char* slot = lds + (step__ % NS) * 16384; \
        _Pragma("unroll") for (int p = 0; p < 4; ++p) { const int pc = (w - 4) * 4 + p; const unsigned char* src = (pc < 8 ? MF + (size_t)st * 8192 + pc * 1024 : GF + (size_t)st * 8192 + (pc - 8) * 1024) + lane * 16; \
            __builtin_amdgcn_global_load_lds((const unsigned*)src, (LAS unsigned*)(slot + pc * 1024), 16, 0, 0); } } while (0)
    if (w >= 4) {
#pragma unroll 1
        for (int s0 = 0; s0 < DD; ++s0) RW_ISSUE(s0); }
#pragma unroll 1
    for (int c = 0; c < NSTEP; ++c) {
        if (w >= 4) { RW_ISSUE(c + DD); asm volatile("s_waitcnt vmcnt(28)" ::: "memory"); }
        __builtin_amdgcn_s_barrier(); asm volatile("" ::: "memory");
        if (w < 2) {
            const LAS unsigned char* slot = lds + (c % NS) * 16384;
            bf16x8 f[4];
            f[0] = pack8c(H0[0], H0[1], H0[2], H0[3], H0[4], H0[5], H0[6], H0[7]); f[1] = pack8c(H0[8], H0[9], H0[10], H0[11], H0[12], H0[13], H0[14], H0[15]);
            f[2] = pack8c(H1[0], H1[1], H1[2], H1[3], H1[4], H1[5], H1[6], H1[7]); f[3] = pack8c(H1[8], H1[9], H1[10], H1[11], H1[12], H1[13], H1[14], H1[15]);
            const u32x4 g00 = *(const LAS u32x4*)(slot + 8192 + (w * 2 + 0) * 2048 + lane * 16), g01 = *(const LAS u32x4*)(slot + 8192 + (w * 2 + 0) * 2048 + 1024 + lane * 16);
            const u32x4 g10 = *(const LAS u32x4*)(slot + 8192 + (w * 2 + 1) * 2048 + lane * 16), g11 = *(const LAS u32x4*)(slot + 8192 + (w * 2 + 1) * 2048 + 1024 + lane * 16);
            f32x16 n0, n1;
            { const unsigned ww[8] = {g00.x, g00.y, g00.z, g00.w, g01.x, g01.y, g01.z, g01.w};
#pragma unroll
              for (int q = 0; q < 8; ++q) { n0[2 * q] = bf_lo(ww[q]); n0[2 * q + 1] = bf_hi(ww[q]); } }
            { const unsigned ww[8] = {g10.x, g10.y, g10.z, g10.w, g11.x, g11.y, g11.z, g11.w};
#pragma unroll
              for (int q = 0; q < 8; ++q) { n1[2 * q] = bf_lo(ww[q]); n1[2 * q + 1] = bf_hi(ww[q]); } }
#pragma unroll
            for (int ks = 0; ks < 4; ++ks) { n0 = __builtin_amdgcn_mfma_f32_32x32x16_bf16(*(const LAS bf16x8*)(slot + (0 * 4 + ks) * 1024 + lane * 16), f[ks], n0, 0, 0, 0);
                                             n1 = __builtin_amdgcn_mfma_f32_32x32x16_bf16(*(const LAS bf16x8*)(slot + (1 * 4 + ks) * 1024 + lane * 16), f[ks], n1, 0, 0, 0); }
            unsigned char* hdst = GF + (size_t)c * 8192;
#pragma unroll
            for (int ks = 0; ks < 4; ++ks) *(u32x4*)(hdst + ((w * 4 + ks) * 64 + lane) * 16) = __builtin_bit_cast(u32x4, f[ks]);
            H0 = n0; H1 = n1;
        }
    }
    asm volatile("s_waitcnt vmcnt(0)" ::: "memory");
    lds_barrier();
}

__device__ __forceinline__ void stage_c(KArgs a, LAS unsigned char* lds, int bid, int nb) {
    const int tid = opaque_tid(), lane = tid & 63, w = __builtin_amdgcn_readfirstlane(tid >> 6), r = lane & 31, h = lane >> 5;
    const unsigned char* HF = a->ws + R0; bf16_t* Yg = (bf16_t*)(a->ws + R6);
    const bf16_t* Vg = (const bf16_t*)(a->ws + R3); const bf16_t* Gg = (const bf16_t*)a->out + (size_t)T * D;
    const LAS float* bon = (const LAS float*)(lds + MISC) + 64;
    LAS float* yb = (LAS float*)(lds + S_AP0 * SLOT); constexpr int YS = 68;
    const int per = (NB * 16 * 128 + nb - 1) / nb, item0 = bid * per, item1 = (item0 + per < NB * 16 * 128) ? item0 + per : NB * 16 * 128;
    Raw RW; if (item0 < item1) raw_load<true>(a, RW, item0, tid);
    tri_init(lds, tid);
    for (int item = item0; item < item1; ++item) {
        const int bh = item >> 7, c = item & 127, b = bh >> 4, hd = bh & 15;
        lds_barrier();
        const int ptk = 8 * w + (lane >> 3), pcg = lane & 7;
        const size_t po = ((size_t)b * S + c * 64 + ptk) * D + hd * 64 + pcg * 8;
        const u32x4 pgv = *(const u32x4*)(Gg + po);
        const int ytile = w - 4, rtile = (w == 0) ? 0 : (w == 1) ? 1 : (w == 3) ? 2 : (w == 5) ? 3 : -1;
        const int tjw = (w >= 4) ? (w & 1) : (w == 1 ? 1 : 0);
        bf16x8 hf[4];
        { const unsigned char* hsrc = HF + (size_t)item * 8192;
#pragma unroll
          for (int ks = 0; ks < 4; ++ks) hf[ks] = *(const bf16x8*)(hsrc + ((tjw * 4 + ks) * 64 + lane) * 16); }
        const int pch = hd * 64 + pcg * 8;
        const f32x4 g0 = *(const f32x4*)(a->in[I_LNG] + pch), g1 = *(const f32x4*)(a->in[I_LNG] + pch + 4), b0 = *(const f32x4*)(a->in[I_LNB] + pch), b1 = *(const f32x4*)(a->in[I_LNB] + pch + 4);
        u32x4 pvv; chunk_front<true>(a, lds, b, hd, c, tid, RW, (item + 1 < item1) ? item + 1 : -1, pvv);
        f32x16 y = zero16();
        if (w == 2) t10_step(lds, r, h);
        if (w >= 4) { const int ti = (ytile >> 1) & 1;
#pragma unroll
            for (int ks = 0; ks < 4; ++ks) y = __builtin_amdgcn_mfma_f32_32x32x16_bf16(*(const LAS bf16x8*)(lds + S_RT * SLOT + (32 * ti + r) * RB + (16 * ks + 8 * h) * 2), hf[ks], y, 0, 0, 0);
            y = mm<false, true>(y, lds + S_ARK * SLOT, 32 * ti, lds + S_VT * SLOT, 32 * tjw, r, h, 4); }
        if (rtile >= 0) { const int ti = (rtile >> 1) & 1; f32x16 x = zero16();
#pragma unroll
            for (int ks = 0; ks < 4; ++ks) x = __builtin_amdgcn_mfma_f32_32x32x16_bf16(*(const LAS bf16x8*)(lds + S_AT * SLOT + (32 * ti + r) * RB + (16 * ks + 8 * h) * 2), hf[ks], x, 0, 0, 0);
            x = mm<false, true>(x, lds + S_AAK * SLOT, 32 * ti, lds + S_VT * SLOT, 32 * tjw, r, h, 4);
            write_T(lds + S_XT0 * SLOT, 32 * tjw, 32 * ti, x, r, h); }
        lds_barrier();
        if (w < 4) { const int ti = (w >> 1) & 1, tj = w & 1; f32x16 u = zero16(); u = mm(u, lds + S_TM * SLOT, 32 * ti, lds + S_XT0 * SLOT, 32 * tj, r, h, 4); write_T(lds + S_APT0 * SLOT, 32 * tj, 32 * ti, u, r, h); }
        lds_barrier();
        if (w >= 4) { const int ti = (ytile >> 1) & 1; y = mm(y, lds + S_ARB * SLOT, 32 * ti, lds + S_APT0 * SLOT, 32 * tjw, r, h, 4);
#pragma unroll
            for (int q = 0; q < 16; ++q) yb[(32 * ti + rowmap(q, h)) * YS + 32 * tjw + r] = y[q]; }
        lds_barrier();
        {
            const f32x4 y0 = *(const LAS f32x4*)(yb + ptk * YS + pcg * 8), y1 = *(const LAS f32x4*)(yb + ptk * YS + pcg * 8 + 4);
            const float mean = sum8(((y0[0] + y0[1]) + (y0[2] + y0[3])) + ((y1[0] + y1[1]) + (y1[2] + y1[3]))) * (1.0f / 64.0f);
            const f32x4 d0 = y0 - mean, d1 = y1 - mean;
            const float var = sum8(((d0[0] * d0[0] + d0[1] * d0[1]) + (d0[2] * d0[2] + d0[3] * d0[3])) + ((d1[0] * d1[0] + d1[1] * d1[1]) + (d1[2] * d1[2] + d1[3] * d1[3]))) * (1.0f / 64.0f);
            const float rs = __builtin_amdgcn_rsqf(var + 64e-5f), bn = bon[ptk];
            const f32x4 v0 = (f32x4){bf_lo(pvv.x), bf_hi(pvv.x), bf_lo(pvv.y), bf_hi(pvv.y)}, v1 = (f32x4){bf_lo(pvv.z), bf_hi(pvv.z), bf_lo(pvv.w), bf_hi(pvv.w)};
            const f32x4 q0 = (f32x4){bf_lo(pgv.x), bf_hi(pgv.x), bf_lo(pgv.y), bf_hi(pgv.y)}, q1 = (f32x4){bf_lo(pgv.z), bf_hi(pgv.z), bf_lo(pgv.w), bf_hi(pgv.w)};
            const f32x4 o0 = ((d0 * rs) * g0 + b0 + v0 * bn) * q0, o1 = ((d1 * rs) * g1 + b1 + v1 * bn) * q1;
            *(u32x4*)(Yg + po) = pack8(o0, o1);
        }
    }
    __syncthreads();
}
}

template <bool DIAG>
__device__ __forceinline__ void sb_block(const f32x16& s, const bf16x8 (&tri)[2], float R, int r, int hh, bf16x8& pb0, bf16x8& pb1, float& tsum) {
    f32x2 X2[8], zr2[8], ts2 = {0.f, 0.f};
#pragma unroll
    for (int qp = 0; qp < 8; ++qp) { const int q0 = 2 * qp, q1 = q0 + 1; const f32x2 z2 = {s[q0], s[q1]};
        const f32x2 e2 = {__builtin_amdgcn_exp2f(-fabsf(z2.x)), __builtin_amdgcn_exp2f(-fabsf(z2.y))};
        const f32x2 u2 = e2 + 1.0f;
        const f32x2 l2 = {__builtin_amdgcn_logf(u2.x), __builtin_amdgcn_logf(u2.y)}, m2 = {fmaxf(z2.x, 0.f), fmaxf(z2.y, 0.f)};
        const f32x2 sp2 = m2 + l2;
        f32x2 x2 = -sp2;
        if (DIAG) { const int k0 = (q0 & 3) + 8 * (q0 >> 2) + 4 * hh, k1 = (q1 & 3) + 8 * (q1 >> 2) + 4 * hh; x2.x = (k0 < r) ? x2.x : 0.f; x2.y = (k1 < r) ? x2.y : 0.f; }
        X2[qp] = x2; ts2 += x2; zr2[qp] = (z2 - sp2) + R; }
    tsum = ts2.x + ts2.y;
    const bf16x8 xb0 = pack8c(X2[0].x, X2[0].y, X2[1].x, X2[1].y, X2[2].x, X2[2].y, X2[3].x, X2[3].y), xb1 = pack8c(X2[4].x, X2[4].y, X2[5].x, X2[5].y, X2[6].x, X2[6].y, X2[7].x, X2[7].y);
    f32x16 c = rw::zero16();
    c = __builtin_amdgcn_mfma_f32_32x32x16_bf16(tri[0], xb0, c, 0, 0, 0); c = __builtin_amdgcn_mfma_f32_32x32x16_bf16(tri[1], xb1, c, 0, 0, 0);
    float P[16];
#pragma unroll
    for (int qp = 0; qp < 8; ++qp) { const int q0 = 2 * qp, q1 = q0 + 1; const f32x2 a2 = zr2[qp] + (f32x2){c[q0], c[q1]};
        float p0 = __builtin_amdgcn_exp2f(a2.x), p1 = __builtin_amdgcn_exp2f(a2.y);
        if (DIAG) { const int k0 = (q0 & 3) + 8 * (q0 >> 2) + 4 * hh, k1 = (q1 & 3) + 8 * (q1 >> 2) + 4 * hh; p0 = (k0 < r) ? p0 : 0.f; p1 = (k1 < r) ? p1 : 0.f; }
        P[q0] = p0; P[q1] = p1; }
    pb0 = pack8c(P[0], P[1], P[2], P[3], P[4], P[5], P[6], P[7]); pb1 = pack8c(P[8], P[9], P[10], P[11], P[12], P[13], P[14], P[15]);
}
__device__ __forceinline__ void sbattn_phase(KArgs a, LAS unsigned char* lds, int bid, int nb) {
    const int tid = opaque_tid(), lane = tid & 63, w = __builtin_amdgcn_readfirstlane(tid >> 6), r = lane & 31, hh = lane >> 5;
    constexpr int NR = 10, KROWB = 144, KBLK = 32 * KROWB, VROWB = 192, VBLK = 32 * VROWB;
    LAS unsigned char* Kr = lds; LAS unsigned char* Vr = lds + NR * KBLK; LAS unsigned char* Ost = Vr + NR * VBLK; volatile LAS int* flag = (volatile LAS int*)(Ost + 8 * 4608);
    const bf16_t* Kg = (const bf16_t*)(a->ws + R2); const bf16_t* Vg = (const bf16_t*)(a->ws + R3); const bf16_t* Qg = (const bf16_t*)(a->ws + R4); bf16_t* Og = (bf16_t*)(a->ws + R0);
    bf16x8 tri[2];
#pragma unroll
    for (int ks = 0; ks < 2; ++ks) {
#pragma unroll
        for (int jj = 0; jj < 8; ++jj) { const int key = 16 * ks + 8 * (jj >> 2) + 4 * hh + (jj & 3); tri[ks][jj] = (key > r) ? (short)0x3F80 : (short)0; } }
    const int skey = (tid & 255) >> 3, sch = tid & 7; const bool isv = tid >= 256;
    u32x4 pre[8];
#define SB_REQUEST(unit_) do { const int u_ = (unit_); const int b_ = u_ >> 9, h_ = (u_ >> 5) & 15, qt_ = u_ & 31; const size_t hb_ = (size_t)b_ * S * D + h_ * 64; \
        _Pragma("unroll") for (int m = 0; m < 8; ++m) { const size_t go = hb_ + (size_t)((qt_ * 8 + m) * 32 + skey) * D + sch * 8; pre[m] = isv ? *(const u32x4*)(Vg + go) : *(const u32x4*)(Kg + go); } } while (0)
    if (bid < NB * 16 * 32) SB_REQUEST(bid);
    for (int unit = bid; unit < NB * 16 * 32; unit += nb) {
        const int b = unit >> 9, h = (unit >> 5) & 15, qt = unit & 31, q0 = qt * 256, kb0 = qt * 8;
        const size_t hbase = (size_t)b * S * D + h * 64;
        lds_barrier();
        if (tid < 3) flag[tid] = 0;
        bf16x8 Qf[4];
        { const bf16_t* qp = Qg + hbase + (size_t)(q0 + 32 * w + r) * D + 8 * hh;
#pragma unroll
          for (int ks = 0; ks < 4; ++ks) Qf[ks] = *(const bf16x8*)(qp + 16 * ks); }
        {
#pragma unroll
            for (int m = 0; m < 8; ++m) { const int slot = (kb0 + m) % NR; const u32x4 v = pre[m];
                if (!isv) *(LAS u32x4*)(Kr + slot * KBLK + skey * KROWB + sch * 16) = v;
                else *(LAS u32x4*)(Vr + slot * VBLK + skey * VROWB + sch * 16) = v; }
        }
        f32x16 o0, o1;
#pragma unroll
        for (int i = 0; i < 16; ++i) { o0[i] = 0.f; o1[i] = 0.f; }
        float R = 0.f; bool wdone = false;
        u32x4 sg0 = (u32x4){0u, 0u, 0u, 0u}, sg1 = sg0, sg2 = sg0;
        { const int n0 = kb0 - 1, n1 = kb0 - 2, n2 = kb0 - 3;
          if (n0 >= 0) { const size_t go = hbase + (size_t)(n0 * 32 + skey) * D + sch * 8; sg0 = isv ? *(const u32x4*)(Vg + go) : *(const u32x4*)(Kg + go); }
          if (n1 >= 0) { const size_t go = hbase + (size_t)(n1 * 32 + skey) * D + sch * 8; sg1 = isv ? *(const u32x4*)(Vg + go) : *(const u32x4*)(Kg + go); }
          if (n2 >= 0) { const size_t go = hbase + (size_t)(n2 * 32 + skey) * D + sch * 8; sg2 = isv ? *(const u32x4*)(Vg + go) : *(const u32x4*)(Kg + go); } }
        if (unit + nb < NB * 16 * 32) SB_REQUEST(unit + nb);
        for (int i = 0;; ++i) {
            lds_barrier();
            if (i > 0 && flag[(i - 1) % 3] == 0) break;
            if (tid == 0) flag[(i + 1) % 3] = 0;
            const int nblk = kb0 - i - 1;
            const u32x4 stg = sg0; sg0 = sg1; sg1 = sg2;
            { const int nf = kb0 - i - 4; sg2 = (u32x4){0u, 0u, 0u, 0u};
              if (nf >= 0) { const size_t go = hbase + (size_t)(nf * 32 + skey) * D + sch * 8; sg2 = isv ? *(const u32x4*)(Vg + go) : *(const u32x4*)(Kg + go); } }
            const int kb = kb0 + w - i;
            if (!wdone && kb >= 0) {
                const int slot = kb % NR;
                f32x16 s;
#pragma unroll
                for (int q = 0; q < 16; ++q) s[q] = 0.f;
#pragma unroll
                for (int ks = 0; ks < 4; ++ks) { const bf16x8 kf = *(const LAS bf16x8*)(Kr + slot * KBLK + r * KROWB + (16 * ks + 8 * hh) * 2); s = __builtin_amdgcn_mfma_f32_32x32x16_bf16(kf, Qf[ks], s, 0, 0, 0); }
                bf16x8 pb0, pb1; float tsum;
                if (i == 0) sb_block<true>(s, tri, R, r, hh, pb0, pb1, tsum); else sb_block<false>(s, tri, R, r, hh, pb0, pb1, tsum);
                const LAS unsigned char* vbase = Vr + slot * VBLK + (4 * hh + ((lane & 15) >> 2)) * VROWB + (16 * ((lane >> 4) & 1) + 4 * (lane & 3)) * 2;
#define SB_VT(s_, c_) __builtin_shufflevector(__builtin_amdgcn_ds_read_tr16_b64_v4i16((LAS s16x4*)(vbase + (16 * (s_)) * VROWB + 64 * (c_))), __builtin_amdgcn_ds_read_tr16_b64_v4i16((LAS s16x4*)(vbase + (16 * (s_) + 8) * VROWB + 64 * (c_))), 0, 1, 2, 3, 4, 5, 6, 7)
                { const bf16x8 v00 = SB_VT(0, 0), v10 = SB_VT(1, 0);
                  o0 = __builtin_amdgcn_mfma_f32_32x32x16_bf16(v00, pb0, o0, 0, 0, 0);
                  o0 = __builtin_amdgcn_mfma_f32_32x32x16_bf16(v10, pb1, o0, 0, 0, 0); }
                __builtin_amdgcn_sched_barrier(0);
                { const bf16x8 v01 = SB_VT(0, 1), v11 = SB_VT(1, 1);
                  o1 = __builtin_amdgcn_mfma_f32_32x32x16_bf16(v01, pb0, o1, 0, 0, 0);
                  o1 = __builtin_amdgcn_mfma_f32_32x32x16_bf16(v11, pb1, o1, 0, 0, 0); }
#undef SB_VT
                tsum += __shfl_xor(tsum, 32); R += tsum;
                wdone = (kb == 0) || (__builtin_amdgcn_ballot_w64(R >= -160.0f) == 0ull);
                if (!wdone && lane == 0) flag[i % 3] = 1;
            }
            if (nblk >= 0) { const int slot = nblk % NR;
                if (!isv) *(LAS u32x4*)(Kr + slot * KBLK + skey * KROWB + sch * 16) = stg;
                else *(LAS u32x4*)(Vr + slot * VBLK + skey * VROWB + sch * 16) = stg; }
        }
        { LAS bf16_t* ow = (LAS bf16_t*)(Ost + w * 4608);
#pragma unroll
          for (int m = 0; m < 4; ++m) { u32x2 wa, wb; wa.x = cvt_pk_c(o0[4 * m], o0[4 * m + 1]); wa.y = cvt_pk_c(o0[4 * m + 2], o0[4 * m + 3]); wb.x = cvt_pk_c(o1[4 * m], o1[4 * m + 1]); wb.y = cvt_pk_c(o1[4 * m + 2], o1[4 * m + 3]);
              *(LAS u32x2*)(ow + r * 72 + 8 * m + 4 * hh) = wa; *(LAS u32x2*)(ow + r * 72 + 32 + 8 * m + 4 * hh) = wb; }
          asm volatile("s_waitcnt lgkmcnt(0)" ::: "memory");
#pragma unroll
          for (int c4 = 0; c4 < 4; ++c4) { const int idx = c4 * 64 + lane, row = idx >> 3, ch = idx & 7; const u32x4 v = *(const LAS u32x4*)(ow + row * 72 + ch * 8);
              *(u32x4*)(Og + hbase + (size_t)(q0 + 32 * w + row) * D + ch * 8) = v; }
          asm volatile("s_waitcnt lgkmcnt(0)" ::: "memory"); }
    }
#undef SB_REQUEST
    __syncthreads();
}

__device__ __forceinline__ void assign_phase(KArgs a, int l, LAS unsigned char* lds, int bid, int nb) {
    const int tid = opaque_tid(), lane = tid & 63, wave = tid >> 6;
    LAS int* pst = (LAS int*)lds; LAS int* lc = pst + 64; LAS int* lbase = lc + 32; LAS int* a_tok = lbase + 32; LAS int* a_slot = a_tok + 512;
    unsigned* ctl = (unsigned*)a->ws;
    if (wave == 0) {
        const int v = lane < 32 ? (int)((__hip_atomic_load(ctl + CW_CNT + 64 * l + lane, __ATOMIC_RELAXED, __HIP_MEMORY_SCOPE_AGENT) + 255u) / 256u * 256u) : 0;
        int s = v;
#pragma unroll
        for (int d = 1; d < 32; d <<= 1) { const int o = __shfl_up(s, d); if (lane >= d) s += o; }
        if (lane < 32) pst[lane] = s - v;
        if (lane == 31) pst[32] = s; }
    if (tid < 32) lc[tid] = 0;
    __syncthreads();
    int* tile_expert = (int*)(a->ws + WS_TILEEXP);
    if (bid == 0) { const int ntl = pst[32] >> 8; if (tid == 0) ctl[CW_NT + 64 * l] = (unsigned)ntl;
        for (int ti = tid; ti < ntl; ti += 512) { int e = 0; for (int q = 1; q < 32; ++q) if (pst[q] <= ti * 256) e = q; tile_expert[ti] = e; } }
    const u32x4* tok = (const u32x4*)(a->ws + WS_TOK); int* slot_of = (int*)(a->ws + WS_SLOTOF); float* slot_info = (float*)(a->ws + WS_SLOTINFO);
    int* slot_tok = (int*)(a->ws + WS_SLOTTOK);
    for (int chunk = bid; chunk < T / 256; chunk += nb) {
        const int t = chunk * 256 + (tid >> 1), kk = tid & 1;
        const u32x4 info = tok[t]; const int e = kk ? (int)((info.x >> 8) & 0xff) : (int)(info.x & 0xff);
        const unsigned gbits = kk ? info.z : info.y, rbits = info.w;
        const float gate = __uint_as_float(gbits), rstd = __uint_as_float(rbits);
        const int rank = atomicAdd((int*)&lc[e], 1);
        __syncthreads();
        if (tid < 32) lbase[tid] = (int)__hip_atomic_fetch_add(ctl + CW_FILL + 64 * l + tid, (unsigned)lc[tid], __ATOMIC_RELAXED, __HIP_MEMORY_SCOPE_AGENT);
        __syncthreads();
        const int slot = pst[e] + lbase[e] + rank;
        slot_of[t * 2 + kk] = slot; slot_info[(size_t)slot * 2] = gate; slot_info[(size_t)slot * 2 + 1] = rstd; slot_tok[slot] = t;
        __syncthreads();
        if (tid < 32) lc[tid] = 0;
        __syncthreads();
    }
}

__device__ __forceinline__ void combine_phase(KArgs a, bool fin, int bid, int nb, float msc = 1.f) {
    const int tid = opaque_tid(), lane = tid & 63, wave = __builtin_amdgcn_readfirstlane(tid >> 6);
    float* x = a->out; const bf16_t* ys = (const bf16_t*)(a->ws + R2); const int* slot_of = (const int*)(a->ws + WS_SLOTOF);
    bf16_t* xb = (bf16_t*)(a->ws + R1); float* ssq = (float*)(a->ws + WS_SSQ); const float* nf = a->in[I_NORM_FINAL];
    const int step = nb * 8, r0 = bid * 8 + wave;
    if (r0 >= T) return;
    const int rlast = r0 + ((T - 1 - r0) / step) * step;
    f32x4 gfa[2], gfb[2];
#pragma unroll
    for (int k = 0; k < 2; ++k) { gfa[k] = fin ? *(const f32x4*)(nf + k * 512 + lane * 8) : (f32x4){0.f, 0.f, 0.f, 0.f}; gfb[k] = fin ? *(const f32x4*)(nf + k * 512 + lane * 8 + 4) : (f32x4){0.f, 0.f, 0.f, 0.f}; }
    u32x4 DA[6], DB[6]; int SA0, SA1, SB0, SB1;
#define CB_SLOT(S0_, S1_, row_) do { const int rr_ = (row_) < T ? (row_) : rlast; S0_ = slot_of[rr_ * 2]; S1_ = slot_of[rr_ * 2 + 1]; } while (0)
#define CB_DATA(D_, S0_, S1_, row_) do { const int rr_ = (row_) < T ? (row_) : rlast; _Pragma("unroll") for (int k = 0; k < 2; ++k) { \
        D_[k] = *(const u32x4*)(xb + (size_t)rr_ * D + k * 512 + lane * 8); D_[2 + k] = *(const u32x4*)(ys + (size_t)(S0_) * D + k * 512 + lane * 8); D_[4 + k] = *(const u32x4*)(ys + (size_t)(S1_) * D + k * 512 + lane * 8); } } while (0)
#define CB_ROW(D_, row_) do { const int rw_ = (row_); f32x4 xv[4]; float ss = 0.f; \
        _Pragma("unroll") for (int k = 0; k < 2; ++k) { const u32x4 xw = D_[k], y1 = D_[2 + k], y2 = D_[4 + k]; const float ms = msc; \
            xv[2 * k] = (f32x4){bf_lo(xw.x) + ms * (bf_lo(y1.x) + bf_lo(y2.x)), bf_hi(xw.x) + ms * (bf_hi(y1.x) + bf_hi(y2.x)), bf_lo(xw.y) + ms * (bf_lo(y1.y) + bf_lo(y2.y)), bf_hi(xw.y) + ms * (bf_hi(y1.y) + bf_hi(y2.y))}; \
            xv[2 * k + 1] = (f32x4){bf_lo(xw.z) + ms * (bf_lo(y1.z) + bf_lo(y2.z)), bf_hi(xw.z) + ms * (bf_hi(y1.z) + bf_hi(y2.z)), bf_lo(xw.w) + ms * (bf_lo(y1.w) + bf_lo(y2.w)), bf_hi(xw.w) + ms * (bf_hi(y1.w) + bf_hi(y2.w))}; \
            ss += ((xv[2 * k][0] * xv[2 * k][0] + xv[2 * k][1] * xv[2 * k][1]) + (xv[2 * k][2] * xv[2 * k][2] + xv[2 * k][3] * xv[2 * k][3])) + ((xv[2 * k + 1][0] * xv[2 * k + 1][0] + xv[2 * k + 1][1] * xv[2 * k + 1][1]) + (xv[2 * k + 1][2] * xv[2 * k + 1][2] + xv[2 * k + 1][3] * xv[2 * k + 1][3])); } \
        ss = wave_sum(ss); \
        if (fin) { const float rstd = __builtin_amdgcn_rsqf(ss * (1.0f / D) + NORM_EPS); \
            _Pragma("unroll") for (int k = 0; k < 2; ++k) { *(f32x4*)(x + (size_t)rw_ * D + k * 512 + lane * 8) = xv[2 * k] * rstd * gfa[k]; *(f32x4*)(x + (size_t)rw_ * D + k * 512 + lane * 8 + 4) = xv[2 * k + 1] * rstd * gfb[k]; } } \
        else { _Pragma("unroll") for (int k = 0; k < 2; ++k) *(u32x4*)(xb + (size_t)rw_ * D + k * 512 + lane * 8) = pack8v4(xv[2 * k], xv[2 * k + 1]); \
            if (lane < 16) ssq[(size_t)rw_ * 16 + lane] = lane == 0 ? ss : 0.f; } } while (0)
    CB_SLOT(SA0, SA1, r0); CB_SLOT(SB0, SB1, r0 + step);
    CB_DATA(DA, SA0, SA1, r0);
    for (int row = r0;;) {
        CB_SLOT(SA0, SA1, row + 2 * step);
        CB_DATA(DB, SB0, SB1, row + step);
        CB_ROW(DA, row);
        row += step; if (row >= T) break;
        CB_SLOT(SB0, SB1, row + 2 * step);
        CB_DATA(DA, SA0, SA1, row + step);
        CB_ROW(DB, row);
        row += step; if (row >= T) break;
    }
#undef CB_SLOT
#undef CB_DATA
#undef CB_ROW
}

#define GRID_BAR() do { XcdBarrier b_; b_.bar = (unsigned*)a->ws + CW_BAR; b_.x = xb_xcc_id(); b_.st = (volatile LAS unsigned*)(lds + LDS_MISC) + 8; xcd_barrier(b_); } while (0)
#define IN(k) true
#define SEAM(k) do { if (IN(k) && IN((k) + 1)) GRID_BAR(); } while (0)
template <int l> __device__ __forceinline__ void layer_body(KArgs a, LAS unsigned char* lds, const int lo, const int hi) {
    const int bid = blockIdx.x, nb = gridDim.x; unsigned char* ws = a->ws;

        const int pb = 1 + 13 * l;
        if constexpr (l == 0) {
            if (IN(pb + 0)) {
                { pg8::Gemm g{(const bf16_t*)ws, (const bf16_t*)(ws + WS_WCAT), D, D, D};
                  SchedRKV Sd; Sd.init(T / 256, 12, nb, bid); Sd.aoff0 = (long long)R6; Sd.aoff1 = (long long)((const unsigned char*)a->out - ws);
                  EpiCat E{(bf16_t*)(ws + R1), (bf16_t*)(ws + R5), (long long)(R2 - R1) / 2, 0};
                  pg8::gemm_phase(lds, g, Sd, E); }
                { pg8::Gemm g{(const bf16_t*)(ws + R0), (const bf16_t*)(ws + WS_WCAT) + (size_t)3072 * 2 * D, D, 2 * D, 2 * D};
                  SchedHP Sd; Sd.init(T / 256, 2, nb, bid);
                  EpiCat E{(bf16_t*)(ws + R1), (bf16_t*)(ws + R5), (long long)(R2 - R1) / 2, 12};
                  pg8::gemm_phase(lds, g, Sd, E); }
            }
            SEAM(pb + 0);
            if (IN(pb + 1)) {
                { pg8::Gemm g{(const bf16_t*)(ws + R5), (const bf16_t*)(ws + WS_WWA2), 512, 256, 256};
                  SchedPlain Sd; Sd.init(T / 256, 8, nb, bid); Sd.astr = (long long)256 * 512 * 2; Sd.bstr = (long long)256 * 256 * 2;
                  const float* b0 = a->in[I_W0]; const float* b1 = a->in[I_A0]; bf16_t* o0 = (bf16_t*)(ws + R4); bf16_t* o1 = (bf16_t*)a->out;
                  EpiAct E{o0, (long long)(o1 - o0), b0, (long long)(b1 - b0), -0.60653066f, 1.60653066f};
                  pg8::gemm_phase(lds, g, Sd, E); }
            }
            SEAM(pb + 1);
            if (IN(pb + 2)) {
                rw::stage_a(a, lds, bid, nb);
                GRID_BAR();
                if (bid < 128) rw::stage_b(a, lds, bid);
                else {
                    pg8::Gemm g{(const bf16_t*)(ws + WS_MN), (const bf16_t*)(ws + WS_WMKV), D, D, D};
                    SchedMemKV Sd; Sd.init(16, 8, nb - 128, bid - 128);
                    EpiMemKV E{(bf16_t*)(ws + WS_KMEM), (bf16_t*)(ws + WS_VT)};
                    pg8::gemm_phase(lds, g, Sd, E); }
                {
                    constexpr int NU = (T / 256) * 4, NSCAN = NU * 2 / 8;
                    pg8::Gemm g{(const bf16_t*)(ws + R5) + 256, (const bf16_t*)(ws + WS_WG2), 512, 256, 256};
                    SchedRange Sd; Sd.init(T / 256, 4, bid < 128 ? 128 : nb - 128, bid < 128 ? bid : bid - 128); Sd.astr = (long long)256 * 512 * 2; Sd.bstr = (long long)256 * 256 * 2;
                    Sd.base = bid < 128 ? 0 : NSCAN; Sd.count = bid < 128 ? NSCAN : NU - NSCAN;
                    EpiAct E{(bf16_t*)a->out + (size_t)T * D, 0, nullptr, 0, 1.f, 0.f};
                    pg8::gemm_phase(lds, g, Sd, E); }
                GRID_BAR();
                rw::stage_c(a, lds, bid, nb);
            }
            SEAM(pb + 2);
        } else {
            if (IN(pb + 0)) {
                pg8::Gemm g{(const bf16_t*)(ws + R1), (const bf16_t*)(ws + WS_WKVQ), D, D, D};
                SchedPlain Sd; Sd.init(T / 256, 12, nb, bid); Sd.astr = (long long)256 * D * 2; Sd.bstr = (long long)256 * D * 2;
                EpiRstd E{(bf16_t*)(ws + R2), (long long)(R3 - R2) / 2, (const float*)(ws + WS_SSQ)};
                pg8::gemm_phase(lds, g, Sd, E);
            }
            SEAM(pb + 0);
            if (IN(pb + 1)) { sbattn_phase(a, lds, bid, nb);
            }
            if (IN(pb + 1) && IN(pb + 3)) GRID_BAR();
        }
        if (IN(pb + 3)) {
            pg8::Gemm g{(const bf16_t*)(ws + (l ? R0 : R6)), (const bf16_t*)(ws + (l ? WS_WOSB : WS_WO0)), D, D, D};
            SchedPlain Sd; Sd.init(T / 256, 4, nb, bid); Sd.astr = (long long)256 * D * 2; Sd.bstr = (long long)256 * D * 2;
            EpiResid E{l ? (const float*)nullptr : a->in[I_X], (bf16_t*)(ws + R1), (float*)(ws + WS_SSQ), 1.f};
            pg8::gemm_phase(lds, g, Sd, E);
            if constexpr (l == 0) {
                { pg8::Gemm g2{(const bf16_t*)(ws + WS_KMEM), (const bf16_t*)(ws + WS_WMQ), D, D, 256};
                  SchedMemPre S2; S2.init(64, 4, nb, bid); S2.mode = 0; EpiMemPre E2{(bf16_t*)a->out};
                  pg8::gemm_phase(lds, g2, S2, E2); }
                { pg8::Gemm g2{(const bf16_t*)(ws + WS_WMO), (const bf16_t*)(ws + WS_VT), D, D, 256};
                  SchedMemPre S2; S2.init(64, 4, nb, bid); S2.mode = 1; EpiMemPre E2{(bf16_t*)a->out + (size_t)16 * D * D};
                  pg8::gemm_phase(lds, g2, S2, E2); } }
        }
        SEAM(pb + 3);
        if (IN(pb + 4)) {
            pg8::Gemm g{(const bf16_t*)(ws + R1), (const bf16_t*)a->out + (size_t)l * 8 * D * D, D, D, D};
            SchedBatchB Sd; Sd.init(T / 256, 4, nb, bid);
            EpiSoftmax E{(bf16_t*)(ws + R2), (const float*)(ws + WS_SSQ)};
            pg8::gemm_phase(lds, g, Sd, E);
        }
        SEAM(pb + 4);
        if (IN(pb + 7)) {
            pg8::Gemm g{(const bf16_t*)(ws + R2), (const bf16_t*)a->out + (size_t)(16 + l * 8) * D * D, D, D, D};
            SchedBatchB Sd; Sd.init(T / 256, 4, nb, bid);
            EpiResid E{(const float*)nullptr, (bf16_t*)(ws + R1), (float*)(ws + WS_SSQ), 1.f};
            pg8::gemm_phase(lds, g, Sd, E);
        }
        SEAM(pb + 7);
        if (IN(pb + 8)) {
            LAS int* lc = (LAS int*)(lds + LDS_EPI + 4096);
            if (threadIdx.x < 32) lc[threadIdx.x] = 0;
            __syncthreads();
            { pg8::Gemm g{(const bf16_t*)(ws + R1), (const bf16_t*)(ws + WS_RS) + (size_t)l * 256 * D, D, D, D};
              SchedPlain Sd; Sd.init(T / 256, 1, nb, bid); Sd.astr = (long long)256 * D * 2; Sd.bstr = 0;
              EpiRouter E{(const float*)(ws + WS_SSQ), a->in[I_BRG] + l * 4, a->in[I_BRE] + l * 32, (u32x4*)(ws + WS_TOK)};
              pg8::gemm_phase(lds, g, Sd, E); }
            __syncthreads();
            if (threadIdx.x < 32) atomicAdd((unsigned*)ws + CW_CNT + 64 * l + threadIdx.x, (unsigned)lc[threadIdx.x]);
        }
        SEAM(pb + 8);
        if (IN(pb + 9)) { assign_phase(a, l, lds, bid, nb);
        }
        SEAM(pb + 9);
        if (IN(pb + 10)) {
            const int ntl = (int)__hip_atomic_load((unsigned*)ws + CW_NT + 64 * l, __ATOMIC_RELAXED, __HIP_MEMORY_SCOPE_AGENT);
            pg8::Gemm g{(const bf16_t*)(ws + R1), (const bf16_t*)(ws + WS_WGU) + (size_t)l * 32 * 512 * D, D, D, D};
            SchedMoE Sd; Sd.init(ntl, 2, nb, bid); Sd.tile_expert = (const int*)(ws + WS_TILEEXP); Sd.mode = 0;
            EpiSwiGLU E{(bf16_t*)(ws + R0), (const float*)(ws + WS_SLOTINFO)};
            pg8::gemm_phase_gather(lds, g, Sd, E, (const int*)(ws + WS_SLOTTOK));
        }
        SEAM(pb + 10);
        if (IN(pb + 11)) {
            const int ntl = (int)__hip_atomic_load((unsigned*)ws + CW_NT + 64 * l, __ATOMIC_RELAXED, __HIP_MEMORY_SCOPE_AGENT);
            pg8::Gemm g{(const bf16_t*)(ws + R0), (const bf16_t*)(ws + WS_WDN) + (size_t)l * 32 * D * 256, 256, 256, 256};
            SchedMoE Sd; Sd.init(ntl, 4, nb, bid); Sd.tile_expert = (const int*)(ws + WS_TILEEXP); Sd.mode = 1;
            EpiGate E{(bf16_t*)(ws + R2), (const float*)(ws + WS_SLOTINFO)};
            pg8::gemm_phase(lds, g, Sd, E);
        }
        SEAM(pb + 11);
        combine_phase(a, l == 1, bid, nb);
        if (l == 0) SEAM(pb + 12);
    }
constexpr int NPHASE = 27;
__global__ void __launch_bounds__(512, 2) fwd_kernel(Args a_unused) {
    extern __shared__ __attribute__((aligned(16))) unsigned char lds_raw[];
    LAS unsigned char* lds = (LAS unsigned char*)lds_raw;
    const int tid = threadIdx.x, bid = blockIdx.x, nb = gridDim.x;
    KArgs a = kargs();
    unsigned char* ws = a->ws;
    volatile LAS unsigned* MISC = (volatile LAS unsigned*)(lds + LDS_MISC);
    if (tid < 64) MISC[tid] = 0u;
    __syncthreads();
    (void)xcd_barrier_post((unsigned*)ws + CW_BAR, MISC + 8);
    const int lo = a->ph_lo, hi = a->ph_hi;
    prologue_phase(a, lds, bid, nb);
    SEAM(0);
    layer_body<0>(a, lds, lo, hi);
    layer_body<1>(a, lds, lo, hi);
#undef IN
#undef SEAM
}

extern "C" void kernel_launch(void* const* d_in, const int* in_sizes, int n_in, void* d_out, int out_size, void* d_ws, size_t ws_size, hipStream_t stream) {
    static int grid = 0;
    if (grid == 0) {
        if (n_in != 37 || in_sizes[0] != T * D || out_size != T * D || ws_size < WS_END) { fprintf(stderr, "kernel_launch: unexpected shapes (n_in %d, ws %zu < %zu)\n", n_in, ws_size, (size_t)WS_END); grid = -1; return; }
        int dev = 0, cus = 0, per_cu = 0;
        if (hipGetDevice(&dev) != hipSuccess || hipDeviceGetAttribute(&cus, hipDeviceAttributeMultiprocessorCount, dev) != hipSuccess) { grid = -1; return; }
        if (hipFuncSetAttribute((const void*)fwd_kernel, hipFuncAttributeMaxDynamicSharedMemorySize, LDS_BYTES) != hipSuccess) { fprintf(stderr, "kernel_launch: hipFuncSetAttribute failed\n"); grid = -1; return; }
        if (hipOccupancyMaxActiveBlocksPerMultiprocessor(&per_cu, (const void*)fwd_kernel, 512, LDS_BYTES) != hipSuccess || per_cu < 1) fprintf(stderr, "kernel_launch: occupancy query reports %d\n", per_cu);
        (void)hipGetLastError();
        grid = cus;
    }
    if (grid < 0) return;
    hipMemsetAsync((char*)d_ws + WS_CTL, 0, CTL_BYTES, stream);
    hipMemsetAsync((char*)d_ws + WS_WCAT + (size_t)3072 * 2048 * 2, 0, (size_t)512 * 2048 * 2, stream);
    hipMemsetAsync((char*)d_ws + WS_WWA2, 0, (size_t)3072 * 256 * 2, stream);
    hipMemsetAsync((char*)d_ws + WS_SLOTTOK, 0, (size_t)NSLOT_MAX * 4, stream);
    Args ha{};
    for (int i = 0; i < 37; ++i) ha.in[i] = (const float*)d_in[i];
    ha.out = (float*)d_out; ha.ws = (unsigned char*)d_ws;
    ha.ph_lo = 0; ha.ph_hi = NPHASE;
    hipLaunchKernelGGL(fwd_kernel, dim3(grid), dim3(512), LDS_BYTES, stream, ha);
}
```
